# Optimizing an MI355X kernel written in HIP

```python
import math
import jax, jax.numpy as jnp
from jax import lax
import numpy as np

D_MODEL = 1024
BATCH = 4
SEQ = 4096
DEPTH = 4
DEC_BATCH = 32
DEC_SEQ = 4
PAST_LEN = 8192
PAGE_SIZE = 128

N_HEADS_RET = 4
HD_RET = 128
D_RET = N_HEADS_RET * HD_RET
N_HEADS_ATT = 8
HD_ATT = 64
D_ATT = N_HEADS_ATT * HD_ATT
D_MIX = D_RET + D_ATT
D_IN = 4 * D_RET + 3 * D_ATT
SPLITS = (D_RET, 2 * D_RET, 3 * D_RET, 4 * D_RET, 4 * D_RET + D_ATT, 4 * D_RET + 2 * D_ATT)
DIL_PATTERNS = ((128, 1), (512, 4), (2048, 16))
WIN_MAX = 2048
RET_CHUNK = 128
D_FF = 2816
CONV_W = 3
ROPE_THETA = 10000.0
EPS = 1e-6

kernel_name = "hybrid_retention_dilated_attn_convffn_step"


def rms_norm(x, w):
    xf = x.astype(jnp.float32)
    y = xf * lax.rsqrt(jnp.mean(xf * xf, axis=-1, keepdims=True) + EPS)
    return (y * w.astype(jnp.float32)).astype(x.dtype)


def rotary(x, pos):
    half = x.shape[-1] // 2
    inv = ROPE_THETA ** (-jnp.arange(half, dtype=jnp.float32) / half)
    ang = pos.astype(jnp.float32)[:, None] * inv[None, :]
    cos = jnp.cos(ang)[None, :, None, :]
    sin = jnp.sin(ang)[None, :, None, :]
    xf = x.astype(jnp.float32)
    x1, x2 = xf[..., :half], xf[..., half:]
    return jnp.concatenate([x1 * cos - x2 * sin, x2 * cos + x1 * sin], axis=-1).astype(x.dtype)


def ret_log_decay():
    return jnp.log1p(-jnp.exp2(-5.0 - jnp.arange(N_HEADS_RET, dtype=jnp.float32)))


def retention(q, k, v, s0):
    C = q.shape[2]
    lg = ret_log_decay()
    idx = jnp.arange(C, dtype=jnp.float32)
    diff = idx[:, None] - idx[None, :]
    causal = diff >= 0
    dmask = jnp.where(causal, jnp.exp(jnp.where(causal, diff, 0.0)[None] * lg[:, None, None]), 0.0)
    k = k * HD_RET ** -0.5
    scores = jnp.einsum('bnihd,bnjhd->bnhij', q, k) * dmask
    inner = jnp.einsum('bnhij,bnjhe->bnihe', scores, v)
    kdec = k * jnp.exp((C - 1.0 - idx)[:, None] * lg[None, :])[None, None, :, :, None]
    upd = jnp.einsum('bnjhd,bnjhe->nbhde', kdec, v)
    chunk_decay = jnp.exp(C * lg)[None, :, None, None]

    def step(s, u):
        return chunk_decay * s + u, s

    s_final, s_before = lax.scan(step, s0, upd)
    qdec = q * jnp.exp((idx + 1.0)[:, None] * lg[None, :])[None, None, :, :, None]
    cross = jnp.einsum('bnihd,nbhde->bnihe', qdec, s_before)
    return inner + cross, s_final


def combine_by_denominator(outs, lses):
    w = jax.nn.softmax(jnp.stack(lses, axis=0), axis=0)
    return jnp.sum(w[..., None] * jnp.stack(outs, axis=0), axis=0)


def dilated_attn_prompt(q, k, v):
    B, S, H, hd = q.shape
    outs, lses = [], []
    for window, dil in DIL_PATTERNS:
        nb = window // dil
        span = dil * nb
        Sp = -(-S // span) * span
        nblk = Sp // span
        pad = ((0, 0), (0, Sp - S), (0, 0), (0, 0))

        def strided(t):
            t = jnp.pad(t.astype(jnp.float32), pad).reshape(B, Sp // dil, dil, H, hd)
            return t.transpose(0, 2, 1, 3, 4).reshape(B, dil, nblk, nb, H, hd)

        def with_prev(t):
            prev = jnp.pad(t, ((0, 0), (0, 0), (1, 0), (0, 0), (0, 0), (0, 0)))[:, :, :-1]
            return jnp.concatenate([prev, t], axis=3)

        qs = strided(q)
        kb, vb = with_prev(strided(k)), with_prev(strided(v))
        s = jnp.einsum('brnqhd,brnkhd->brnhqk', qs, kb) * hd ** -0.5
        qi = jnp.arange(nb)[:, None]
        ki = jnp.arange(2 * nb)[None, :] - nb
        dist = qi - ki
        blk = jnp.arange(nblk)[:, None, None]
        valid = (dist >= 0) & (dist <= nb) & (blk * nb + ki >= 0)
        s = jnp.where(valid[None, None, :, None], s, -jnp.inf)
        m = jnp.max(s, axis=-1, keepdims=True)
        p = jnp.exp(s - m)
        den = jnp.sum(p, axis=-1, keepdims=True)
        o = jnp.einsum('brnhqk,brnkhd->brnqhd', p / den, vb)
        lse = (m + jnp.log(den))[..., 0]
        o = o.reshape(B, dil, Sp // dil, H, hd).transpose(0, 2, 1, 3, 4).reshape(B, Sp, H, hd)[:, :S]
        lse = lse.transpose(0, 1, 2, 4, 3).reshape(B, dil, Sp // dil, H).transpose(0, 2, 1, 3).reshape(B, Sp, H)[:, :S]
        outs.append(o)
        lses.append(lse)
    return combine_by_denominator(outs, lses)


def dilated_attn_sample(q, k_all, v_all, n_ctx):
    B, T, H, hd = q.shape
    qf = q.astype(jnp.float32)
    kf, vf = k_all.astype(jnp.float32), v_all.astype(jnp.float32)
    outs, lses = [], []
    for window, dil in DIL_PATTERNS:
        n = window // dil + 1
        idx = n_ctx + jnp.arange(T)[:, None] - dil * jnp.arange(n)[None, :]
        valid = idx >= 0
        idx_c = jnp.clip(idx, 0, None)
        kg = jnp.take(kf, idx_c, axis=1)
        vg = jnp.take(vf, idx_c, axis=1)
        s = jnp.einsum('bthd,btnhd->btnh', qf, kg) * hd ** -0.5
        s = jnp.where(valid[None, :, :, None], s, -jnp.inf)
        m = jnp.max(s, axis=2, keepdims=True)
        p = jnp.exp(s - m)
        den = jnp.sum(p, axis=2, keepdims=True)
        outs.append(jnp.einsum('btnh,btnhd->bthd', p / den, vg))
        lses.append((m + jnp.log(den))[:, :, 0, :])
    return combine_by_denominator(outs, lses)


def project(h, w_in_l, pos):
    B, T, _ = h.shape
    z = h @ w_in_l
    qr, kr, vr, gr, qa, ka, va = jnp.split(z, SPLITS, axis=-1)
    hr = lambda t: t.reshape(B, T, N_HEADS_RET, HD_RET)
    ha = lambda t: t.reshape(B, T, N_HEADS_ATT, HD_ATT)
    qr, kr = rotary(hr(qr), pos), rotary(hr(kr), pos)
    qa, ka = rotary(ha(qa), pos), rotary(ha(ka), pos)
    return qr, kr, hr(vr), gr, qa, ka, ha(va)


def merge(o_ret, g_ret, o_att, gn_w_l, w_out_l, dtype):
    B, T = o_ret.shape[:2]
    mu = jnp.mean(o_ret, axis=-1, keepdims=True)
    var = jnp.mean(jnp.square(o_ret - mu), axis=-1, keepdims=True)
    y = ((o_ret - mu) * lax.rsqrt(var + EPS)).reshape(B, T, D_RET) * gn_w_l.astype(jnp.float32)
    y = jax.nn.silu(g_ret.astype(jnp.float32)) * y
    cat = jnp.concatenate([y.astype(dtype), o_att.reshape(B, T, D_ATT).astype(dtype)], axis=-1)
    return cat @ w_out_l


def token_mixer_prompt(h, w_in_l, gn_w_l, w_out_l):
    B, S, _ = h.shape
    pos = jnp.arange(S, dtype=jnp.int32)
    qr, kr, vr, gr, qa, ka, va = project(h, w_in_l, pos)
    C = RET_CHUNK
    chunk = lambda t: t.astype(jnp.float32).reshape(B, S // C, C, N_HEADS_RET, HD_RET)
    s0 = jnp.zeros((B, N_HEADS_RET, HD_RET, HD_RET), jnp.float32)
    o_r, s_fin = retention(chunk(qr), chunk(kr), chunk(vr), s0)
    o_r = o_r.reshape(B, S, N_HEADS_RET, HD_RET)
    o_a = dilated_attn_prompt(qa, ka, va)
    out = merge(o_r, gr, o_a, gn_w_l, w_out_l, h.dtype)
    w_keep = min(WIN_MAX, S)
    return out, ka[:, S - w_keep:], va[:, S - w_keep:], s_fin


def token_mixer_sample(h, ck, cv, s0, w_in_l, gn_w_l, w_out_l):
    B, T, _ = h.shape
    pos = PAST_LEN + jnp.arange(T, dtype=jnp.int32)
    qr, kr, vr, gr, qa, ka, va = project(h, w_in_l, pos)
    one = lambda t: t.astype(jnp.float32).reshape(B, 1, T, N_HEADS_RET, HD_RET)
    o_r, s_new = retention(one(qr), one(kr), one(vr), s0.astype(jnp.float32))
    o_r = o_r.reshape(B, T, N_HEADS_RET, HD_RET)
    k_all = jnp.concatenate([ck.astype(ka.dtype), ka], axis=1)
    v_all = jnp.concatenate([cv.astype(va.dtype), va], axis=1)
    o_a = dilated_attn_sample(qa, k_all, v_all, ck.shape[1])
    out = merge(o_r, gr, o_a, gn_w_l, w_out_l, h.dtype)
    return out, ka, va, s_new


def conv_ffn(h, ctx, w_up_l, conv_w_l, conv_b_l, w_down_l):
    u = h @ w_up_l
    T = u.shape[1]
    ext = jnp.concatenate([ctx.astype(u.dtype), u], axis=1)
    c = conv_b_l
    for j in range(CONV_W):
        c = c + ext[:, j:j + T] * conv_w_l[j]
    g, val = c[..., :D_FF], c[..., D_FF:]
    y = (jax.nn.silu(g) * val) @ w_down_l
    return y, ext[:, ext.shape[1] - (CONV_W - 1):]


def setup_inputs(seed: int = 0) -> dict:
    key = jax.random.key(seed)
    ks = jax.random.split(key, 20)
    f32 = jnp.float32
    nrm = lambda k, shape, scale: scale * jax.random.normal(k, shape, f32)
    w_ctx = min(WIN_MAX, PAST_LEN)
    return {
        "x_prompt": nrm(ks[0], (BATCH, SEQ, D_MODEL), 1.0),
        "x_sample": nrm(ks[1], (DEC_BATCH, DEC_SEQ, D_MODEL), 1.0),
        "cache_win_k": nrm(ks[2], (DEPTH, DEC_BATCH, w_ctx, N_HEADS_ATT, HD_ATT), 1.0),
        "cache_win_v": nrm(ks[3], (DEPTH, DEC_BATCH, w_ctx, N_HEADS_ATT, HD_ATT), 1.0),
        "state_ret": nrm(ks[4], (DEPTH, DEC_BATCH, N_HEADS_RET, HD_RET, HD_RET), 0.5),
        "state_conv": nrm(ks[5], (DEPTH, DEC_BATCH, CONV_W - 1, 2 * D_FF), 0.5),
        "norm1_w": 1.0 + nrm(ks[6], (DEPTH, D_MODEL), 0.02),
        "w_in": nrm(ks[7], (DEPTH, D_MODEL, D_IN), D_MODEL ** -0.5),
        "ret_gn_w": 1.0 + nrm(ks[8], (DEPTH, D_RET), 0.02),
        "w_out": nrm(ks[9], (DEPTH, D_MIX, D_MODEL), D_MIX ** -0.5),
        "norm2_w": 1.0 + nrm(ks[10], (DEPTH, D_MODEL), 0.02),
        "w_up": nrm(ks[11], (DEPTH, D_MODEL, 2 * D_FF), D_MODEL ** -0.5),
        "conv_w": nrm(ks[12], (DEPTH, CONV_W, 2 * D_FF), CONV_W ** -0.5),
        "conv_b": nrm(ks[13], (DEPTH, 2 * D_FF), 0.02),
        "w_down": nrm(ks[14], (DEPTH, D_FF, D_MODEL), D_FF ** -0.5),
        "final_norm_w": 1.0 + nrm(ks[15], (D_MODEL,), 0.02),
    }


def reference(x_prompt, x_sample, cache_win_k, cache_win_v, state_ret, state_conv,
              norm1_w, w_in, ret_gn_w, w_out, norm2_w, w_up, conv_w, conv_b, w_down, final_norm_w):
    xp, xs = x_prompt, x_sample
    B = xp.shape[0]
    pk, pv, pr, pc, sk, sv, sr, sc = [], [], [], [], [], [], [], []
    for l in range(DEPTH):
        mp, kp_, vp_, rp_ = token_mixer_prompt(rms_norm(xp, norm1_w[l]), w_in[l], ret_gn_w[l], w_out[l])
        xp = xp + mp
        ms, ks_, vs_, rs_ = token_mixer_sample(rms_norm(xs, norm1_w[l]), cache_win_k[l], cache_win_v[l],
                                              state_ret[l], w_in[l], ret_gn_w[l], w_out[l])
        xs = xs + ms
        zero_ctx = jnp.zeros((B, CONV_W - 1, 2 * D_FF), xp.dtype)
        fp, cp_ = conv_ffn(rms_norm(xp, norm2_w[l]), zero_ctx, w_up[l], conv_w[l], conv_b[l], w_down[l])
        xp = xp + fp
        fs, cs_ = conv_ffn(rms_norm(xs, norm2_w[l]), state_conv[l], w_up[l], conv_w[l], conv_b[l], w_down[l])
        xs = xs + fs
        pk.append(kp_); pv.append(vp_); pr.append(rp_); pc.append(cp_)
        sk.append(ks_); sv.append(vs_); sr.append(rs_); sc.append(cs_)
    y_prompt = rms_norm(xp, final_norm_w)
    y_sample = rms_norm(xs, final_norm_w)
    p_win_k, p_win_v = jnp.stack(pk), jnp.stack(pv)
    p_ret, p_conv = jnp.stack(pr), jnp.stack(pc)
    s_win_k, s_win_v = jnp.stack(sk), jnp.stack(sv)
    s_ret, s_conv = jnp.stack(sr), jnp.stack(sc)
    return (y_prompt, y_sample, p_win_k, p_win_v, p_ret, p_conv, s_win_k, s_win_v, s_ret, s_conv)
```

```cpp
#include <hip/hip_runtime.h>
#include <cstdio>
#include <cstdint>
#include <cmath>

namespace nv {
constexpr int DM = 1024, NB = 4, SEQ = 4096, DEPTH = 4, DB = 32, DS = 4, PAST = 8192;
constexpr int MP = NB * SEQ, MS = DB * DS, MT = MP + MS;
constexpr int DIN = 3584, DFF = 2816, DUP = 2 * DFF, WCTX = 2048;
constexpr int C_QR = 0, C_KR = 512, C_VR = 1024, C_GR = 1536, C_QA = 2048, C_KA = 2560, C_VA = 3072;
constexpr float EPS = 1e-6f;

__device__ __forceinline__ float silu(float x) { return x / (1.f + expf(-x)); }

__global__ __launch_bounds__(256) void rmsnorm_k(const float* x, const float* w, float* y) {
    __shared__ float red[4];
    const int m = blockIdx.x, tid = threadIdx.x;
    const float4 v = ((const float4*)(x + (size_t)m * DM))[tid];
    float s = v.x * v.x + v.y * v.y + v.z * v.z + v.w * v.w;
    for (int o = 32; o > 0; o >>= 1) s += __shfl_xor(s, o);
    if ((tid & 63) == 0) red[tid >> 6] = s;
    __syncthreads();
    const float tot = red[0] + red[1] + red[2] + red[3];
    const float r = rsqrtf(tot * (1.f / DM) + EPS);
    const float4 ww = ((const float4*)w)[tid];
    float4 o; o.x = v.x * r * ww.x; o.y = v.y * r * ww.y; o.z = v.z * r * ww.z; o.w = v.w * r * ww.w;
    ((float4*)(y + (size_t)m * DM))[tid] = o;
}

__global__ __launch_bounds__(256) void gemm_k(const float* __restrict__ A, const float* __restrict__ B, float* C, const float* R, int M, int N, int K) {
    __shared__ float As[16][68];
    __shared__ float Bs[16][68];
    const int tid = threadIdx.x, tx = tid & 15, ty = tid >> 4;
    const int m0 = blockIdx.y * 64, n0 = blockIdx.x * 64;
    float acc[4][4];
#pragma unroll
    for (int i = 0; i < 4; ++i)
#pragma unroll
        for (int j = 0; j < 4; ++j) acc[i][j] = 0.f;
    for (int k0 = 0; k0 < K; k0 += 16) {
        const float4 a = *(const float4*)(A + (size_t)(m0 + (tid >> 2)) * K + k0 + (tid & 3) * 4);
        As[(tid & 3) * 4 + 0][tid >> 2] = a.x; As[(tid & 3) * 4 + 1][tid >> 2] = a.y; As[(tid & 3) * 4 + 2][tid >> 2] = a.z; As[(tid & 3) * 4 + 3][tid >> 2] = a.w;
        const float4 b = *(const float4*)(B + (size_t)(k0 + (tid >> 4)) * N + n0 + (tid & 15) * 4);
        *(float4*)&Bs[tid >> 4][(tid & 15) * 4] = b;
        __syncthreads();
#pragma unroll
        for (int k = 0; k < 16; ++k) {
            const float4 av = *(const float4*)&As[k][ty * 4];
            const float4 bv = *(const float4*)&Bs[k][tx * 4];
            const float aa[4] = {av.x, av.y, av.z, av.w}, bb[4] = {bv.x, bv.y, bv.z, bv.w};
#pragma unroll
            for (int i = 0; i < 4; ++i)
#pragma unroll
                for (int j = 0; j < 4; ++j) acc[i][j] += aa[i] * bb[j];
        }
        __syncthreads();
    }
#pragma unroll
    for (int i = 0; i < 4; ++i) {
        const size_t off = (size_t)(m0 + ty * 4 + i) * N + n0 + tx * 4;
        float4 o = {acc[i][0], acc[i][1], acc[i][2], acc[i][3]};
        if (R) { const float4 r = *(const float4*)(R + off); o.x += r.x; o.y += r.y; o.z += r.z; o.w += r.w; }
        *(float4*)(C + off) = o;
    }
}

__device__ __forceinline__ int row_pos(int m) { return m < MP ? (m % SEQ) : PAST + ((m - MP) % DS); }

__global__ __launch_bounds__(256) void rotary_k(float* z) {
    const int m = blockIdx.x; const float pos = (float)row_pos(m);
    float* zr = z + (size_t)m * DIN;
    for (int p = threadIdx.x; p < 1024; p += 256) {
        int c1, c2; float inv;
        if (p < 512) { const int sec = p >> 8, hh = (p >> 6) & 3, i = p & 63; c1 = (sec ? C_KR : C_QR) + hh * 128 + i; c2 = c1 + 64; inv = powf(10000.f, -(float)i / 64.f); }
        else { const int q = p - 512, sec = q >> 8, hh = (q >> 5) & 7, i = q & 31; c1 = (sec ? C_KA : C_QA) + hh * 64 + i; c2 = c1 + 32; inv = powf(10000.f, -(float)i / 32.f); }
        const float ang = pos * inv; float sn, cs; sincosf(ang, &sn, &cs);
        const float x1 = zr[c1], x2 = zr[c2];
        zr[c1] = x1 * cs - x2 * sn; zr[c2] = x2 * cs + x1 * sn;
    }
}

__global__ __launch_bounds__(128) void ret_k(const float* z, int row0, int T, const float* s0, float* oret, float* sfin) {
    __shared__ float qs[128], ks[128];
    const int sq = blockIdx.x, h = blockIdx.y, e = threadIdx.x;
    const float gam = 1.f - exp2f(-5.f - (float)h);
    float S[128];
    const size_t sbase = ((size_t)sq * 4 + h) * 16384;
#pragma unroll
    for (int d = 0; d < 128; ++d) S[d] = s0 ? s0[sbase + d * 128 + e] : 0.f;
    for (int t = 0; t < T; ++t) {
        const float* zr = z + (size_t)(row0 + sq * T + t) * DIN;
        qs[e] = zr[C_QR + h * 128 + e]; ks[e] = zr[C_KR + h * 128 + e] * 0.08838834764831845f;
        const float v = zr[C_VR + h * 128 + e];
        __syncthreads();
        float o = 0.f;
#pragma unroll
        for (int d = 0; d < 128; ++d) { S[d] = gam * S[d] + ks[d] * v; o += qs[d] * S[d]; }
        oret[(size_t)(row0 + sq * T + t) * 512 + h * 128 + e] = o;
        __syncthreads();
    }
#pragma unroll
    for (int d = 0; d < 128; ++d) sfin[sbase + d * 128 + e] = S[d];
}

__global__ __launch_bounds__(256) void attn_k(const float* z, const float* ck, const float* cv, float* cat) {
    const int wv = blockIdx.x * 4 + (threadIdx.x >> 6), d = threadIdx.x & 63;
    const int m = wv >> 3, h = wv & 7;
    if (m >= MT) return;
    const float q = z[(size_t)m * DIN + C_QA + h * 64 + d] * 0.125f;
    float mx = -INFINITY, l = 0.f, acc = 0.f;
    const bool prompt = m < MP;
    const int b = prompt ? m / SEQ : (m - MP) / DS, t = prompt ? m % SEQ : (m - MP) % DS;
    for (int g = 0; g < 3; ++g) {
        const int dil = g == 0 ? 1 : (g == 1 ? 4 : 16);
        for (int j = 0; j <= 128; ++j) {
            float kv, vv;
            if (prompt) { const int p = t - dil * j; if (p < 0) break; const float* zr = z + (size_t)(b * SEQ + p) * DIN; kv = zr[C_KA + h * 64 + d]; vv = zr[C_VA + h * 64 + d]; }
            else { const int idx = WCTX + t - dil * j; if (idx < 0) break;
                if (idx >= WCTX) { const float* zr = z + (size_t)(MP + b * DS + (idx - WCTX)) * DIN; kv = zr[C_KA + h * 64 + d]; vv = zr[C_VA + h * 64 + d]; }
                else { const size_t o = (((size_t)b * WCTX + idx) * 8 + h) * 64 + d; kv = ck[o]; vv = cv[o]; } }
            float s = q * kv;
            for (int o = 32; o > 0; o >>= 1) s += __shfl_xor(s, o);
            const float mn = fmaxf(mx, s), f = expf(mx - mn), pe = expf(s - mn);
            l = l * f + pe; acc = acc * f + pe * vv; mx = mn;
        }
    }
    cat[(size_t)m * DM + 512 + h * 64 + d] = acc / l;
}

__global__ __launch_bounds__(256) void merge_k(const float* oret, const float* z, const float* gnw, float* cat) {
    const int wv = blockIdx.x * 4 + (threadIdx.x >> 6), lane = threadIdx.x & 63;
    const int m = wv >> 2, h = wv & 3;
    if (m >= MT) return;
    const float a = oret[(size_t)m * 512 + h * 128 + lane], b = oret[(size_t)m * 512 + h * 128 + 64 + lane];
    float s = a + b;
    for (int o = 32; o > 0; o >>= 1) s += __shfl_xor(s, o);
    const float mu = s * (1.f / 128.f);
    float v = (a - mu) * (a - mu) + (b - mu) * (b - mu);
    for (int o = 32; o > 0; o >>= 1) v += __shfl_xor(v, o);
    const float r = rsqrtf(v * (1.f / 128.f) + EPS);
    const float g0 = z[(size_t)m * DIN + C_GR + h * 128 + lane], g1 = z[(size_t)m * DIN + C_GR + h * 128 + 64 + lane];
    cat[(size_t)m * DM + h * 128 + lane] = silu(g0) * ((a - mu) * r * gnw[h * 128 + lane]);
    cat[(size_t)m * DM + h * 128 + 64 + lane] = silu(g1) * ((b - mu) * r * gnw[h * 128 + 64 + lane]);
}

__global__ __launch_bounds__(256) void conv_k(const float* u, const float* sconv_in, const float* cw, const float* cb, float* a, float* pconv, float* sconv) {
    const size_t i = (size_t)blockIdx.x * 256 + threadIdx.x;
    if (i >= (size_t)MT * DFF) return;
    const int m = (int)(i / DFF), c = (int)(i % DFF);
    const bool prompt = m < MP;
    const int b = prompt ? m / SEQ : (m - MP) / DS, t = prompt ? m % SEQ : (m - MP) % DS;
    float gv[2];
#pragma unroll
    for (int half = 0; half < 2; ++half) {
        const int cc = c + half * DFF;
        float r = cb[cc];
#pragma unroll
        for (int j = 0; j < 3; ++j) {
            const int tt = t + j - 2; float e;
            if (tt >= 0) e = u[(size_t)(m + j - 2) * DUP + cc];
            else e = prompt ? 0.f : sconv_in[((size_t)b * 2 + (tt + 2)) * DUP + cc];
            r += e * cw[j * DUP + cc];
        }
        gv[half] = r;
    }
    a[(size_t)m * DFF + c] = silu(gv[0]) * gv[1];
    if (prompt) { if (t >= SEQ - 2) { const int j = t - (SEQ - 2); pconv[((size_t)b * 2 + j) * DUP + c] = u[(size_t)m * DUP + c]; pconv[((size_t)b * 2 + j) * DUP + c + DFF] = u[(size_t)m * DUP + c + DFF]; } }
    else { if (t >= DS - 2) { const int j = t - (DS - 2); sconv[((size_t)b * 2 + j) * DUP + c] = u[(size_t)m * DUP + c]; sconv[((size_t)b * 2 + j) * DUP + c + DFF] = u[(size_t)m * DUP + c + DFF]; } }
}

__global__ __launch_bounds__(256) void winout_k(const float* z, float* pwk, float* pwv, float* swk, float* swv) {
    const size_t i = (size_t)blockIdx.x * 256 + threadIdx.x;
    const size_t np = (size_t)NB * 2048 * 512;
    if (i < np) { const int c = (int)(i % 512); const size_t r = i / 512; const int b = (int)(r / 2048), ii = (int)(r % 2048); const float* zr = z + (size_t)(b * SEQ + 2048 + ii) * DIN; pwk[i] = zr[C_KA + c]; pwv[i] = zr[C_VA + c]; }
    else if (i < np + (size_t)MS * 512) { const size_t k = i - np; const int c = (int)(k % 512); const int r = (int)(k / 512); const float* zr = z + (size_t)(MP + r) * DIN; swk[k] = zr[C_KA + c]; swv[k] = zr[C_VA + c]; }
}
}

extern "C" void kernel_launch(void* const* d_in, const int* in_sizes, int n_in, void* d_out, int out_size, void* d_ws, size_t ws_size, hipStream_t stream) {
    using namespace nv;
    const float* x_prompt = (const float*)d_in[0]; const float* x_sample = (const float*)d_in[1];
    const float* cwk = (const float*)d_in[2]; const float* cwv = (const float*)d_in[3];
    const float* sret = (const float*)d_in[4]; const float* sconv = (const float*)d_in[5];
    const float* n1w = (const float*)d_in[6]; const float* w_in = (const float*)d_in[7]; const float* gnw = (const float*)d_in[8];
    const float* w_out = (const float*)d_in[9]; const float* n2w = (const float*)d_in[10]; const float* w_up = (const float*)d_in[11];
    const float* cw = (const float*)d_in[12]; const float* cb = (const float*)d_in[13]; const float* w_down = (const float*)d_in[14]; const float* fnw = (const float*)d_in[15];
    float* out = (float*)d_out;
    float* y_prompt = out; float* y_sample = y_prompt + (size_t)MP * DM;
    float* p_win_k = y_sample + (size_t)MS * DM; float* p_win_v = p_win_k + (size_t)DEPTH * NB * 2048 * 512;
    float* p_ret = p_win_v + (size_t)DEPTH * NB * 2048 * 512; float* p_conv = p_ret + (size_t)DEPTH * NB * 4 * 16384;
    float* s_win_k = p_conv + (size_t)DEPTH * NB * 2 * DUP; float* s_win_v = s_win_k + (size_t)DEPTH * DB * DS * 512;
    float* s_ret = s_win_v + (size_t)DEPTH * DB * DS * 512; float* s_conv = s_ret + (size_t)DEPTH * DB * 4 * 16384;
    float* ws = (float*)d_ws;
    float* x = ws;                       ws += (size_t)MT * DM;
    float* h = ws;                       ws += (size_t)MT * DM;
    float* z = ws;                       ws += (size_t)MT * DIN;
    float* oret = ws;                    ws += (size_t)MT * 512;
    float* cat = ws;                     ws += (size_t)MT * DM;
    float* u = ws;                       ws += (size_t)MT * DUP;
    float* a = ws;                       ws += (size_t)MT * DFF;
    hipMemcpyAsync(x, x_prompt, (size_t)MP * DM * 4, hipMemcpyDeviceToDevice, stream);
    hipMemcpyAsync(x + (size_t)MP * DM, x_sample, (size_t)MS * DM * 4, hipMemcpyDeviceToDevice, stream);
    for (int l = 0; l < DEPTH; ++l) {
        rmsnorm_k<<<MT, 256, 0, stream>>>(x, n1w + (size_t)l * DM, h);
        gemm_k<<<dim3(DIN / 64, MT / 64), 256, 0, stream>>>(h, w_in + (size_t)l * DM * DIN, z, nullptr, MT, DIN, DM);
        rotary_k<<<MT, 256, 0, stream>>>(z);
        winout_k<<<(int)(((size_t)(NB * 2048 + MS) * 512 + 255) / 256), 256, 0, stream>>>(z, p_win_k + (size_t)l * NB * 2048 * 512, p_win_v + (size_t)l * NB * 2048 * 512,
                                                                                         s_win_k + (size_t)l * MS * 512, s_win_v + (size_t)l * MS * 512);
        ret_k<<<dim3(NB, 4), 128, 0, stream>>>(z, 0, SEQ, nullptr, oret, p_ret + (size_t)l * NB * 4 * 16384);
        ret_k<<<dim3(DB, 4), 128, 0, stream>>>(z, MP, DS, sret + (size_t)l * DB * 4 * 16384, oret, s_ret + (size_t)l * DB * 4 * 16384);
        attn_k<<<MT * 8 / 4, 256, 0, stream>>>(z, cwk + (size_t)l * DB * WCTX * 512, cwv + (size_t)l * DB * WCTX * 512, cat);
        merge_k<<<MT * 4 / 4, 256, 0, stream>>>(oret, z, gnw + (size_t)l * 512, cat);
        gemm_k<<<dim3(DM / 64, MT / 64), 256, 0, stream>>>(cat, w_out + (size_t)l * DM * DM, x, x, MT, DM, DM);
        rmsnorm_k<<<MT, 256, 0, stream>>>(x, n2w + (size_t)l * DM, h);
        gemm_k<<<dim3(DUP / 64, MT / 64), 256, 0, stream>>>(h, w_up + (size_t)l * DM * DUP, u, nullptr, MT, DUP, DM);
        conv_k<<<(int)(((size_t)MT * DFF + 255) / 256), 256, 0, stream>>>(u, sconv + (size_t)l * DB * 2 * DUP, cw + (size_t)l * 3 * DUP, cb + (size_t)l * DUP, a,
                                                                        p_conv + (size_t)l * NB * 2 * DUP, s_conv + (size_t)l * DB * 2 * DUP);
        gemm_k<<<dim3(DM / 64, MT / 64), 256, 0, stream>>>(a, w_down + (size_t)l * DFF * DM, x, x, MT, DM, DFF);
    }
    rmsnorm_k<<<MP, 256, 0, stream>>>(x, fnw, y_prompt);
    rmsnorm_k<<<MS, 256, 0, stream>>>(x + (size_t)MP * DM, fnw, y_sample);
}
```

```cpp
#include <hip/hip_runtime.h>
#include <cstdio>
#include <cstdint>
#include <cmath>
namespace pg8 {
#define PG8_LAS __attribute__((address_space(3)))
typedef unsigned short bf16_t;
typedef short bf16x8 __attribute__((ext_vector_type(8)));
typedef float f32x4 __attribute__((ext_vector_type(4)));
typedef unsigned u32x4 __attribute__((ext_vector_type(4)));
constexpr int BM = 256, BK = 64, HALF = 128, HTB = HALF * BK * 2  , STAGE_BYTES = 8 * HTB, NXCD = 8, WGM = 8;

__host__ __device__ __forceinline__ int lds_byte(int r, int c) { const int st = (r >> 4) * 2 + (c >> 5), rr = r & 15, cc = c & 31, ob = rr * 64 + cc * 2; return st * 1024 + (ob ^ (((ob >> 9) & 1) << 5)); }
__host__ __device__ __forceinline__ void stage_rc(int b, int& R, int& C) { const int st = b / 1024, sb = b % 1024, swz = sb ^ (((sb >> 9) & 1) << 5); R = (st >> 1) * 16 + swz / 64; C = (st & 1) * 32 + (swz % 64) / 2; }
__host__ __device__ __forceinline__ int perm32(int rho) { const int n = rho >> 4, i = rho & 15; return 8 * (i >> 2) + 4 * n + (i & 3); }

struct Unit { int pm, pn; };
struct Gemm { const bf16_t* A; const bf16_t* Bt; int M, N, K; };

struct StaticOrder {
    int nM, nN, nwg, G, c;
    __host__ __device__ void init(int M, int N, int G_, int c_) { nM = M / BM; nN = N / BM; nwg = nM * nN; G = G_; c = c_; }
    __host__ __device__ bool next(int i, Unit& u) const {
        const long L = (long)i * G + c; if (L >= nwg) return false;
        int wgid = (int)L; { const int q = nwg / NXCD, r = nwg % NXCD, xcd = wgid % NXCD, off = wgid / NXCD; wgid = (xcd < r ? xcd * (q + 1) : r * (q + 1) + (xcd - r) * q) + off; }
        const int nig = WGM * nN, gid = wgid / nig, fm = gid * WGM, gsz = (nM - fm) < WGM ? (nM - fm) : WGM;
        u.pm = fm + ((wgid % nig) % gsz); u.pn = (wgid % nig) / gsz; return true;
    }
    __device__ __forceinline__ void a_ready(const Unit&) const {}
    __device__ __forceinline__ void done(const Unit&) const {}
};

__device__ __forceinline__ unsigned cvt_pk_bf16(float lo, float hi) { unsigned r; asm volatile("v_cvt_pk_bf16_f32 %0, %1, %2" : "=v"(r) : "v"(lo), "v"(hi)); return r; }
typedef float f32x2 __attribute__((ext_vector_type(2)));
constexpr float KR_SCALE = 0.08838834764831845f;
constexpr float QA_SCALE = 0.125f * 1.4426950408889634f;
constexpr int ZLD = 3584;
__device__ __forceinline__ float row_rstd(const float* ssp, int row, int fq) {
    const f32x4 a = *(const f32x4*)(ssp + (size_t)row * 16 + 4 * fq); float s = (a[0] + a[1]) + (a[2] + a[3]); s += __shfl_xor(s, 16); s += __shfl_xor(s, 32); return 1.f / sqrtf(s * (1.f / 1024.f) + 1e-6f); }
__device__ __forceinline__ u32x4 pack8(const f32x4& a, const f32x4& b) { u32x4 w; w.x = cvt_pk_bf16(a[0], a[1]); w.y = cvt_pk_bf16(a[2], a[3]); w.z = cvt_pk_bf16(b[0], b[1]); w.w = cvt_pk_bf16(b[2], b[3]); return w; }
struct EpiIn {
    static constexpr bool PERM = true, AFTER_DRAIN = false, APERM = false;
    bf16_t* Z; const float* T64; const float* T32; float* pwk; float* pwv; const float* ss;
    __device__ __forceinline__ void operator()(const f32x4 (&acc)[2][2][4][2], const Unit& u, int wr, int wc, int fr, int fq) const {
        const int pn = u.pn; const int row0 = u.pm * BM + wr * 64 + fr;
        if ((pn >= 4 && pn < 8) || pn >= 12) {
            const int colb = pn * BM + wc * 32 + 8 * fq;
#pragma unroll
            for (int ai = 0; ai < 2; ++ai)
#pragma unroll
                for (int m = 0; m < 4; ++m) { const int row = row0 + ai * HALF + m * 16; bf16_t* rowp = Z + (size_t)row * ZLD + colb; const float rs = row_rstd(ss, row, fq);
#pragma unroll
                    for (int bj = 0; bj < 2; ++bj) { const f32x4 v0 = acc[ai][bj][m][0] * rs, v1 = acc[ai][bj][m][1] * rs;
                        *(u32x4*)(rowp + bj * HALF) = pack8(v0, v1);
                        if (pn >= 12) { const int t = row & 4095; if (t >= 2048) { float* o = pwv + ((size_t)((row >> 12) * 2048 + (t - 2048))) * 512 + (colb + bj * HALF - 3072); *(f32x4*)o = v0; *(f32x4*)(o + 4) = v1; } } } }
        } else {
            const bool hd128 = pn < 4;
            int featbase, d0, half, tstride; const float* T;
            if (hd128) { const int head = 2 * (pn & 1) + (wc >> 1); d0 = 32 * (wc & 1) + 8 * fq; featbase = (pn >> 1) * 512 + head * 128 + d0; half = 64; T = T64; tstride = 64; }
            else { const int head = 4 * (pn & 1) + wc; d0 = 8 * fq; featbase = 2048 + ((pn - 8) >> 1) * 512 + head * 64 + d0; half = 32; T = T32; tstride = 32; }
            const float sc0 = (pn < 2) ? 1.f : (pn < 4) ? KR_SCALE : (pn < 10) ? QA_SCALE : 1.f;
            const bool is_ka = (pn == 10 || pn == 11);
            f32x4 nc0, nc1, nc2, nc3, np;
            { const f32x4* tp = (const f32x4*)(T + ((size_t)(row0 & 4095) * tstride + d0) * 2); nc0 = tp[0]; nc1 = tp[1]; nc2 = tp[2]; nc3 = tp[3]; np = *(const f32x4*)(ss + (size_t)row0 * 16 + 4 * fq); }
#pragma unroll
            for (int ai = 0; ai < 2; ++ai)
#pragma unroll
                for (int m = 0; m < 4; ++m) { const int row = row0 + ai * HALF + m * 16; const int t = row & 4095;
                    const f32x4 cs0 = nc0, cs1 = nc1, cs2 = nc2, cs3 = nc3; const f32x4 pp = np;
                    if (ai * 4 + m < 7) { const int rown = row0 + ((ai * 4 + m + 1) >> 2) * HALF + ((ai * 4 + m + 1) & 3) * 16;
                        const f32x4* tp = (const f32x4*)(T + ((size_t)(rown & 4095) * tstride + d0) * 2); nc0 = tp[0]; nc1 = tp[1]; nc2 = tp[2]; nc3 = tp[3]; np = *(const f32x4*)(ss + (size_t)rown * 16 + 4 * fq); }
                    __builtin_amdgcn_sched_barrier(0);
                    float sq = (pp[0] + pp[1]) + (pp[2] + pp[3]); sq += __shfl_xor(sq, 16); sq += __shfl_xor(sq, 32); const float sc = sc0 / sqrtf(sq * (1.f / 1024.f) + 1e-6f);
                    const f32x4 xa0 = acc[ai][0][m][0], xa1 = acc[ai][0][m][1], xb0 = acc[ai][1][m][0], xb1 = acc[ai][1][m][1];
                    f32x4 o10, o11, o20, o21;
                    o10[0] = (xa0[0] * cs0[0] - xb0[0] * cs0[1]) * sc; o20[0] = (xb0[0] * cs0[0] + xa0[0] * cs0[1]) * sc;
                    o10[1] = (xa0[1] * cs0[2] - xb0[1] * cs0[3]) * sc; o20[1] = (xb0[1] * cs0[2] + xa0[1] * cs0[3]) * sc;
                    o10[2] = (xa0[2] * cs1[0] - xb0[2] * cs1[1]) * sc; o20[2] = (xb0[2] * cs1[0] + xa0[2] * cs1[1]) * sc;
                    o10[3] = (xa0[3] * cs1[2] - xb0[3] * cs1[3]) * sc; o20[3] = (xb0[3] * cs1[2] + xa0[3] * cs1[3]) * sc;
                    o11[0] = (xa1[0] * cs2[0] - xb1[0] * cs2[1]) * sc; o21[0] = (xb1[0] * cs2[0] + xa1[0] * cs2[1]) * sc;
                    o11[1] = (xa1[1] * cs2[2] - xb1[1] * cs2[3]) * sc; o21[1] = (xb1[1] * cs2[2] + xa1[1] * cs2[3]) * sc;
                    o11[2] = (xa1[2] * cs3[0] - xb1[2] * cs3[1]) * sc; o21[2] = (xb1[2] * cs3[0] + xa1[2] * cs3[1]) * sc;
                    o11[3] = (xa1[3] * cs3[2] - xb1[3] * cs3[3]) * sc; o21[3] = (xb1[3] * cs3[2] + xa1[3] * cs3[3]) * sc;
                    bf16_t* rowp = Z + (size_t)row * ZLD + featbase;
                    *(u32x4*)rowp = pack8(o10, o11); *(u32x4*)(rowp + half) = pack8(o20, o21);
                    if (is_ka && t >= 2048) { float* o = pwk + ((size_t)((row >> 12) * 2048 + (t - 2048))) * 512 + (featbase - 2560);
                        *(f32x4*)o = o10; *(f32x4*)(o + 4) = o11; *(f32x4*)(o + half) = o20; *(f32x4*)(o + half + 4) = o21; } }
        }
    }
};
struct EpiResid {
    static constexpr bool PERM = false, AFTER_DRAIN = false, APERM = false;
    const float* base; float* out;
    __device__ __forceinline__ void operator()(const f32x4 (&acc)[2][2][4][2], const Unit& u, int wr, int wc, int fr, int fq) const {
        const int col0 = u.pn * BM + wc * 32 + 4 * fq;
#pragma unroll
        for (int ai = 0; ai < 2; ++ai)
#pragma unroll
            for (int m = 0; m < 4; ++m) { const size_t off = (size_t)(u.pm * BM + ai * HALF + wr * 64 + m * 16 + fr) * 1024 + col0;
#pragma unroll
                for (int bj = 0; bj < 2; ++bj)
#pragma unroll
                    for (int n = 0; n < 2; ++n) { const f32x4 b = *(const f32x4*)(base + off + bj * HALF + n * 16); *(f32x4*)(out + off + bj * HALF + n * 16) = b + acc[ai][bj][m][n]; } }
    }
};
struct EpiResidNorm {
    static constexpr bool PERM = true, AFTER_DRAIN = false, APERM = false;
    bf16_t* xb; float* ss;
    __device__ __forceinline__ void operator()(const f32x4 (&acc)[2][2][4][2], const Unit& u, int wr, int wc, int fr, int fq) const {
        const int col0 = u.pn * BM + wc * 32 + 8 * fq;
#pragma unroll
        for (int ai = 0; ai < 2; ++ai) {
            u32x4 xin[2][4][2];
#pragma unroll
            for (int m = 0; m < 4; ++m)
#pragma unroll
                for (int bj = 0; bj < 2; ++bj) xin[ai][m][bj] = *(const u32x4*)(xb + (size_t)(u.pm * BM + ai * HALF + wr * 64 + m * 16 + fr) * 1024 + col0 + bj * HALF);
#pragma unroll
            for (int m = 0; m < 4; ++m) { const int row = u.pm * BM + ai * HALF + wr * 64 + m * 16 + fr; const size_t off = (size_t)row * 1024 + col0; float s = 0.f;
#pragma unroll
                for (int bj = 0; bj < 2; ++bj) { const u32x4 b = xin[ai][m][bj];
                    f32x4 x0, x1;
                    x0[0] = __uint_as_float(b.x << 16) + acc[ai][bj][m][0][0]; x0[1] = __uint_as_float(b.x & 0xffff0000u) + acc[ai][bj][m][0][1]; x0[2] = __uint_as_float(b.y << 16) + acc[ai][bj][m][0][2]; x0[3] = __uint_as_float(b.y & 0xffff0000u) + acc[ai][bj][m][0][3];
                    x1[0] = __uint_as_float(b.z << 16) + acc[ai][bj][m][1][0]; x1[1] = __uint_as_float(b.z & 0xffff0000u) + acc[ai][bj][m][1][1]; x1[2] = __uint_as_float(b.w << 16) + acc[ai][bj][m][1][2]; x1[3] = __uint_as_float(b.w & 0xffff0000u) + acc[ai][bj][m][1][3];
                    *(u32x4*)(xb + off + bj * HALF) = pack8(x0, x1);
                    s += (x0[0] * x0[0] + x0[1] * x0[1]) + (x0[2] * x0[2] + x0[3] * x0[3]) + (x1[0] * x1[0] + x1[1] * x1[1]) + (x1[2] * x1[2] + x1[3] * x1[3]); }
                s += __shfl_xor(s, 16); s += __shfl_xor(s, 32);
                if (fq == 0) ss[(size_t)row * 16 + u.pn * 4 + wc] = s; }
        }
    }
};
struct EpiUp {
    static constexpr bool PERM = true, AFTER_DRAIN = false, APERM = false;
    bf16_t* U; float* pconv;
    __device__ __forceinline__ void operator()(const f32x4 (&acc)[2][2][4][2], const Unit& u, int wr, int wc, int fr, int fq) const {
        const int row0 = u.pm * BM + wr * 64 + fr, col0 = u.pn * BM + wc * 32 + 8 * fq;
#pragma unroll
        for (int ai = 0; ai < 2; ++ai)
#pragma unroll
            for (int m = 0; m < 4; ++m) { const int row = row0 + ai * HALF + m * 16; bf16_t* rowp = U + (size_t)row * 5632 + col0; const int t = row & 4095;
#pragma unroll
                for (int bj = 0; bj < 2; ++bj) { const f32x4 v0 = acc[ai][bj][m][0], v1 = acc[ai][bj][m][1];
                    *(u32x4*)(rowp + bj * HALF) = pack8(v0, v1);
                    if (t >= 4094) { float* o = pconv + ((size_t)((row >> 12) * 2 + (t - 4094))) * 5632 + col0 + bj * HALF; *(f32x4*)o = v0; *(f32x4*)(o + 4) = v1; } } }
    }
};

#define PG8_DPP(oldv, src, ctrl) __builtin_bit_cast(float, __builtin_amdgcn_update_dpp(__builtin_bit_cast(int, (oldv)), __builtin_bit_cast(int, (src)), (ctrl), 0xf, 0xf, false))
__device__ __forceinline__ float silu_fast(float x) { return x * __builtin_amdgcn_rcpf(1.f + __expf(-x)); }
struct EpiUpConv {
    static constexpr bool PERM = true, AFTER_DRAIN = false, APERM = true;
    bf16_t* AB; float* ubnd; float* pconv; const float* cw; const float* cb; PG8_LAS float* exb; const float* ss;
    __device__ __forceinline__ void operator()(f32x4 (&acc)[2][2][4][2], const Unit& u, int wr, int wc, int fr, int fq) const {
        const int pn = u.pn, pm = u.pm, cloc = wc * 32 + 8 * fq, gcol = 128 * pn + cloc;
        PG8_LAS float* cwl = exb + 2048;
        { int fr_ = fr; asm volatile("" : "+v"(fr_));
          const int tid = ((wr * 4 + wc) * 4 + fq) * 16 + fr_;
#pragma unroll
          for (int k = 0; k < 2; ++k) { const int i = tid + 512 * k, which = i >> 8, col = i & 255; const int feat = col < 128 ? 128 * pn + col : 2816 + 128 * pn + (col - 128);
              cwl[i] = which < 3 ? cw[which * 5632 + feat] : cb[feat]; } }
#pragma unroll
        for (int ai = 0; ai < 2; ++ai)
#pragma unroll
            for (int m = 0; m < 4; ++m) { const float rs = row_rstd(ss, pm * BM + ai * HALF + wr * 64 + 4 * fr + m, fq);
#pragma unroll
                for (int bj = 0; bj < 2; ++bj)
#pragma unroll
                    for (int n = 0; n < 2; ++n) acc[ai][bj][m][n] *= rs; }
        if (fr == 15) {
#pragma unroll
            for (int ai = 0; ai < 2; ++ai)
#pragma unroll
                for (int bj = 0; bj < 2; ++bj)
#pragma unroll
                    for (int n = 0; n < 2; ++n) { PG8_LAS float* d = exb + ((2 * ai + wr) * 2) * 256 + bj * 128 + cloc + 4 * n; *(PG8_LAS f32x4*)d = acc[ai][bj][2][n]; *(PG8_LAS f32x4*)(d + 256) = acc[ai][bj][3][n]; }
            if (wr == 1) {
#pragma unroll
                for (int bj = 0; bj < 2; ++bj)
#pragma unroll
                    for (int n = 0; n < 2; ++n)
#pragma unroll
                        for (int k = 0; k < 2; ++k) { *(f32x4*)(ubnd + ((size_t)(pm * 4 + 2 + k) * 5632 + bj * 2816 + gcol + 4 * n)) = acc[1][bj][2 + k][n];
                            if ((pm & 15) == 15) *(f32x4*)(pconv + ((size_t)((pm >> 4) * 2 + k) * 5632 + bj * 2816 + gcol + 4 * n)) = acc[1][bj][2 + k][n]; }
            }
        }
        if (wr == 0 && fr == 0) {
#pragma unroll
            for (int bj = 0; bj < 2; ++bj)
#pragma unroll
                for (int n = 0; n < 2; ++n)
#pragma unroll
                    for (int k = 0; k < 2; ++k) *(f32x4*)(ubnd + ((size_t)(pm * 4 + k) * 5632 + bj * 2816 + gcol + 4 * n)) = acc[0][bj][k][n];
        }
        asm volatile("s_waitcnt vmcnt(0) lgkmcnt(0)" ::: "memory"); __builtin_amdgcn_s_barrier(); asm volatile("" ::: "memory");
#pragma unroll
        for (int ai = 0; ai < 2; ++ai) {
            const int s = 2 * ai + wr;
#pragma unroll
            for (int n = 0; n < 2; ++n) {
                const int cl = cloc + 4 * n;
                float o[1][4][4];
                f32x4 Bg0 = {0.f, 0.f, 0.f, 0.f}, Bg1 = Bg0, Bv0 = Bg0, Bv1 = Bg0;
                if (s > 0) { const PG8_LAS float* eb = exb + ((s - 1) * 2) * 256 + cl;
                    Bg0 = *(const PG8_LAS f32x4*)eb; Bg1 = *(const PG8_LAS f32x4*)(eb + 256); Bv0 = *(const PG8_LAS f32x4*)(eb + 128); Bv1 = *(const PG8_LAS f32x4*)(eb + 256 + 128); }
                {
                    const f32x4 wg0 = *(const PG8_LAS f32x4*)(cwl + cl), wg1 = *(const PG8_LAS f32x4*)(cwl + 256 + cl), wg2 = *(const PG8_LAS f32x4*)(cwl + 512 + cl), bg = *(const PG8_LAS f32x4*)(cwl + 768 + cl);
#pragma unroll
                    for (int i = 0; i < 4; ++i) {
                        const float g0 = acc[ai][0][0][n][i], g1 = acc[ai][0][1][n][i], g2 = acc[ai][0][2][n][i], g3 = acc[ai][0][3][n][i];
                        float og1 = Bg1[i], og0 = Bg0[i];
                        asm volatile("" : "+v"(og1), "+v"(og0));
                        const float pg3 = PG8_DPP(og1, g3, 0x111), pg2 = PG8_DPP(og0, g2, 0x111);
                        o[0][0][i] = silu_fast(bg[i] + wg2[i] * g0 + wg1[i] * pg3 + wg0[i] * pg2);
                        o[0][1][i] = silu_fast(bg[i] + wg2[i] * g1 + wg1[i] * g0 + wg0[i] * pg3);
                        o[0][2][i] = silu_fast(bg[i] + wg2[i] * g2 + wg1[i] * g1 + wg0[i] * g0);
                        o[0][3][i] = silu_fast(bg[i] + wg2[i] * g3 + wg1[i] * g2 + wg0[i] * g1);
                    }
                }
                {
                    const f32x4 wv0 = *(const PG8_LAS f32x4*)(cwl + 128 + cl), wv1 = *(const PG8_LAS f32x4*)(cwl + 256 + 128 + cl), wv2 = *(const PG8_LAS f32x4*)(cwl + 512 + 128 + cl), bv = *(const PG8_LAS f32x4*)(cwl + 768 + 128 + cl);
#pragma unroll
                    for (int i = 0; i < 4; ++i) {
                        const float v0 = acc[ai][1][0][n][i], v1 = acc[ai][1][1][n][i], v2 = acc[ai][1][2][n][i], v3 = acc[ai][1][3][n][i];
                        float ov1 = Bv1[i], ov0 = Bv0[i];
                        asm volatile("" : "+v"(ov1), "+v"(ov0));
                        const float pv3 = PG8_DPP(ov1, v3, 0x111), pv2 = PG8_DPP(ov0, v2, 0x111);
                        o[0][0][i] *= bv[i] + wv2[i] * v0 + wv1[i] * pv3 + wv0[i] * pv2;
                        o[0][1][i] *= bv[i] + wv2[i] * v1 + wv1[i] * v0 + wv0[i] * pv3;
                        o[0][2][i] *= bv[i] + wv2[i] * v2 + wv1[i] * v1 + wv0[i] * v0;
                        o[0][3][i] *= bv[i] + wv2[i] * v3 + wv1[i] * v2 + wv0[i] * v1;
                    }
                }
#pragma unroll
                for (int m = 0; m < 4; ++m) { const int row = pm * BM + ai * HALF + wr * 64 + 4 * fr + m;
                    typedef unsigned u32x2 __attribute__((ext_vector_type(2)));
                    u32x2 w; w.x = cvt_pk_bf16(o[0][m][0], o[0][m][1]); w.y = cvt_pk_bf16(o[0][m][2], o[0][m][3]);
                    *(u32x2*)(AB + (size_t)row * 2816 + gcol + 4 * n) = w; }
            }
        }
    }
};
template <class Epi, class Sched, bool ALIGN_EPI = false, bool SP2 = false>
__device__ __forceinline__ void gemm_phase(PG8_LAS unsigned char* lds, const Gemm g, const Sched& S, const Epi& E, int tid_in) {
    int tid_ = tid_in; asm volatile("" : "+v"(tid_));
    const int tid = tid_, wid = __builtin_amdgcn_readfirstlane(tid >> 6), lane = tid & 63, wr = wid >> 2, wc = wid & 3, fr = lane & 15, fq = lane >> 4;
    const int K = g.K, nt = K / BK;
    unsigned voffA[2], voffB[2];
#pragma unroll
    for (int i = 0; i < 2; ++i) { int R, C; stage_rc(tid * 16 + i * 8192, R, C); const int Rb = Epi::PERM ? ((R & ~31) + perm32(R & 31)) : R;
        const int Ra = Epi::APERM ? ((R & 64) | ((R & 15) << 2) | ((R >> 4) & 3)) : R;
        voffA[i] = (unsigned)(Ra * K + C) * 2u; voffB[i] = (unsigned)(Rb * K + C) * 2u; }
    const size_t kstep = (size_t)(BK * 2);
    const size_t hstep = (size_t)HALF * K * 2;
    const size_t tstep = 2 * hstep;
    const unsigned ldsw = (unsigned)wid * 1024u;
    const int aoff = lds_byte(wr * 64 + fr, fq * 8), boff = lds_byte(wc * 32 + fr, fq * 8);
#define PG8_SA(b, h) (((b) * 2 + (h)) * HTB)
#define PG8_SB(b, h) ((4 + (b) * 2 + (h)) * HTB)
#define PG8_STAGE(bufoff, gbase, voff) do { _Pragma("unroll") for (int _i = 0; _i < 2; ++_i) \
        __builtin_amdgcn_global_load_lds((const unsigned*)((const char*)(gbase) + (voff)[_i]), (PG8_LAS unsigned*)(lds + (bufoff) + ldsw + _i * 8192), 16, 0, 0); } while (0)
#define PG8_LDA(dst, b, h) do { _Pragma("unroll") for (int m = 0; m < 4; ++m) _Pragma("unroll") for (int k = 0; k < 2; ++k) dst[m][k] = *(const PG8_LAS bf16x8*)(lds + PG8_SA(b, h) + aoff + m * 2048 + k * 1024); } while (0)
#define PG8_LDB(dst, b, h) do { _Pragma("unroll") for (int n = 0; n < 2; ++n) _Pragma("unroll") for (int k = 0; k < 2; ++k) dst[n][k] = *(const PG8_LAS bf16x8*)(lds + PG8_SB(b, h) + boff + n * 2048 + k * 1024); } while (0)
#define PG8_MMA(ai, bj, At, Bt) do { __builtin_amdgcn_s_setprio(1); _Pragma("unroll") for (int m = 0; m < 4; ++m) _Pragma("unroll") for (int n = 0; n < 2; ++n) _Pragma("unroll") for (int k = 0; k < 2; ++k) \
        acc[ai][bj][m][n] = __builtin_amdgcn_mfma_f32_16x16x32_bf16(Bt[n][k], At[m][k], acc[ai][bj][m][n], 0, 0, 0); __builtin_amdgcn_s_setprio(0); } while (0)
#define PG8_WAIT_V(n) asm volatile("s_waitcnt vmcnt(" #n ")" ::: "memory")
#define PG8_WAIT_L(n) asm volatile("s_waitcnt lgkmcnt(" #n ")" ::: "memory")
#define PG8_BAR __builtin_amdgcn_s_barrier()
#define PG8_SCHED __builtin_amdgcn_sched_barrier(0)
    Unit cur, nxt; int ui = 0;
    if (!S.next(0, cur)) return;
    f32x4 acc[2][2][4][2];
#pragma unroll
    for (int a = 0; a < 2; ++a)
#pragma unroll
        for (int b = 0; b < 2; ++b)
#pragma unroll
            for (int m = 0; m < 4; ++m)
#pragma unroll
                for (int n = 0; n < 2; ++n) acc[a][b][m][n] = (f32x4){0.f, 0.f, 0.f, 0.f};
    bf16x8 At[4][2], B0[2][2], B1[2][2];
    const char* cA = (const char*)g.A + (size_t)cur.pm * tstep; const char* cB = (const char*)g.Bt + (size_t)cur.pn * tstep;
    S.a_ready(cur);
    if constexpr (SP2) {
        PG8_STAGE(PG8_SB(0, 0), cB, voffB); PG8_STAGE(PG8_SB(0, 1), cB + hstep, voffB); PG8_STAGE(PG8_SA(0, 0), cA, voffA); PG8_STAGE(PG8_SA(0, 1), cA + hstep, voffA);
        if (wr == 1) PG8_BAR;
        PG8_WAIT_V(2); PG8_BAR;
        PG8_STAGE(PG8_SB(1, 0), cB + kstep, voffB); PG8_STAGE(PG8_SA(1, 0), cA + kstep, voffA); PG8_STAGE(PG8_SB(1, 1), cB + hstep + kstep, voffB);
        PG8_WAIT_V(6); PG8_BAR;
    } else {
        PG8_STAGE(PG8_SB(0, 0), cB, voffB); PG8_STAGE(PG8_SA(0, 0), cA, voffA); PG8_STAGE(PG8_SB(0, 1), cB + hstep, voffB); PG8_STAGE(PG8_SA(0, 1), cA + hstep, voffA);
        if (wr == 1) PG8_BAR;
        PG8_WAIT_V(4); PG8_BAR;
        PG8_STAGE(PG8_SB(1, 0), cB + kstep, voffB); PG8_STAGE(PG8_SA(1, 0), cA + kstep, voffA); PG8_STAGE(PG8_SB(1, 1), cB + hstep + kstep, voffB);
        PG8_WAIT_V(6); PG8_BAR;
    }
    for (;;) {
        const bool has_next = S.next(ui + 1, nxt);
        const char* nA = has_next ? (const char*)g.A + (size_t)nxt.pm * tstep : cA; const char* nB = has_next ? (const char*)g.Bt + (size_t)nxt.pn * tstep : cB;
        for (int t = 0; t < nt; t += 2) {
            const bool last = (t == nt - 2);
            const char* a1 = cA + (size_t)(t + 1) * kstep;
            const char* a2 = last ? nA : cA + (size_t)(t + 2) * kstep; const char* b2 = last ? nB : cB + (size_t)(t + 2) * kstep;
            const char* a3 = a2 + kstep; const char* b3 = b2 + kstep;
            if (last && has_next) S.a_ready(nxt);
            if constexpr (SP2) {
            int pre_ = __builtin_amdgcn_readfirstlane((int)(t == 0) & (int)(ui > 0)); asm volatile("" : "+s"(pre_));
            const bool pre = pre_ != 0;
            PG8_LDB(B0, 0, 0); PG8_LDB(B1, 0, 1); PG8_SCHED; PG8_LDA(At, 0, 0); if (!pre) { PG8_STAGE(PG8_SA(1, 1), a1 + hstep, voffA); PG8_WAIT_V(8); }
            PG8_WAIT_L(0); PG8_BAR; PG8_MMA(0, 0, At, B0); PG8_MMA(0, 1, At, B1); PG8_BAR; PG8_SCHED;
            PG8_LDA(At, 0, 1); PG8_STAGE(PG8_SB(0, 0), b2, voffB); PG8_STAGE(PG8_SB(0, 1), b2 + hstep, voffB); PG8_STAGE(PG8_SA(0, 0), a2, voffA);
            if (!pre) PG8_WAIT_V(8);
            PG8_WAIT_L(0); PG8_BAR; PG8_MMA(1, 0, At, B0); PG8_MMA(1, 1, At, B1); PG8_BAR; PG8_SCHED;
            PG8_LDB(B0, 1, 0); PG8_LDB(B1, 1, 1); PG8_SCHED; PG8_LDA(At, 1, 0); PG8_STAGE(PG8_SA(0, 1), a2 + hstep, voffA);
            if (!pre) PG8_WAIT_V(8);
            PG8_WAIT_L(0); PG8_BAR; PG8_MMA(0, 0, At, B0); PG8_MMA(0, 1, At, B1); PG8_BAR; PG8_SCHED;
            PG8_LDA(At, 1, 1); PG8_STAGE(PG8_SB(1, 0), b3, voffB); PG8_STAGE(PG8_SB(1, 1), b3 + hstep, voffB); PG8_STAGE(PG8_SA(1, 0), a3, voffA);
            PG8_WAIT_V(8); PG8_WAIT_L(0); PG8_BAR; PG8_MMA(1, 0, At, B0); PG8_MMA(1, 1, At, B1); PG8_BAR; PG8_SCHED;
            } else {
            PG8_LDB(B0, 0, 0); PG8_SCHED; PG8_LDA(At, 0, 0); PG8_STAGE(PG8_SA(1, 1), a1 + hstep, voffA);
            PG8_WAIT_L(8); PG8_BAR; PG8_WAIT_L(0); PG8_MMA(0, 0, At, B0); PG8_BAR; PG8_SCHED;
            PG8_LDB(B1, 0, 1); PG8_STAGE(PG8_SB(0, 0), b2, voffB);
            PG8_BAR; PG8_WAIT_L(0); PG8_MMA(0, 1, At, B1); PG8_BAR;
            PG8_LDA(At, 0, 1); PG8_STAGE(PG8_SA(0, 0), a2, voffA);
            PG8_BAR; PG8_WAIT_L(0); PG8_MMA(1, 0, At, B0); PG8_BAR; PG8_SCHED;
            PG8_STAGE(PG8_SB(0, 1), b2 + hstep, voffB);
            PG8_WAIT_V(6); PG8_BAR; PG8_MMA(1, 1, At, B1); PG8_BAR;
            PG8_LDB(B0, 1, 0); PG8_SCHED; PG8_LDA(At, 1, 0); PG8_STAGE(PG8_SA(0, 1), a2 + hstep, voffA);
            PG8_WAIT_L(8); PG8_BAR; PG8_WAIT_L(0); PG8_MMA(0, 0, At, B0); PG8_BAR; PG8_SCHED;
            PG8_LDB(B1, 1, 1); PG8_STAGE(PG8_SB(1, 0), b3, voffB);
            PG8_BAR; PG8_WAIT_L(0); PG8_MMA(0, 1, At, B1); PG8_BAR;
            PG8_LDA(At, 1, 1); PG8_STAGE(PG8_SA(1, 0), a3, voffA);
            PG8_BAR; PG8_WAIT_L(0); PG8_MMA(1, 0, At, B0); PG8_BAR; PG8_SCHED;
            PG8_STAGE(PG8_SB(1, 1), b3 + hstep, voffB);
            PG8_WAIT_V(6); PG8_BAR; PG8_MMA(1, 1, At, B1); PG8_BAR;
            }
        }
        if constexpr (ALIGN_EPI) { if (wr == 0) PG8_BAR; }
        if constexpr (SP2 && ALIGN_EPI) { if (has_next) PG8_STAGE(PG8_SA(1, 1), nA + kstep + hstep, voffA); }
        if constexpr (!Epi::AFTER_DRAIN) { E(acc, cur, wr, wc, fr, fq); S.done(cur); }
        if (!has_next) break;
#pragma unroll
        for (int a = 0; a < 2; ++a)
#pragma unroll
            for (int b = 0; b < 2; ++b)
#pragma unroll
                for (int m = 0; m < 4; ++m)
#pragma unroll
                    for (int n = 0; n < 2; ++n) acc[a][b][m][n] = (f32x4){0.f, 0.f, 0.f, 0.f};
        cur = nxt; cA = nA; cB = nB; ++ui;
        if constexpr (ALIGN_EPI) { if (wr == 1) PG8_BAR; }
    }
    PG8_WAIT_V(0);
    if constexpr (!ALIGN_EPI) { if (wr == 0) PG8_BAR; }
    PG8_BAR;
    if constexpr (Epi::AFTER_DRAIN) { E.fused(acc, cur, wr, wc, fr, fq, lds, wid, lane); S.done(cur); }
#undef PG8_SA
#undef PG8_SB
#undef PG8_STAGE
#undef PG8_LDA
#undef PG8_LDB
#undef PG8_MMA
#undef PG8_WAIT_V
#undef PG8_WAIT_L
#undef PG8_BAR
#undef PG8_SCHED
}
}
#define GAS __attribute__((address_space(1)))
#define LAS __attribute__((address_space(3)))
typedef unsigned short bf16;
typedef unsigned v4u __attribute__((ext_vector_type(4)));
typedef float f32x4 __attribute__((ext_vector_type(4)));
typedef short bf16x8 __attribute__((ext_vector_type(8)));
typedef GAS unsigned gu32;
typedef GAS unsigned long long gu64;
#define RLX_AGENT __ATOMIC_RELAXED, __HIP_MEMORY_SCOPE_AGENT
#define LDS_WAIT() asm volatile("s_waitcnt lgkmcnt(0)" ::: "memory")
#define VM_WAIT() asm volatile("s_waitcnt vmcnt(0)" ::: "memory")
__device__ __forceinline__ unsigned long long rt() { return __builtin_amdgcn_s_memrealtime(); }
__device__ __forceinline__ unsigned f2bf(float f) { unsigned u = __builtin_bit_cast(unsigned, f); return (u + 0x7fffu + ((u >> 16) & 1u)) >> 16; }
__device__ __forceinline__ unsigned pk2(float lo, float hi) { return f2bf(lo) | (f2bf(hi) << 16); }
#define XB_TMO      128
#define XB_XCNT(j)  (256  + 64 * (j))
#define XB_XSUB(j)  (1280 + 64 * (j))
#define XB_XGEN(j)  (2304 + 64 * (j))
#define XB_TOP      3328
#define XB_TOPGEN   3392
#define XCD_BAR_WORDS 3456
#define XB_SPIN_CAP (1u << 18)

__device__ __forceinline__ unsigned xb_ld(unsigned* p)              { return __hip_atomic_load(p, __ATOMIC_RELAXED, __HIP_MEMORY_SCOPE_AGENT); }
__device__ __forceinline__ unsigned xb_add(unsigned* p, unsigned v) { return __hip_atomic_fetch_add(p, v, __ATOMIC_RELAXED, __HIP_MEMORY_SCOPE_AGENT); }
__device__ __forceinline__ unsigned xb_xcc_id() { return (unsigned)__builtin_amdgcn_s_getreg((3 << 11) | 20) & 0xFu; }
#define XB_SPIN(cond, bar) do { unsigned _sp = 0; while (cond) { __builtin_amdgcn_s_sleep(1); \
    if ((++_sp & 255u) == 0u) { if (xb_ld(&(bar)[XB_TMO])) break; if (_sp > XB_SPIN_CAP) { atomicAdd(&(bar)[XB_TMO], 1u); break; } } } } while (0)

struct XcdBarrier {
    unsigned* bar; unsigned x;
    volatile LAS unsigned* st;
};

__device__ __forceinline__ XcdBarrier xcd_barrier_post(unsigned* bar, volatile LAS unsigned* st) {
    XcdBarrier b; b.bar = bar; b.x = xb_xcc_id(); b.st = st;
    if (threadIdx.x == 0) (void)xb_add(&bar[XB_XCNT(b.x)], 1u);
    return b;
}
__device__ __forceinline__ void xcd_barrier_complete(unsigned* bar, unsigned x, unsigned& nloc, unsigned& nx) {
    const unsigned G = gridDim.x * gridDim.y * gridDim.z;
    unsigned sum, cnt, mine, sp = 0u;
    for (;;) {
        sum = 0u; cnt = 0u; mine = 0u;
#pragma unroll
        for (unsigned j = 0; j < 16; ++j) { const unsigned c = xb_ld(&bar[XB_XCNT(j)]); sum += c; cnt += (c > 0u) ? 1u : 0u; mine = (j == x) ? c : mine; }
        if (sum == G) break;
        __builtin_amdgcn_s_sleep(1);
        if ((++sp & 255u) == 0u) { if (xb_ld(&bar[XB_TMO])) break; if (sp > XB_SPIN_CAP) { atomicAdd(&bar[XB_TMO], 1u); break; } }
    }
    nloc = mine > 0u ? mine : 1u; nx = cnt > 0u ? cnt : 1u;
}

__device__ __forceinline__ void xcd_barrier(const XcdBarrier& b, int tid) {
    asm volatile("s_waitcnt vmcnt(0)" ::: "memory");
    __syncthreads();
    if (tid == 0) {
        unsigned* bar = b.bar; asm volatile("" : "+s"(bar));
        __builtin_amdgcn_s_waitcnt(0);
        unsigned bx_ = b.x; asm volatile("" : "+s"(bx_));
        unsigned nloc = b.st[0], nx = b.st[1];
        if (nloc == 0u) { xcd_barrier_complete(bar, bx_, nloc, nx); b.st[0] = nloc; b.st[1] = nx; }
        const unsigned old = xb_add(&bar[XB_XSUB(bx_)], 1u);
        const unsigned gen = old / nloc;
        if (old + 1u == (gen + 1u) * nloc) {
            __builtin_amdgcn_fence(__ATOMIC_RELEASE, "agent");
            asm volatile("s_waitcnt vmcnt(0)" ::: "memory");
            const unsigned og = xb_add(&bar[XB_TOP], 1u);
            const unsigned tg = og / nx;
            if (og + 1u == (tg + 1u) * nx) xb_add(&bar[XB_TOPGEN], 1u);
            else XB_SPIN(xb_ld(&bar[XB_TOPGEN]) == tg, bar);
            __builtin_amdgcn_fence(__ATOMIC_ACQUIRE, "agent");
            xb_add(&bar[XB_XGEN(bx_)], 1u);
            asm volatile("s_waitcnt vmcnt(0)" ::: "memory");
        } else {
            XB_SPIN(xb_ld(&bar[XB_XGEN(bx_)]) == gen, bar);
            __builtin_amdgcn_fence(__ATOMIC_ACQUIRE, "agent");
            asm volatile("s_waitcnt vmcnt(0)" ::: "memory");
        }
    }
    __syncthreads();
}
constexpr int NWAVES = 8;
constexpr int DM = 1024, NBATCH = 4, SEQ = 4096, DEPTH = 4, DBATCH = 32, DSEQ = 4, PAST = 8192;
constexpr int MP = NBATCH * SEQ, MS = DBATCH * DSEQ;
constexpr int DIN = 3584, DFF = 2816, DUP = 2 * DFF, WCTX = 2048;
constexpr int C_QR = 0, C_KR = 512, C_VR = 1024, C_GR = 1536, C_QA = 2048, C_KA = 2560, C_VA = 3072;
constexpr float EPS = 1e-6f;
constexpr int NPOS = SEQ + DSEQ;

__host__ __device__ __forceinline__ int in_feature(int nrow) {
    const int pn = nrow >> 8, tc = nrow & 255, bj = tc >> 7, j = tc & 127;
    if (pn < 4) return (pn >> 1) * 512 + (2 * (pn & 1) + (j >> 6)) * 128 + (j & 63) + 64 * bj;
    if (pn >= 8 && pn < 12) return 2048 + ((pn - 8) >> 1) * 512 + (4 * (pn & 1) + (j >> 5)) * 64 + (j & 31) + 32 * bj;
    return nrow;
}

__host__ __device__ __forceinline__ int up_feature(int nrow) { const int pn = nrow >> 8, tc = nrow & 255; return tc < 128 ? 128 * pn + tc : 2816 + 128 * pn + (tc - 128); }

constexpr size_t MiB = 1u << 20;
constexpr size_t WS_CTL = 0, CTL_ZERO_BYTES = 1 * MiB;
constexpr size_t WS_T64 = 1 * MiB;
constexpr size_t WS_T32 = 4 * MiB;
constexpr size_t WS_SS1 = 356 * MiB, WS_SS2 = 358 * MiB;
constexpr size_t WS_WIN = 6 * MiB;
constexpr size_t WS_WOUT = 34 * MiB;
constexpr size_t WS_WUP = 42 * MiB;
constexpr size_t WS_WDN = 86 * MiB;
constexpr size_t WS_XRES = 108 * MiB;
constexpr size_t WS_HB = 172 * MiB;
constexpr size_t WS_ZB = 204 * MiB;
constexpr size_t WS_CATB = 316 * MiB;
constexpr size_t WS_UB = 348 * MiB;
constexpr size_t WS_AB = 524 * MiB;
constexpr size_t WS_OG = 612 * MiB;
constexpr size_t WS_LSE = 660 * MiB;
constexpr size_t WS_UPD = 662 * MiB;
constexpr size_t WS_ST = 694 * MiB;
constexpr size_t WS_SMP = 710 * MiB;
constexpr size_t WS_OPT_END = 718 * MiB;
constexpr size_t WS_NAIVE = 720 * MiB;
constexpr size_t SM_X = 0;
constexpr size_t SM_HB = 512 * 1024;
constexpr size_t SM_ZB = 768 * 1024;
constexpr size_t SM_CATB = 1792 * 1024;
constexpr size_t SM_U = 2048 * 1024;
constexpr size_t SM_AB = 5120 * 1024;
constexpr size_t SM_SS = 6144 * 1024;
constexpr int CW_TMO = 0, CW_CODE = 1, CW_BAR = 4096;

constexpr int RING_OFF = 0, RING_BYTES = 131072;
constexpr int LDSCTL_OFF = RING_BYTES, MISC_OFF = LDSCTL_OFF + 320;
constexpr int EXB_OFF = 132096;
constexpr int LDS_BYTES = 147456;
static_assert(MISC_OFF + 128 <= EXB_OFF && EXB_OFF + 8192 + 4096 <= LDS_BYTES, "LDS map");
struct Frame {
    LAS unsigned char* lds;
    volatile LAS unsigned* MISC;
    gu32* ctl;
    int tid, lane, wave;
    int vcu, G;
    unsigned char* ws;
};
struct Args { const float* in[16]; float* out; unsigned char* ws; int layer, pad; };

__device__ __forceinline__ float wave_sum(float v) {
#pragma unroll
    for (int o = 1; o < 64; o <<= 1) v += __shfl_xor(v, o);
    return v;
}
__device__ __forceinline__ float silu_f(float x) { return x / (1.f + __expf(-x)); }

struct P0Item { const float* src; bf16* dst; const float* ksc; int K, N; };
__device__ __forceinline__ void p0_item_load(const P0Item& I, f32x4 (&v)[8], int lane) {
#pragma unroll
    for (int i = 0; i < 8; ++i) v[i] = *(const GAS f32x4*)(I.src + (size_t)((lane >> 3) + 8 * i) * I.N + 4 * (lane & 7));
}
__device__ __forceinline__ void p0_item_store(const P0Item& I, const f32x4 (&v)[8], LAS float* scr, int lane) {
#pragma unroll
    for (int i = 0; i < 8; ++i) { const int kk = (lane >> 3) + 8 * i; const float sc = I.ksc ? I.ksc[kk] : 1.f; LAS float* d = scr + kk * 33 + 4 * (lane & 7);
        d[0] = v[i][0] * sc; d[1] = v[i][1] * sc; d[2] = v[i][2] * sc; d[3] = v[i][3] * sc; }
    LDS_WAIT(); asm volatile("" ::: "memory");
    const int c = lane & 7;
#pragma unroll
    for (int j = 0; j < 4; ++j) { const int n = (lane >> 3) + 8 * j; const LAS float* s = scr + (8 * c) * 33 + n;
        v4u o; o.x = pk2(s[0 * 33], s[1 * 33]); o.y = pk2(s[2 * 33], s[3 * 33]); o.z = pk2(s[4 * 33], s[5 * 33]); o.w = pk2(s[6 * 33], s[7 * 33]);
        *(GAS v4u*)(I.dst + (size_t)n * I.K + 8 * c) = o; }
    LDS_WAIT(); asm volatile("" ::: "memory");
}
__device__ __forceinline__ void p0_prologue(Frame& F, const float* w_in, const float* w_out, const float* w_up, const float* w_dn, const float* n1w, const float* n2w, const float* xp) {
    LAS float* scr = (LAS float*)(F.lds + RING_OFF + F.wave * 16384);
    const int gw = F.vcu * NWAVES + F.wave, NGW = F.G * NWAVES;
    constexpr int I_IN = (DM / 64) * (DIN / 32), I_OUT = (DM / 64) * (DM / 32), I_UP = (DM / 64) * (DUP / 32), I_DN = (DFF / 64) * (DM / 32);
    constexpr int I_L = I_IN + I_OUT + I_UP + I_DN;
    bf16* WIN = (bf16*)(F.ws + WS_WIN); bf16* WOUT = (bf16*)(F.ws + WS_WOUT); bf16* WUP = (bf16*)(F.ws + WS_WUP); bf16* WDN = (bf16*)(F.ws + WS_WDN);
    auto resolve = [&](int it) -> P0Item {
        const int l = it / I_L; int r = it % I_L; P0Item I;
        if (r < I_IN) { const int nblk = DIN / 32, kb = r / nblk, nb = r % nblk; I.K = DM; I.N = DIN; I.src = w_in + (size_t)l * DM * DIN + (size_t)(64 * kb) * DIN + in_feature(32 * nb); I.dst = WIN + (size_t)l * DIN * DM + (size_t)(32 * nb) * DM + 64 * kb; I.ksc = n1w + (size_t)l * DM + 64 * kb; return I; } r -= I_IN;
        if (r < I_OUT) { const int nblk = DM / 32, kb = r / nblk, nb = r % nblk; I.K = DM; I.N = DM; I.src = w_out + (size_t)l * DM * DM + (size_t)(64 * kb) * DM + 32 * nb; I.dst = WOUT + (size_t)l * DM * DM + (size_t)(32 * nb) * DM + 64 * kb; I.ksc = nullptr; return I; } r -= I_OUT;
        if (r < I_UP) { const int nblk = DUP / 32, kb = r / nblk, nb = r % nblk; I.K = DM; I.N = DUP; I.src = w_up + (size_t)l * DM * DUP + (size_t)(64 * kb) * DUP + up_feature(32 * nb); I.dst = WUP + (size_t)l * DUP * DM + (size_t)(32 * nb) * DM + 64 * kb; I.ksc = n2w + (size_t)l * DM + 64 * kb; return I; } r -= I_UP;
        { const int nblk = DM / 32, kb = r / nblk, nb = r % nblk; I.K = DFF; I.N = DM; I.src = w_dn + (size_t)l * DFF * DM + (size_t)(64 * kb) * DM + 32 * nb; I.dst = WDN + (size_t)l * DM * DFF + (size_t)(32 * nb) * DFF + 64 * kb; I.ksc = nullptr; return I; }
    };
    if (gw < DEPTH * I_L) {
        P0Item cur = resolve(gw); f32x4 v[8]; p0_item_load(cur, v, F.lane);
#pragma unroll 1
        for (int it = gw; it < DEPTH * I_L; it += NGW) {
            const bool more = it + NGW < DEPTH * I_L; P0Item nxt = cur; f32x4 vn[8];
            if (more) { nxt = resolve(it + NGW); p0_item_load(nxt, vn, F.lane); }
            p0_item_store(cur, v, scr, F.lane);
            if (more) { cur = nxt;
#pragma unroll
                for (int i = 0; i < 8; ++i) v[i] = vn[i]; }
        }
    }
    { bf16* XB = (bf16*)(F.ws + WS_HB); float* SS1 = (float*)(F.ws + WS_SS1);
      for (int m = gw; m < MP; m += NGW) { const GAS f32x4* xr = (const GAS f32x4*)(xp + (size_t)m * DM) + F.lane; GAS unsigned long long* o8 = (GAS unsigned long long*)(XB + (size_t)m * DM) + F.lane; float s = 0.f;
#pragma unroll
          for (int j = 0; j < 4; ++j) { const f32x4 v = xr[64 * j]; s += (v.x * v.x + v.y * v.y) + (v.z * v.z + v.w * v.w); o8[64 * j] = (unsigned long long)pk2(v.x, v.y) | ((unsigned long long)pk2(v.z, v.w) << 32); }
          s = wave_sum(s); if (F.lane < 16) SS1[(size_t)m * 16 + F.lane] = (F.lane == 0) ? s : 0.f; } }
    float* T64 = (float*)(F.ws + WS_T64); float* T32 = (float*)(F.ws + WS_T32);
    const int gt = (F.vcu * NWAVES + F.wave) * 64 + F.lane, NT = F.G * NWAVES * 64;
    for (int i = gt; i < NPOS * 96; i += NT) {
        const int p = i / 96, k = i % 96; const float pos = (float)(p < SEQ ? p : PAST + (p - SEQ));
        float inv; float* dst;
        if (k < 64) { inv = powf(10000.f, -(float)k / 64.f); dst = T64 + ((size_t)p * 64 + k) * 2; }
        else { inv = powf(10000.f, -(float)(k - 64) / 32.f); dst = T32 + ((size_t)p * 32 + (k - 64)) * 2; }
        float sn, cs; sincosf(pos * inv, &sn, &cs); dst[0] = cs; dst[1] = sn;
    }
}
__device__ __forceinline__ void rms_row_to_bf16(const float* xrow, const float* w, bf16* orow, int lane) {
    const GAS f32x4* xr = (const GAS f32x4*)xrow + lane; const GAS f32x4* wr = (const GAS f32x4*)w + lane;
    f32x4 v[4]; float s = 0.f;
#pragma unroll
    for (int j = 0; j < 4; ++j) { v[j] = xr[64 * j]; s += (v[j].x * v[j].x + v[j].y * v[j].y) + (v[j].z * v[j].z + v[j].w * v[j].w); }
    const float rstd = 1.f / sqrtf(wave_sum(s) * (1.f / DM) + EPS);
    GAS unsigned long long* o8 = (GAS unsigned long long*)orow + lane;
#pragma unroll
    for (int j = 0; j < 4; ++j) { const f32x4 ww = wr[64 * j];
        o8[64 * j] = (unsigned long long)pk2(v[j].x * rstd * ww.x, v[j].y * rstd * ww.y) | ((unsigned long long)pk2(v[j].z * rstd * ww.z, v[j].w * rstd * ww.w) << 32); }
}
__device__ __forceinline__ void rms_row_to_f32(const float* xrow, const float* w, float* orow, int lane) {
    const GAS f32x4* xr = (const GAS f32x4*)xrow + lane; const GAS f32x4* wr = (const GAS f32x4*)w + lane;
    f32x4 v[4]; float s = 0.f;
#pragma unroll
    for (int j = 0; j < 4; ++j) { v[j] = xr[64 * j]; s += (v[j].x * v[j].x + v[j].y * v[j].y) + (v[j].z * v[j].z + v[j].w * v[j].w); }
    const float rstd = 1.f / sqrtf(wave_sum(s) * (1.f / DM) + EPS);
    GAS f32x4* o = (GAS f32x4*)orow + lane;
#pragma unroll
    for (int j = 0; j < 4; ++j) { const f32x4 ww = wr[64 * j]; o[64 * j] = (v[j] * rstd) * ww; }
}
__device__ __forceinline__ void norm_phase(Frame& F, const float* xp, const float* xs, const float* w) {
    const int gw = F.vcu * NWAVES + F.wave, NGW = F.G * NWAVES;
    bf16* HB = (bf16*)(F.ws + WS_HB); bf16* HS = (bf16*)(F.ws + WS_SMP + SM_HB);
    for (int m = gw; m < MP; m += NGW) rms_row_to_bf16(xp + (size_t)m * DM, w, HB + (size_t)m * DM, F.lane);
    for (int m = NGW - 1 - gw; m < MS; m += NGW) rms_row_to_bf16(xs + (size_t)m * DM, w, HS + (size_t)m * DM, F.lane);
}
__device__ __forceinline__ void rms_rowb_to_f32(const bf16* xrow, const float* w, float* orow, int lane) {
    const GAS unsigned long long* xr = (const GAS unsigned long long*)xrow + lane; const GAS f32x4* wr = (const GAS f32x4*)w + lane;
    f32x4 v[4]; float s = 0.f;
#pragma unroll
    for (int j = 0; j < 4; ++j) { const unsigned long long q = xr[64 * j]; v[j].x = __uint_as_float((unsigned)q << 16); v[j].y = __uint_as_float((unsigned)q & 0xffff0000u); v[j].z = __uint_as_float((unsigned)(q >> 32) << 16); v[j].w = __uint_as_float((unsigned)(q >> 32) & 0xffff0000u);
        s += (v[j].x * v[j].x + v[j].y * v[j].y) + (v[j].z * v[j].z + v[j].w * v[j].w); }
    const float rstd = 1.f / sqrtf(wave_sum(s) * (1.f / DM) + EPS);
    GAS f32x4* o = (GAS f32x4*)orow + lane;
#pragma unroll
    for (int j = 0; j < 4; ++j) { const f32x4 ww = wr[64 * j]; o[64 * j] = (v[j] * rstd) * ww; }
}
__device__ __forceinline__ void final_norm_phase(Frame& F, const bf16* xpb, const float* xs, const float* w, float* yp, float* ys) {
    const int gw = F.vcu * NWAVES + F.wave, NGW = F.G * NWAVES;
    for (int m = gw; m < MP; m += NGW) rms_rowb_to_f32(xpb + (size_t)m * DM, w, yp + (size_t)m * DM, F.lane);
    for (int m = NGW - 1 - gw; m < MS; m += NGW) rms_row_to_f32(xs + (size_t)m * DM, w, ys + (size_t)m * DM, F.lane);
}
__device__ __forceinline__ void conv_phase_prompt(Frame& F, const float* cw, const float* cb) {
    const bf16* UB = (const bf16*)(F.ws + WS_UB); bf16* AB = (bf16*)(F.ws + WS_AB);
    const int gt = (F.vcu * NWAVES + F.wave) * 64 + F.lane, NT = F.G * NWAVES * 64;
    constexpr int NCH = DFF / 8, NITEM = (MP / 16) * NCH;
    for (int it = gt; it < NITEM; it += NT) {
        const int rb = it / NCH, c8 = it % NCH, r0 = rb * 16, c0 = c8 * 8;
        float wg[3][8], wv[3][8], bg[8], bv[8];
#pragma unroll
        for (int j = 0; j < 3; ++j)
#pragma unroll
            for (int q = 0; q < 2; ++q) { const f32x4 a = *(const GAS f32x4*)(cw + (size_t)j * DUP + c0 + 4 * q), b = *(const GAS f32x4*)(cw + (size_t)j * DUP + DFF + c0 + 4 * q);
#pragma unroll
                for (int e = 0; e < 4; ++e) { wg[j][4 * q + e] = a[e]; wv[j][4 * q + e] = b[e]; } }
#pragma unroll
        for (int q = 0; q < 2; ++q) { const f32x4 a = *(const GAS f32x4*)(cb + c0 + 4 * q), b = *(const GAS f32x4*)(cb + DFF + c0 + 4 * q);
#pragma unroll
            for (int e = 0; e < 4; ++e) { bg[4 * q + e] = a[e]; bv[4 * q + e] = b[e]; } }
        float g2[8], g1[8], v2[8], v1[8];
        const bool has_prev = (r0 & 4095) != 0;
        {
            v4u a2 = {0u, 0u, 0u, 0u}, a1 = a2, b2 = a2, b1 = a2;
            if (has_prev) { a2 = *(const GAS v4u*)(UB + (size_t)(r0 - 2) * DUP + c0); a1 = *(const GAS v4u*)(UB + (size_t)(r0 - 1) * DUP + c0);
                            b2 = *(const GAS v4u*)(UB + (size_t)(r0 - 2) * DUP + DFF + c0); b1 = *(const GAS v4u*)(UB + (size_t)(r0 - 1) * DUP + DFF + c0); }
#pragma unroll
            for (int e = 0; e < 4; ++e) { g2[2 * e] = __uint_as_float(a2[e] << 16); g2[2 * e + 1] = __uint_as_float(a2[e] & 0xffff0000u); g1[2 * e] = __uint_as_float(a1[e] << 16); g1[2 * e + 1] = __uint_as_float(a1[e] & 0xffff0000u);
                                          v2[2 * e] = __uint_as_float(b2[e] << 16); v2[2 * e + 1] = __uint_as_float(b2[e] & 0xffff0000u); v1[2 * e] = __uint_as_float(b1[e] << 16); v1[2 * e + 1] = __uint_as_float(b1[e] & 0xffff0000u); }
        }
#pragma unroll 4
        for (int i = 0; i < 16; ++i) {
            const v4u a0 = *(const GAS v4u*)(UB + (size_t)(r0 + i) * DUP + c0), b0 = *(const GAS v4u*)(UB + (size_t)(r0 + i) * DUP + DFF + c0);
            float g0[8], v0[8], o[8];
#pragma unroll
            for (int e = 0; e < 4; ++e) { g0[2 * e] = __uint_as_float(a0[e] << 16); g0[2 * e + 1] = __uint_as_float(a0[e] & 0xffff0000u); v0[2 * e] = __uint_as_float(b0[e] << 16); v0[2 * e + 1] = __uint_as_float(b0[e] & 0xffff0000u); }
#pragma unroll
            for (int e = 0; e < 8; ++e) { const float gg = bg[e] + wg[0][e] * g2[e] + wg[1][e] * g1[e] + wg[2][e] * g0[e]; const float vv = bv[e] + wv[0][e] * v2[e] + wv[1][e] * v1[e] + wv[2][e] * v0[e];
                o[e] = silu_f(gg) * vv; g2[e] = g1[e]; g1[e] = g0[e]; v2[e] = v1[e]; v1[e] = v0[e]; }
            v4u w; w.x = pk2(o[0], o[1]); w.y = pk2(o[2], o[3]); w.z = pk2(o[4], o[5]); w.w = pk2(o[6], o[7]);
            *(GAS v4u*)(AB + (size_t)(r0 + i) * DFF + c0) = w;
        }
    }
}

__device__ __forceinline__ void conv_fixup_phase(Frame& F, const float* cw, const float* cb) {
    const float* UB = (const float*)(F.ws + WS_UB); bf16* AB = (bf16*)(F.ws + WS_AB);
    const int gt = (F.vcu * NWAVES + F.wave) * 64 + F.lane, NT = F.G * NWAVES * 64;
    for (int it = gt; it < 64 * 2 * DFF; it += NT) { const int c = it % DFF, tr = it / DFF, pm = tr >> 1, r = tr & 1;
        if ((pm & 15) == 0) continue;
        float o[2];
#pragma unroll
        for (int hh = 0; hh < 2; ++hh) { const int cc = c + hh * DFF;
            const float um2 = UB[((size_t)(pm - 1) * 4 + 2) * DUP + cc], um1 = UB[((size_t)(pm - 1) * 4 + 3) * DUP + cc], u0 = UB[((size_t)pm * 4 + 0) * DUP + cc], u1 = UB[((size_t)pm * 4 + 1) * DUP + cc];
            const float a = r ? um1 : um2, b = r ? u0 : um1, d = r ? u1 : u0;
            o[hh] = cb[cc] + cw[cc] * a + cw[DUP + cc] * b + cw[2 * DUP + cc] * d; }
        AB[(size_t)(pm * 256 + r) * DFF + c] = (bf16)f2bf(silu_f(o[0]) * o[1]); }
}

__device__ __forceinline__ void zero_rows_f32(Frame& F, float* p) { const int gt = (F.vcu * NWAVES + F.wave) * 64 + F.lane; if (gt < MP) p[gt] = 0.f; }
typedef float f32x16 __attribute__((ext_vector_type(16)));
typedef short s16x4 __attribute__((ext_vector_type(4)));
typedef float f32x2_t __attribute__((ext_vector_type(2))); typedef __bf16 bf16x2_t __attribute__((ext_vector_type(2)));
__device__ __forceinline__ unsigned cvtpk(float lo, float hi) { f32x2_t v = {lo, hi}; bf16x2_t b = __builtin_convertvector(v, bf16x2_t); return __builtin_bit_cast(unsigned, b); }
__device__ __forceinline__ int crow(int r, int hi) { return (r & 3) + 8 * (r >> 2) + 4 * hi; }
__device__ __forceinline__ s16x4 ds_tr(const LAS unsigned char* p) { return __builtin_bit_cast(s16x4, __builtin_amdgcn_ds_read_tr16_b64_v4i16((LAS s16x4*)p)); }
__device__ __forceinline__ bf16x8 mk8(s16x4 lo, s16x4 hi) { return (bf16x8){lo[0], lo[1], lo[2], lo[3], hi[0], hi[1], hi[2], hi[3]}; }
__device__ __forceinline__ bf16x8 pack_step(const f32x16& x, int s) {
    v4u p; p.x = cvtpk(x[8 * s], x[8 * s + 1]); p.y = cvtpk(x[8 * s + 2], x[8 * s + 3]); p.z = cvtpk(x[8 * s + 4], x[8 * s + 5]); p.w = cvtpk(x[8 * s + 6], x[8 * s + 7]);
    return __builtin_bit_cast(bf16x8, p);
}
#define MFMA32(a, b, c) __builtin_amdgcn_mfma_f32_32x32x16_bf16((a), (b), (c), 0, 0, 0)
__device__ __forceinline__ float log2_gamma(int h) { return log2f(1.f - exp2f(-5.f - (float)h)); }

constexpr int AT_V0 = 49152, AT_V1 = 49152 + 24576 + 128;
struct AttnIds { int g, b, h, r, np; };
__device__ __forceinline__ AttnIds attn_ids(int uid) { AttnIds a; a.g = uid >> 9; const int rem = uid & 511, bh = rem >> 4, rn = rem & 15, npc = 16 >> (2 * a.g); a.b = bh >> 3; a.h = bh & 7; a.r = rn / npc; a.np = rn % npc; return a; }
__device__ __forceinline__ void attn_fetch(Frame& F, const AttnIds& a, v4u (&kreg)[6], v4u (&vreg)[6]) {
    const bf16* ZB = (const bf16*)(F.ws + WS_ZB); const int dsh = 2 * a.g; const size_t brow = (size_t)a.b * SEQ;
#pragma unroll
    for (int i = 0; i < 6; ++i) { const int c = F.tid + 512 * i, key = c >> 3, ch = c & 7; int uk = 256 * a.np - 128 + key; uk = uk < 0 ? 0 : uk;
        const bf16* src = ZB + (brow + a.r + ((size_t)uk << dsh)) * DIN + a.h * 64 + ch * 8;
        kreg[i] = *(const GAS v4u*)(src + C_KA); vreg[i] = *(const GAS v4u*)(src + C_VA); }
}
__device__ __forceinline__ void attn_stage(Frame& F, const v4u (&kreg)[6], const v4u (&vreg)[6]) {
#pragma unroll
    for (int i = 0; i < 6; ++i) { const int c = F.tid + 512 * i, key = c >> 3, ch = c & 7;
        *(LAS v4u*)(F.lds + key * 128 + ((ch ^ ((key >> 1) & 7)) << 4)) = kreg[i];
        *(LAS v4u*)(F.lds + ((ch >> 2) ? AT_V1 : AT_V0) + key * 64 + ((ch & 3) << 4)) = vreg[i]; }
}
__device__ __forceinline__ void attn_compute(Frame& F, const AttnIds& a, const bf16x8 (&qf)[4]) {
    const int g = a.g, b = a.b, h = a.h, r = a.r, np = a.np;
    const int dsh = 2 * g;
    bf16* OG = (bf16*)(F.ws + WS_OG) + (size_t)g * MP * 512; float* LSE = (float*)(F.ws + WS_LSE) + (size_t)g * MP * 8;
    const int lane = F.lane, w = F.wave, r32 = lane & 31, hi = lane >> 5;
    LAS unsigned char* Kl = F.lds;
    const size_t brow = (size_t)b * SEQ;
    const size_t qrow = brow + r + ((size_t)(256 * np + 32 * w + r32) << dsh);
    f32x16 p[5];
#pragma unroll
    for (int kb = 0; kb < 5; ++kb) {
        f32x16 a = {};
        const int key = 32 * w + 32 * kb + r32;
#pragma unroll
        for (int d0 = 0; d0 < 4; ++d0) { const bf16x8 kf = *(const LAS bf16x8*)(Kl + key * 128 + (((2 * d0 + hi) ^ ((key >> 1) & 7)) << 4)); a = MFMA32(kf, qf[d0], a); }
        p[kb] = a;
    }
    float mx = -INFINITY;
#pragma unroll
    for (int kb = 0; kb < 5; ++kb) { const bool blk_dead = (np == 0) && (kb < 4 - w);
#pragma unroll
        for (int rg = 0; rg < 16; ++rg) { const int c = crow(rg, hi); bool ok = !blk_dead; if (kb == 0) ok = ok && (c >= r32); if (kb == 4) ok = ok && (c <= r32);
            const float v = ok ? p[kb][rg] : -INFINITY; p[kb][rg] = v; mx = fmaxf(mx, v); } }
    mx = fmaxf(mx, __shfl_xor(mx, 32));
    float l = 0.f;
#pragma unroll
    for (int kb = 0; kb < 5; ++kb)
#pragma unroll
        for (int rg = 0; rg < 16; ++rg) { const float e = __builtin_amdgcn_exp2f(p[kb][rg] - mx); p[kb][rg] = e; l += e; }
    l += __shfl_xor(l, 32);
    f32x16 o[2]; o[0] = (f32x16){}; o[1] = (f32x16){};
    const int gidx = lane >> 4, ql = (lane & 15) >> 2, pl = lane & 3;
    const int voff = (4 * hi + ql) * 64 + (16 * (gidx & 1) + 4 * pl) * 2;
#pragma unroll
    for (int kb = 0; kb < 5; ++kb)
#pragma unroll
        for (int s = 0; s < 2; ++s) { const bf16x8 pf = pack_step(p[kb], s);
#pragma unroll
            for (int dh = 0; dh < 2; ++dh) { const LAS unsigned char* vb = F.lds + (dh ? AT_V1 : AT_V0) + (32 * w + 32 * kb + 16 * s) * 64 + voff;
                const bf16x8 vf = mk8(ds_tr(vb), ds_tr(vb + 8 * 64)); o[dh] = MFMA32(vf, pf, o[dh]); } }
    const float inv = 1.f / l;
    bf16* orow = OG + qrow * 512 + h * 64;
#pragma unroll
    for (int dh = 0; dh < 2; ++dh)
#pragma unroll
        for (int t = 0; t < 4; ++t) { const int d = 32 * dh + 8 * t + 4 * hi;
            const unsigned lo = cvtpk(o[dh][4 * t] * inv, o[dh][4 * t + 1] * inv), hi2 = cvtpk(o[dh][4 * t + 2] * inv, o[dh][4 * t + 3] * inv);
            *(GAS unsigned long long*)(orow + d) = (unsigned long long)lo | ((unsigned long long)hi2 << 32); }
    if (hi == 0) LSE[qrow * 8 + h] = mx + log2f(l);
}
__device__ __forceinline__ void attn_qfetch(Frame& F, const AttnIds& a, bf16x8 (&qf)[4]) {
    const bf16* ZB = (const bf16*)(F.ws + WS_ZB); const int r32 = F.lane & 31, hi = F.lane >> 5;
    const size_t qrow = (size_t)a.b * SEQ + a.r + ((size_t)(256 * a.np + 32 * F.wave + r32) << (2 * a.g));
#pragma unroll
    for (int d0 = 0; d0 < 4; ++d0) qf[d0] = *(const GAS bf16x8*)(ZB + qrow * DIN + C_QA + a.h * 64 + d0 * 16 + hi * 8);
}
__device__ __forceinline__ void attn_prompt_units(Frame& F) {
    const int per = (1536 + F.G - 1) / F.G, u0 = F.vcu * per, u1 = (u0 + per < 1536) ? u0 + per : 1536;
    if (u0 >= u1) return;
    v4u kreg[6], vreg[6]; bf16x8 qn[4];
    attn_fetch(F, attn_ids(u0), kreg, vreg); attn_qfetch(F, attn_ids(u0), qn);
#pragma unroll 1
    for (int uid = u0; uid < u1; ++uid) {
        const AttnIds a = attn_ids(uid);
        bf16x8 qf[4];
#pragma unroll
        for (int d0 = 0; d0 < 4; ++d0) qf[d0] = qn[d0];
        attn_stage(F, kreg, vreg);
        __syncthreads();
        if (uid + 1 < u1) { attn_fetch(F, attn_ids(uid + 1), kreg, vreg); attn_qfetch(F, attn_ids(uid + 1), qn); }
        attn_compute(F, a, qf);
        __syncthreads();
    }
}
__device__ __forceinline__ void combine_prompt(Frame& F) {
    const bf16* OG = (const bf16*)(F.ws + WS_OG); const float* LSE = (const float*)(F.ws + WS_LSE); bf16* CATB = (bf16*)(F.ws + WS_CATB);
    const int gt = (F.vcu * NWAVES + F.wave) * 64 + F.lane, NT = F.G * NWAVES * 64;
    for (int it0 = gt; it0 < MP * 64; it0 += 4 * NT) {
        float l0[4], l1[4], l2[4]; v4u a[4], b[4], c[4];
#pragma unroll
        for (int q = 0; q < 4; ++q) { const int it = it0 + q * NT; const int row = (it < MP * 64 ? it : gt) >> 6, hc = it & 63, h = hc >> 3;
            l0[q] = *(const GAS float*)(LSE + (size_t)row * 8 + h); l1[q] = *(const GAS float*)(LSE + ((size_t)MP + row) * 8 + h); l2[q] = *(const GAS float*)(LSE + ((size_t)2 * MP + row) * 8 + h);
            a[q] = *(const GAS v4u*)(OG + (size_t)row * 512 + hc * 8); b[q] = *(const GAS v4u*)(OG + ((size_t)MP + row) * 512 + hc * 8); c[q] = *(const GAS v4u*)(OG + ((size_t)2 * MP + row) * 512 + hc * 8); }
        __builtin_amdgcn_sched_barrier(0);
#pragma unroll
        for (int q = 0; q < 4; ++q) { const int it = it0 + q * NT; if (it >= MP * 64) break; const int row = it >> 6, hc = it & 63;
            const float m = fmaxf(l0[q], fmaxf(l1[q], l2[q])); float w0 = __builtin_amdgcn_exp2f(l0[q] - m), w1 = __builtin_amdgcn_exp2f(l1[q] - m), w2 = __builtin_amdgcn_exp2f(l2[q] - m); const float inv = 1.f / (w0 + w1 + w2); w0 *= inv; w1 *= inv; w2 *= inv;
            v4u o;
#pragma unroll
            for (int e = 0; e < 4; ++e) { const float x0 = w0 * __uint_as_float(a[q][e] << 16) + w1 * __uint_as_float(b[q][e] << 16) + w2 * __uint_as_float(c[q][e] << 16);
                const float x1 = w0 * __uint_as_float(a[q][e] & 0xffff0000u) + w1 * __uint_as_float(b[q][e] & 0xffff0000u) + w2 * __uint_as_float(c[q][e] & 0xffff0000u); o[e] = cvtpk(x0, x1); }
            *(GAS v4u*)(CATB + (size_t)row * DM + 512 + hc * 8) = o; }
    }
}
__device__ __forceinline__ void ret_upd_unit(Frame& F, int bh, int n) {
    const bf16* ZB = (const bf16*)(F.ws + WS_ZB); float* UPD = (float*)(F.ws + WS_UPD) + ((size_t)bh * 32 + n) * 16384;
    const int tid = F.tid, lane = F.lane, w = F.wave, r32 = lane & 31, hi = lane >> 5;
    const int b = bh >> 2, h = bh & 3; const size_t row0 = (size_t)b * SEQ + 128 * n; const float lg = log2_gamma(h);
    {
        v4u kreg[4], vreg[4];
#pragma unroll
        for (int i = 0; i < 4; ++i) { const int c = tid + 512 * i, tok = c >> 4, ch = c & 15; const bf16* src = ZB + (row0 + tok) * DIN + h * 128 + ch * 8;
            kreg[i] = *(const GAS v4u*)(src + C_KR); vreg[i] = *(const GAS v4u*)(src + C_VR); }
#pragma unroll
        for (int i = 0; i < 4; ++i) { const int c = tid + 512 * i, tok = c >> 4, ch = c & 15; const float dec = exp2f((float)(127 - tok) * lg);
            v4u kk;
#pragma unroll
            for (int e = 0; e < 4; ++e) kk[e] = cvtpk(__uint_as_float(kreg[i][e] << 16) * dec, __uint_as_float(kreg[i][e] & 0xffff0000u) * dec);
            const int dst = (ch >> 2) * 8192 + tok * 64 + ((ch & 3) << 4);
            *(LAS v4u*)(F.lds + dst) = kk; *(LAS v4u*)(F.lds + 32768 + dst) = vreg[i]; }
    }
    __syncthreads();
    const int eb = w >> 1, db0 = 2 * (w & 1);
    const int gidx = lane >> 4, ql = (lane & 15) >> 2, pl = lane & 3;
    const int toff = (4 * hi + ql) * 64 + (16 * (gidx & 1) + 4 * pl) * 2;
    f32x16 acc[2]; acc[0] = (f32x16){}; acc[1] = (f32x16){};
#pragma unroll
    for (int s = 0; s < 8; ++s) { const LAS unsigned char* vb = F.lds + 32768 + eb * 8192 + (16 * s) * 64 + toff; const bf16x8 vf = mk8(ds_tr(vb), ds_tr(vb + 8 * 64));
#pragma unroll
        for (int q = 0; q < 2; ++q) { const LAS unsigned char* kb = F.lds + (db0 + q) * 8192 + (16 * s) * 64 + toff; const bf16x8 kf = mk8(ds_tr(kb), ds_tr(kb + 8 * 64)); acc[q] = MFMA32(vf, kf, acc[q]); } }
#pragma unroll
    for (int q = 0; q < 2; ++q)
#pragma unroll
        for (int rg = 0; rg < 16; ++rg) UPD[(size_t)(32 * eb + crow(rg, hi)) * 128 + 32 * (db0 + q) + r32] = acc[q][rg];
    __syncthreads();
}
__device__ __forceinline__ void ret_scan(Frame& F, float* pret) {
    const float* UPD = (const float*)(F.ws + WS_UPD); bf16* ST = (bf16*)(F.ws + WS_ST);
    const int gt = (F.vcu * NWAVES + F.wave) * 64 + F.lane, NT = F.G * NWAVES * 64;
    for (int it = gt; it < 16 * 16384; it += NT) { const int bh = it >> 14, ed = it & 16383, e = ed >> 7, d = ed & 127;
        const float cd = exp2f(128.f * log2_gamma(bh & 3));
        float u[32];
#pragma unroll
        for (int n = 0; n < 32; ++n) u[n] = UPD[((size_t)bh * 32 + n) * 16384 + ed];
        float S = 0.f;
#pragma unroll
        for (int n = 0; n < 32; ++n) { ST[((size_t)bh * 32 + n) * 16384 + ed] = (bf16)f2bf(S); S = cd * S + u[n]; }
        pret[(size_t)bh * 16384 + d * 128 + e] = S; }
}
__device__ __forceinline__ void ret_out_pair(Frame& F, int upair, const float* gnw) {
    const bf16* ZB = (const bf16*)(F.ws + WS_ZB); bf16* CATB = (bf16*)(F.ws + WS_CATB);
    const int tid = F.tid, lane = F.lane, w = F.wave, r32 = lane & 31, hi = lane >> 5, qd = w >> 2, wq = w & 3, tq = tid & 255;
    const int unit = 2 * upair + qd, bh = unit >> 5, n = unit & 31, b = bh >> 2, h = bh & 3;
    const size_t row0 = (size_t)b * SEQ + 128 * n; const float lg = log2_gamma(h);
    const bf16* STu = (const bf16*)(F.ws + WS_ST) + ((size_t)bh * 32 + n) * 16384;
    LAS unsigned char* Vl = F.lds + qd * 32768;
    {
        v4u vreg[8];
#pragma unroll
        for (int i = 0; i < 8; ++i) { const int c = tq + 256 * i, tok = c >> 4, ch = c & 15; vreg[i] = *(const GAS v4u*)(ZB + (row0 + tok) * DIN + C_VR + h * 128 + ch * 8); }
#pragma unroll
        for (int i = 0; i < 8; ++i) { const int c = tq + 256 * i, tok = c >> 4, ch = c & 15; *(LAS v4u*)(Vl + (ch >> 2) * 8192 + tok * 64 + ((ch & 3) << 4)) = vreg[i]; }
    }
    const int iq = 32 * wq + r32; const size_t qrow = row0 + iq;
    bf16x8 qf[8];
#pragma unroll
    for (int ks = 0; ks < 8; ++ks) qf[ks] = *(const GAS bf16x8*)(ZB + qrow * DIN + C_QR + h * 128 + ks * 16 + hi * 8);
    __syncthreads();
    f32x16 acc[4];
#pragma unroll
    for (int eb = 0; eb < 4; ++eb) { f32x16 a = {};
        bf16x8 sf[8];
#pragma unroll
        for (int ks = 0; ks < 8; ++ks) sf[ks] = *(const GAS bf16x8*)(STu + (size_t)(32 * eb + r32) * 128 + ks * 16 + hi * 8);
        __builtin_amdgcn_sched_barrier(0);
#pragma unroll
        for (int ks = 0; ks < 8; ++ks) a = MFMA32(sf[ks], qf[ks], a);
        acc[eb] = a; __builtin_amdgcn_sched_barrier(0); }
    { const float cdec = exp2f((float)(iq + 1) * lg);
#pragma unroll
        for (int eb = 0; eb < 4; ++eb)
#pragma unroll
            for (int rg = 0; rg < 16; ++rg) acc[eb][rg] *= cdec; }
    const int gidx = lane >> 4, ql = (lane & 15) >> 2, pl = lane & 3;
    const int toff = (4 * hi + ql) * 64 + (16 * (gidx & 1) + 4 * pl) * 2;
#pragma unroll 1
    for (int kb = 0; kb <= wq; ++kb) {
        {
            f32x16 p = {};
            bf16x8 kfr[8];
#pragma unroll
            for (int ks = 0; ks < 8; ++ks) kfr[ks] = *(const GAS bf16x8*)(ZB + (row0 + 32 * kb + r32) * DIN + C_KR + h * 128 + ks * 16 + hi * 8);
            __builtin_amdgcn_sched_barrier(0);
#pragma unroll
            for (int ks = 0; ks < 8; ++ks) p = MFMA32(kfr[ks], qf[ks], p);
#pragma unroll
            for (int rg = 0; rg < 16; ++rg) { const int j = 32 * kb + crow(rg, hi); p[rg] = (j <= iq) ? p[rg] * __builtin_amdgcn_exp2f((float)(iq - j) * lg) : 0.f; }
#pragma unroll
            for (int s = 0; s < 2; ++s) { const bf16x8 pf = pack_step(p, s);
#pragma unroll
                for (int eb = 0; eb < 4; ++eb) { const LAS unsigned char* vb = Vl + eb * 8192 + (32 * kb + 16 * s) * 64 + toff; const bf16x8 vf = mk8(ds_tr(vb), ds_tr(vb + 8 * 64)); acc[eb] = MFMA32(vf, pf, acc[eb]); } }
        }
    }
    float s1 = 0.f;
#pragma unroll
    for (int eb = 0; eb < 4; ++eb)
#pragma unroll
        for (int rg = 0; rg < 16; ++rg) s1 += acc[eb][rg];
    s1 += __shfl_xor(s1, 32); const float mu = s1 * (1.f / 128.f);
    float s2 = 0.f;
#pragma unroll
    for (int eb = 0; eb < 4; ++eb)
#pragma unroll
        for (int rg = 0; rg < 16; ++rg) { const float dlt = acc[eb][rg] - mu; s2 += dlt * dlt; }
    s2 += __shfl_xor(s2, 32); const float rstd = 1.f / sqrtf(s2 * (1.f / 128.f) + EPS);
#pragma unroll
    for (int eb = 0; eb < 4; ++eb)
#pragma unroll
        for (int t = 0; t < 4; ++t) { const int e = 32 * eb + 8 * t + 4 * hi;
            const unsigned long long gg = *(const GAS unsigned long long*)(ZB + qrow * DIN + C_GR + h * 128 + e);
            const f32x4 gw = *(const GAS f32x4*)(gnw + h * 128 + e);
            float gv[4] = {__uint_as_float((unsigned)gg << 16), __uint_as_float((unsigned)gg & 0xffff0000u), __uint_as_float((unsigned)(gg >> 32) << 16), __uint_as_float((unsigned)(gg >> 32) & 0xffff0000u)};
            float y[4];
#pragma unroll
            for (int k = 0; k < 4; ++k) y[k] = silu_f(gv[k]) * ((acc[eb][4 * t + k] - mu) * rstd * gw[k]);
            *(GAS unsigned long long*)(CATB + qrow * DM + h * 128 + e) = (unsigned long long)cvtpk(y[0], y[1]) | ((unsigned long long)cvtpk(y[2], y[3]) << 32); }
    __syncthreads();
}
#define MFMA16(a, b, c) __builtin_amdgcn_mfma_f32_16x16x32_bf16((a), (b), (c), 0, 0, 0)
template <int KW> __device__ __forceinline__ f32x4 smp_task_core(Frame& F, const bf16* A, const bf16* Bt, int K, int wrow) {
#if defined(DBG_NAIVE_CORE)
    { const int lane = F.lane, fr = lane & 15, fq = lane >> 4, row = 16 * F.wave + fr; f32x4 s;
      for (int i = 0; i < 4; ++i) { const int wr_i = __shfl(wrow, 4 * fq + i); float a = 0.f;
          for (int k = 0; k < K; ++k) a += __uint_as_float((unsigned)A[(size_t)row * K + k] << 16) * __uint_as_float((unsigned)Bt[(size_t)wr_i * K + k] << 16);
          s[i] = a; }
      __syncthreads(); return s; }
#endif
    const int lane = F.lane, w = F.wave, fr = lane & 15, fq = lane >> 4;
    const bf16* ap = A + (size_t)fr * K + w * KW + 8 * fq; const bf16* bp = Bt + (size_t)wrow * K + w * KW + 8 * fq;
    f32x4 acc[8];
#pragma unroll
    for (int mb = 0; mb < 8; ++mb) acc[mb] = (f32x4){0.f, 0.f, 0.f, 0.f};
    static_assert(KW % 32 == 0, "K slice");
    constexpr int NS = KW / 32;
#pragma unroll 1
    for (int s0 = 0; s0 < NS; s0 += 2) {
        bf16x8 bf[2], af[2][8];
#pragma unroll
        for (int q = 0; q < 2; ++q) if (s0 + q < NS) { bf[q] = *(const GAS bf16x8*)(bp + (s0 + q) * 32);
#pragma unroll
            for (int mb = 0; mb < 8; ++mb) af[q][mb] = *(const GAS bf16x8*)(ap + (size_t)(16 * mb) * K + (s0 + q) * 32); }
        __builtin_amdgcn_sched_barrier(0);
#pragma unroll
        for (int q = 0; q < 2; ++q) if (s0 + q < NS) {
#pragma unroll
            for (int mb = 0; mb < 8; ++mb) acc[mb] = MFMA16(bf[q], af[q][mb], acc[mb]); }
        __builtin_amdgcn_sched_barrier(0);
    }
    LAS f32x4* red = (LAS f32x4*)F.lds;
#pragma unroll
    for (int mb = 0; mb < 8; ++mb) red[(w * 8 + mb) * 64 + lane] = acc[mb];
    __syncthreads();
    f32x4 s = red[(0 * 8 + w) * 64 + lane];
#pragma unroll
    for (int ww = 1; ww < 8; ++ww) s += red[(ww * 8 + w) * 64 + lane];
    return s;
}
__device__ __forceinline__ float smp_rstd(Frame& F) {
    const float* SSs = (const float*)(F.ws + WS_SMP + SM_SS); const int fr = F.lane & 15, fq = F.lane >> 4, row = 16 * F.wave + fr;
    const GAS f32x4* p = (const GAS f32x4*)(SSs + (size_t)row * 64 + 16 * fq); const f32x4 a = p[0], b = p[1], c = p[2], d = p[3];
    float s = (((a[0] + a[1]) + (a[2] + a[3])) + ((b[0] + b[1]) + (b[2] + b[3]))) + (((c[0] + c[1]) + (c[2] + c[3])) + ((d[0] + d[1]) + (d[2] + d[3])));
    s += __shfl_xor(s, 16); s += __shfl_xor(s, 32); return 1.f / sqrtf(s * (1.f / DM) + EPS);
}

#if defined(DBG_RSTD_DIRECT)
#define smp_rstd smp_rstd_direct
__device__ __forceinline__ float smp_rstd_direct(Frame& F) {
    const float* XSf = (const float*)(F.ws + WS_SMP + SM_X); const int fr = F.lane & 15, fq = F.lane >> 4, row = 16 * F.wave + fr;
    const GAS f32x4* p = (const GAS f32x4*)(XSf + (size_t)row * DM + 256 * fq); float s = 0.f;
    for (int i = 0; i < 64; ++i) { const f32x4 a = p[i]; s += (a[0] * a[0] + a[1] * a[1]) + (a[2] * a[2] + a[3] * a[3]); }
    s += __shfl_xor(s, 16); s += __shfl_xor(s, 32); return 1.f / sqrtf(s * (1.f / DM) + EPS);
}
#endif
__device__ __forceinline__ void sample_win_task(Frame& F, int task, const bf16* Wl, float* swk, float* swv) {
    const bf16* XSB = (const bf16*)(F.ws + WS_SMP + SM_HB); bf16* ZS = (bf16*)(F.ws + WS_SMP + SM_ZB);
    const float* T64 = (const float*)(F.ws + WS_T64); const float* T32 = (const float*)(F.ws + WS_T32);
    const int lane = F.lane, fr = lane & 15, fq = lane >> 4, pn = task >> 4, j0 = (task & 15) * 8;
    const int wrow = pn * 256 + (fr < 8 ? j0 + fr : 128 + j0 + (fr - 8));
    f32x4 v = smp_task_core<128>(F, XSB, Wl, DM, wrow) * smp_rstd(F);
    const int bj = fq >> 1, j = j0 + 4 * (fq & 1);
    const bool rot = (pn < 4) || (pn >= 8 && pn < 12);
    int feat; const float* T = T64; int tstride = 64, fidx = 0; float sc = 1.f;
    if (pn < 4) { feat = (pn >> 1) * 512 + (2 * (pn & 1) + (j >> 6)) * 128 + (j & 63) + 64 * bj; fidx = j & 63; sc = (pn >= 2) ? pg8::KR_SCALE : 1.f; }
    else if (pn >= 8 && pn < 12) { feat = 2048 + ((pn - 8) >> 1) * 512 + (4 * (pn & 1) + (j >> 5)) * 64 + (j & 31) + 32 * bj; fidx = j & 31; T = T32; tstride = 32; sc = (pn < 10) ? pg8::QA_SCALE : 1.f; }
    else feat = pn * 256 + 128 * bj + j;
    const int row = 16 * F.wave + fr;
    f32x4 pr; pr[0] = __shfl_xor(v[0], 32); pr[1] = __shfl_xor(v[1], 32); pr[2] = __shfl_xor(v[2], 32); pr[3] = __shfl_xor(v[3], 32);
    if (rot) { const float* tp = T + ((size_t)(SEQ + (row & 3)) * tstride + fidx) * 2;
        const f32x4 cs0 = *(const GAS f32x4*)tp, cs1 = *(const GAS f32x4*)(tp + 4);
        const float c[4] = {cs0[0], cs0[2], cs1[0], cs1[2]}, s[4] = {cs0[1], cs0[3], cs1[1], cs1[3]};
#pragma unroll
        for (int i = 0; i < 4; ++i) v[i] = (bj == 0 ? (v[i] * c[i] - pr[i] * s[i]) : (v[i] * c[i] + pr[i] * s[i])) * sc; }
    *(GAS unsigned long long*)(ZS + (size_t)row * DIN + feat) = (unsigned long long)cvtpk(v[0], v[1]) | ((unsigned long long)cvtpk(v[2], v[3]) << 32);
    if (pn == 10 || pn == 11) *(GAS f32x4*)(swk + (size_t)row * 512 + (feat - C_KA)) = v;
    if (pn >= 12) *(GAS f32x4*)(swv + (size_t)row * 512 + (feat - C_VA)) = v;
    __syncthreads();
}
template <int KW> __device__ __forceinline__ void sample_resid_task(Frame& F, const bf16* A, const bf16* Bt, int K, int task) {
    float* XS = (float*)(F.ws + WS_SMP + SM_X); bf16* XSB = (bf16*)(F.ws + WS_SMP + SM_HB); float* SSs = (float*)(F.ws + WS_SMP + SM_SS);
    const int lane = F.lane, w = F.wave, fr = lane & 15, fq = lane >> 4, cg = task >> 2, rq = task & 3;
    constexpr int NS = KW / 32;
    const bf16* ap = A + (size_t)(32 * rq + fr) * K + w * KW + 8 * fq; const bf16* bp = Bt + (size_t)(16 * cg + fr) * K + w * KW + 8 * fq;
    bf16x8 bf[NS], a0[NS], a1[NS];
#pragma unroll
    for (int s = 0; s < NS; ++s) { bf[s] = *(const GAS bf16x8*)(bp + s * 32); a0[s] = *(const GAS bf16x8*)(ap + s * 32); a1[s] = *(const GAS bf16x8*)(ap + (size_t)16 * K + s * 32); }
    __builtin_amdgcn_sched_barrier(0);
    f32x4 acc0 = {0.f, 0.f, 0.f, 0.f}, acc1 = acc0;
#pragma unroll
    for (int s = 0; s < NS; ++s) { acc0 = MFMA16(bf[s], a0[s], acc0); acc1 = MFMA16(bf[s], a1[s], acc1); }
    LAS f32x4* red = (LAS f32x4*)F.lds;
    red[(w * 2 + 0) * 64 + lane] = acc0; red[(w * 2 + 1) * 64 + lane] = acc1;
    __syncthreads();
    if (w < 2) {
        f32x4 d = red[(0 * 2 + w) * 64 + lane];
#pragma unroll
        for (int ww = 1; ww < 8; ++ww) d += red[(ww * 2 + w) * 64 + lane];
        const int row = 32 * rq + 16 * w + fr;
        float* xp = XS + (size_t)row * DM + 16 * cg + 4 * fq;
        const f32x4 x = *(const GAS f32x4*)xp + d;
        *(GAS f32x4*)xp = x;
        *(GAS unsigned long long*)(XSB + (size_t)row * DM + 16 * cg + 4 * fq) = (unsigned long long)cvtpk(x[0], x[1]) | ((unsigned long long)cvtpk(x[2], x[3]) << 32);
        float s = (x[0] * x[0] + x[1] * x[1]) + (x[2] * x[2] + x[3] * x[3]); s += __shfl_xor(s, 16); s += __shfl_xor(s, 32);
        if (fq == 0) SSs[(size_t)row * 64 + cg] = s;
    }
    __syncthreads();
}

#if defined(DBG_NAIVE_RESID)
__device__ __forceinline__ void sample_resid_naive(Frame& F, const bf16* A, const bf16* Bt, int K) {
    float* XSf = (float*)(F.ws + WS_SMP + SM_X); bf16* XSB = (bf16*)(F.ws + WS_SMP + SM_HB);
    const int gt = (F.vcu * NWAVES + F.wave) * 64 + F.lane, NT = F.G * NWAVES * 64;
    for (int it = gt; it < MS * DM; it += NT) { const int row = it / DM, col = it % DM; float s = 0.f;
        for (int k = 0; k < K; ++k) s += __uint_as_float((unsigned)A[(size_t)row * K + k] << 16) * __uint_as_float((unsigned)Bt[(size_t)col * K + k] << 16);
        const float x = XSf[it] + s; XSf[it] = x; XSB[it] = (bf16)f2bf(x); }
}
#endif
__device__ __forceinline__ void sample_up_task(Frame& F, int task, const bf16* Wl, const float* sconv_in, const float* cw, const float* cb, float* sconv_out) {
    const bf16* XSB = (const bf16*)(F.ws + WS_SMP + SM_HB); bf16* AS = (bf16*)(F.ws + WS_SMP + SM_AB);
    const int lane = F.lane, fr = lane & 15, fq = lane >> 4, pn = task >> 4, j0 = (task & 15) * 8;
    const int wrow = pn * 256 + (fr < 8 ? j0 + fr : 128 + j0 + (fr - 8));
    const f32x4 u = smp_task_core<128>(F, XSB, Wl, DM, wrow) * smp_rstd(F);
    const int row = 16 * F.wave + fr, b = row >> 2, t = row & 3;
    const int feat = (fq >> 1) * DFF + 128 * pn + j0 + 4 * (fq & 1);
    const f32x4 c0 = *(const GAS f32x4*)(sconv_in + ((size_t)b * 2 + 0) * DUP + feat), c1 = *(const GAS f32x4*)(sconv_in + ((size_t)b * 2 + 1) * DUP + feat);
    const f32x4 w0 = *(const GAS f32x4*)(cw + feat), w1 = *(const GAS f32x4*)(cw + DUP + feat), w2 = *(const GAS f32x4*)(cw + 2 * DUP + feat), bb = *(const GAS f32x4*)(cb + feat);
    f32x4 r;
#pragma unroll
    for (int i = 0; i < 4; ++i) { const float s1 = __shfl_up(u[i], 1, 16), s2 = __shfl_up(u[i], 2, 16);
        const float p1 = (t >= 1) ? s1 : c1[i], p2 = (t >= 2) ? s2 : (t == 1 ? c1[i] : c0[i]);
        r[i] = bb[i] + w0[i] * p2 + w1[i] * p1 + w2[i] * u[i]; }
    f32x4 pr; pr[0] = __shfl_xor(r[0], 32); pr[1] = __shfl_xor(r[1], 32); pr[2] = __shfl_xor(r[2], 32); pr[3] = __shfl_xor(r[3], 32);
    if (fq < 2) { const int c = 128 * pn + j0 + 4 * fq;
        *(GAS unsigned long long*)(AS + (size_t)row * DFF + c) = (unsigned long long)cvtpk(silu_f(r[0]) * pr[0], silu_f(r[1]) * pr[1]) | ((unsigned long long)cvtpk(silu_f(r[2]) * pr[2], silu_f(r[3]) * pr[3]) << 32); }
    if (t >= 2) *(GAS f32x4*)(sconv_out + ((size_t)b * 2 + (t - 2)) * DUP + feat) = u;
    __syncthreads();
}

__device__ __forceinline__ void sample_attn_unit(Frame& F, int b, int h, const float* ck, const float* cv) {
    const bf16* ZS = (const bf16*)(F.ws + WS_SMP + SM_ZB); bf16* CATS = (bf16*)(F.ws + WS_SMP + SM_CATB);
    LAS float* sc = (LAS float*)F.lds; LAS float* part = sc + 4 * 388; LAS float* ml = part + 8 * 64;
    const int lane = F.lane, w = F.wave, t = w & 3, hf = w >> 2, sub = lane >> 4, l16 = lane & 15;
    float q[4];
    { const unsigned long long qq = *(const GAS unsigned long long*)(ZS + (size_t)(b * 4 + t) * DIN + C_QA + h * 64 + 4 * l16);
      q[0] = __uint_as_float((unsigned)qq << 16); q[1] = __uint_as_float((unsigned)qq & 0xffff0000u); q[2] = __uint_as_float((unsigned)(qq >> 32) << 16); q[3] = __uint_as_float((unsigned)(qq >> 32) & 0xffff0000u); }
    const float* ckb = ck + ((size_t)b * WCTX * 8 + h) * 64 + 4 * l16; const float* cvb = cv + ((size_t)b * WCTX * 8 + h) * 64 + 4 * l16;
#pragma unroll 1
    for (int c0 = 0; c0 < 50; c0 += 25) {
        f32x4 kvv[25];
#pragma unroll
        for (int u = 0; u < 25; ++u) { const int k = 4 * (hf + 2 * (c0 + u)) + sub; const int kk = k < 387 ? k : 386;
            const int g = kk / 129, j = kk - 129 * g; const int idx = WCTX + t - (j << (2 * g)); const int ic = idx >= WCTX ? WCTX - 1 : idx;
            kvv[u] = *(const GAS f32x4*)(ckb + (size_t)ic * 512); }
        __builtin_amdgcn_sched_barrier(0);
#pragma unroll
        for (int u = 0; u < 25; ++u) { const int k = 4 * (hf + 2 * (c0 + u)) + sub; const bool valid = k < 387; const int kk = valid ? k : 386;
            const int g = kk / 129, j = kk - 129 * g; const int idx = WCTX + t - (j << (2 * g)); const bool isnew = idx >= WCTX;
            const f32x4 kv = kvv[u];
            float s = q[0] * kv[0] + q[1] * kv[1] + q[2] * kv[2] + q[3] * kv[3];
            s += __shfl_xor(s, 1); s += __shfl_xor(s, 2); s += __shfl_xor(s, 4); s += __shfl_xor(s, 8);
            if (l16 == 0 && valid && !isnew) sc[t * 388 + k] = s; }
        __builtin_amdgcn_sched_barrier(0);
    }
#define SMP_NEWPAIR(pi, kvar, rvar) const bool pv_ = (pi) < t + 3; const int kvar = (pi) <= t ? (pi) : ((pi) == t + 1 ? 129 : 258); const int rvar = (pi) <= t ? t - (pi) : t;
    if (hf == 0) {
#pragma unroll
        for (int i = 0; i < 2; ++i) { SMP_NEWPAIR(4 * i + sub, kn, rn)
            const unsigned long long x = *(const GAS unsigned long long*)(ZS + (size_t)(b * 4 + rn) * DIN + C_KA + h * 64 + 4 * l16);
            float s = q[0] * __uint_as_float((unsigned)x << 16) + q[1] * __uint_as_float((unsigned)x & 0xffff0000u) + q[2] * __uint_as_float((unsigned)(x >> 32) << 16) + q[3] * __uint_as_float((unsigned)(x >> 32) & 0xffff0000u);
            s += __shfl_xor(s, 1); s += __shfl_xor(s, 2); s += __shfl_xor(s, 4); s += __shfl_xor(s, 8);
            if (l16 == 0 && pv_) sc[t * 388 + kn] = s; }
    }
    __syncthreads();
    if (w < 4) {
        float m = -INFINITY;
        for (int k = lane; k < 387; k += 64) m = fmaxf(m, sc[t * 388 + k]);
#pragma unroll
        for (int o = 1; o < 64; o <<= 1) m = fmaxf(m, __shfl_xor(m, o));
        float l = 0.f;
        for (int k = lane; k < 387; k += 64) { const float e = exp2f(sc[t * 388 + k] - m); sc[t * 388 + k] = e; l += e; }
        l = wave_sum(l);
        if (lane == 0) { ml[t] = l; sc[t * 388 + 387] = 0.f; }
    }
    __syncthreads();
    float a4[4] = {0.f, 0.f, 0.f, 0.f};
#pragma unroll 1
    for (int c0 = 0; c0 < 50; c0 += 25) {
        f32x4 vvv[25];
#pragma unroll
        for (int u = 0; u < 25; ++u) { const int k = 4 * (hf + 2 * (c0 + u)) + sub; const int kk = k < 387 ? k : 386;
            const int g = kk / 129, j = kk - 129 * g; const int idx = WCTX + t - (j << (2 * g)); const int ic = idx >= WCTX ? WCTX - 1 : idx;
            vvv[u] = *(const GAS f32x4*)(cvb + (size_t)ic * 512); }
        __builtin_amdgcn_sched_barrier(0);
#pragma unroll
        for (int u = 0; u < 25; ++u) { const int k = 4 * (hf + 2 * (c0 + u)) + sub; const bool valid = k < 387; const int kk = valid ? k : 386;
            const int g = kk / 129, j = kk - 129 * g; const int idx = WCTX + t - (j << (2 * g)); const bool isnew = idx >= WCTX;
            const f32x4 vv = vvv[u];
            const float p = (valid && !isnew) ? sc[t * 388 + kk] : 0.f;
#pragma unroll
            for (int i = 0; i < 4; ++i) a4[i] += p * vv[i]; }
        __builtin_amdgcn_sched_barrier(0);
    }
    if (hf == 0) {
#pragma unroll
        for (int i = 0; i < 2; ++i) { SMP_NEWPAIR(4 * i + sub, kn, rn)
            const unsigned long long x = *(const GAS unsigned long long*)(ZS + (size_t)(b * 4 + rn) * DIN + C_VA + h * 64 + 4 * l16);
            const float p = pv_ ? sc[t * 388 + kn] : 0.f;
            a4[0] += p * __uint_as_float((unsigned)x << 16); a4[1] += p * __uint_as_float((unsigned)x & 0xffff0000u); a4[2] += p * __uint_as_float((unsigned)(x >> 32) << 16); a4[3] += p * __uint_as_float((unsigned)(x >> 32) & 0xffff0000u); }
    }
#undef SMP_NEWPAIR
#pragma unroll
    for (int i = 0; i < 4; ++i) { a4[i] += __shfl_xor(a4[i], 16); a4[i] += __shfl_xor(a4[i], 32); }
    if (lane < 16) { part[w * 64 + 4 * l16 + 0] = a4[0]; part[w * 64 + 4 * l16 + 1] = a4[1]; part[w * 64 + 4 * l16 + 2] = a4[2]; part[w * 64 + 4 * l16 + 3] = a4[3]; }
    __syncthreads();
    if (w < 4) { const float o = (part[w * 64 + lane] + part[(w + 4) * 64 + lane]) / ml[w];
        CATS[(size_t)(b * 4 + w) * DM + 512 + h * 64 + lane] = (bf16)f2bf(o); }
    __syncthreads();
}
__device__ __forceinline__ void sample_ret_unit(Frame& F, int b, int h, const float* s0, float* s1, const float* gnw) {
    const bf16* ZS = (const bf16*)(F.ws + WS_SMP + SM_ZB); bf16* CATS = (bf16*)(F.ws + WS_SMP + SM_CATB);
    LAS float* qs = (LAS float*)F.lds; LAS float* ks = qs + 512; LAS float* vs = ks + 512; LAS float* part = vs + 512; LAS float* ob = part + 512;
    const int tid = F.tid, lane = F.lane, w = F.wave, e = tid & 127, dq = tid >> 7;
    { const int tt = tid >> 7, dd = tid & 127; const bf16* zr = ZS + (size_t)(b * 4 + tt) * DIN + h * 128 + dd;
      qs[tid] = __uint_as_float((unsigned)zr[C_QR] << 16); ks[tid] = __uint_as_float((unsigned)zr[C_KR] << 16); vs[tid] = __uint_as_float((unsigned)zr[C_VR] << 16); }
    const size_t sbase = ((size_t)b * 4 + h) * 16384;
    float S[32];
#pragma unroll
    for (int d = 0; d < 32; ++d) S[d] = s0[sbase + (size_t)(32 * dq + d) * 128 + e];
    const float gam = 1.f - exp2f(-5.f - (float)h);
    __syncthreads();
#pragma unroll 1
    for (int t = 0; t < 4; ++t) {
        const float v = vs[t * 128 + e]; float po = 0.f;
#pragma unroll
        for (int d = 0; d < 32; ++d) { S[d] = gam * S[d] + ks[t * 128 + 32 * dq + d] * v; po += qs[t * 128 + 32 * dq + d] * S[d]; }
        part[dq * 128 + e] = po;
        __syncthreads();
        if (dq == 0) ob[t * 128 + e] = (part[e] + part[128 + e]) + (part[256 + e] + part[384 + e]);
        __syncthreads();
    }
#pragma unroll
    for (int d = 0; d < 32; ++d) s1[sbase + (size_t)(32 * dq + d) * 128 + e] = S[d];
    if (w < 4) { const int t = w; const float a = ob[t * 128 + lane], c = ob[t * 128 + 64 + lane];
        const float mu = wave_sum(a + c) * (1.f / 128.f); const float var = wave_sum((a - mu) * (a - mu) + (c - mu) * (c - mu)) * (1.f / 128.f); const float rstd = 1.f / sqrtf(var + EPS);
        const bf16* zr = ZS + (size_t)(b * 4 + t) * DIN + C_GR + h * 128;
        const float g0 = __uint_as_float((unsigned)zr[lane] << 16), g1 = __uint_as_float((unsigned)zr[64 + lane] << 16);
        CATS[(size_t)(b * 4 + t) * DM + h * 128 + lane] = (bf16)f2bf(silu_f(g0) * ((a - mu) * rstd * gnw[h * 128 + lane]));
        CATS[(size_t)(b * 4 + t) * DM + h * 128 + 64 + lane] = (bf16)f2bf(silu_f(g1) * ((c - mu) * rstd * gnw[h * 128 + 64 + lane])); }
    __syncthreads();
}
#if defined(__HIP_DEVICE_COMPILE__)
#define MK_ASSUME_GLOBAL(p) do { __builtin_assume(!__builtin_amdgcn_is_shared((const void*)(p))); __builtin_assume(!__builtin_amdgcn_is_private((const void*)(p))); } while (0)
#else
#define MK_ASSUME_GLOBAL(p) do { } while (0)
#endif
#define MK_REFRESH() do { int t_; asm volatile("v_mbcnt_lo_u32_b32 %0, -1, 0\n\tv_mbcnt_hi_u32_b32 %0, -1, %0" : "=v"(t_)); t_ += wave_s * 64;     F.tid = t_; F.lane = t_ & 63; F.wave = __builtin_amdgcn_readfirstlane(t_ >> 6); \
    GAS unsigned char* w_ = (GAS unsigned char*)args.ws; asm volatile("" : "+s"(w_)); F.ws = (unsigned char*)w_;     F.ctl = (gu32*)(w_ + WS_CTL); { GAS float* o_ = (GAS float*)args.out; asm volatile("" : "+s"(o_)); outp = (float*)o_; } \
    bx = blockIdx.x; asm volatile("" : "+s"(bx)); F.G = gridDim.x; F.vcu = (F.G % 8 == 0) ? (bx % 8) * (F.G / 8) + bx / 8 : bx; } while (0)
#define MK_FRAME_SETUP() \
    extern __shared__ __attribute__((aligned(16))) unsigned char lds[]; \
    Frame F; F.lds = (LAS unsigned char*)lds; F.MISC = (volatile LAS unsigned*)(F.lds + MISC_OFF); \
    F.tid = threadIdx.x; F.lane = F.tid & 63; F.wave = __builtin_amdgcn_readfirstlane(F.tid >> 6); \
    F.G = gridDim.x; { const int bx = blockIdx.x; F.vcu = (F.G % 8 == 0) ? (bx % 8) * (F.G / 8) + bx / 8 : bx; } \
    F.ws = args.ws; F.ctl = (gu32*)(args.ws + WS_CTL);

enum { I_XP = 0, I_XS = 1, I_CK = 2, I_CV = 3, I_SRET = 4, I_SCONV = 5, I_N1W = 6, I_WIN = 7, I_GNW = 8, I_WOUT = 9, I_N2W = 10, I_WUP = 11, I_CW = 12, I_CB = 13, I_WDN = 14, I_FNW = 15 };
constexpr size_t O_YP = 0, O_YS = O_YP + (size_t)MP * DM, O_PWK = O_YS + (size_t)MS * DM, O_PWV = O_PWK + (size_t)DEPTH * NBATCH * 2048 * 512,
                 O_PRET = O_PWV + (size_t)DEPTH * NBATCH * 2048 * 512, O_PCONV = O_PRET + (size_t)DEPTH * NBATCH * 4 * 16384, O_SWK = O_PCONV + (size_t)DEPTH * NBATCH * 2 * DUP,
                 O_SWV = O_SWK + (size_t)DEPTH * MS * 512, O_SRET = O_SWV + (size_t)DEPTH * MS * 512, O_SCONV = O_SRET + (size_t)DEPTH * DBATCH * 4 * 16384, O_END = O_SCONV + (size_t)DEPTH * DBATCH * 2 * DUP;


__global__ void __launch_bounds__(NWAVES * 64, 2) mk_fwd(Args args) {
    MK_FRAME_SETUP();
#define INP(i) ((const float*)(const GAS float*)args.in[i])
    float* outp = args.out; int bx = blockIdx.x; const int wave_s = __builtin_amdgcn_readfirstlane((int)threadIdx.x >> 6);
    for (int u = F.tid; u < (LDS_BYTES - LDSCTL_OFF) / 4; u += NWAVES * 64) ((LAS unsigned*)(F.lds + LDSCTL_OFF))[u] = 0u;
    __syncthreads();
    XcdBarrier bar = xcd_barrier_post((unsigned*)(F.ctl + CW_BAR), F.MISC + 8);
#define XRES ((float*)(F.ws + WS_XRES))
#define XS ((float*)(F.ws + WS_SMP + SM_X))
    p0_prologue(F, INP(I_WIN), INP(I_WOUT), INP(I_WUP), INP(I_WDN), INP(I_N1W), INP(I_N2W), INP(I_XP));
    { const int gw = F.vcu * NWAVES + F.wave, NGW = F.G * NWAVES;
      for (int r = NGW - 1 - gw; r < MS; r += NGW) { const GAS f32x4* xr = (const GAS f32x4*)(INP(I_XS) + (size_t)r * DM) + F.lane; GAS f32x4* xo = (GAS f32x4*)(XS + (size_t)r * DM) + F.lane;
          GAS unsigned long long* o8 = (GAS unsigned long long*)((bf16*)(F.ws + WS_SMP + SM_HB) + (size_t)r * DM) + F.lane; float s = 0.f;
#pragma unroll
          for (int j = 0; j < 4; ++j) { const f32x4 v = xr[64 * j]; xo[64 * j] = v; s += (v.x * v.x + v.y * v.y) + (v.z * v.z + v.w * v.w); o8[64 * j] = (unsigned long long)pk2(v.x, v.y) | ((unsigned long long)pk2(v.z, v.w) << 32); }
          s = wave_sum(s); ((float*)(F.ws + WS_SMP + SM_SS))[(size_t)r * 64 + F.lane] = (F.lane == 0) ? s : 0.f; } }
    MK_REFRESH(); xcd_barrier(bar, F.tid); MK_REFRESH();
    for (int l = 0; l < DEPTH; ++l) {
        {
            pg8::Gemm g{(const pg8::bf16_t*)(F.ws + WS_HB), (const pg8::bf16_t*)(F.ws + WS_WIN) + (size_t)l * DIN * DM, MP, DIN, DM}; pg8::StaticOrder S; S.init(MP, DIN, F.G, bx);
            pg8::EpiIn E{(pg8::bf16_t*)(F.ws + WS_ZB), (const float*)(F.ws + WS_T64), (const float*)(F.ws + WS_T32), outp + O_PWK + (size_t)l * NBATCH * 2048 * 512, outp + O_PWV + (size_t)l * NBATCH * 2048 * 512, (const float*)(F.ws + WS_SS1)};
            if (bx >= F.G / 2) for (int task = bx - F.G / 2; task < 224; task += F.G / 2) sample_win_task(F, task, (const bf16*)(F.ws + WS_WIN) + (size_t)l * DIN * DM, outp + O_SWK + (size_t)l * MS * 512, outp + O_SWV + (size_t)l * MS * 512);
            pg8::gemm_phase<pg8::EpiIn, pg8::StaticOrder, true, true>(F.lds + RING_OFF, g, S, E, F.tid);
        }
        MK_REFRESH(); xcd_barrier(bar, F.tid); MK_REFRESH();
        {
#define MK_SAMPLE_UNITS() do { \
                for (int u = F.G - 1 - F.vcu; u < 256; u += F.G) sample_attn_unit(F, u >> 3, u & 7, INP(I_CK) + (size_t)l * DBATCH * WCTX * 512, INP(I_CV) + (size_t)l * DBATCH * WCTX * 512); \
                for (int u = F.vcu; u < 128; u += F.G) sample_ret_unit(F, u >> 2, u & 3, INP(I_SRET) + (size_t)l * DBATCH * 4 * 16384, outp + O_SRET + (size_t)l * DBATCH * 4 * 16384, INP(I_GNW) + (size_t)l * 512); } while (0)
            if (F.vcu & 1) MK_SAMPLE_UNITS();
            attn_prompt_units(F);
            for (int u = F.vcu; u < 512; u += F.G) ret_upd_unit(F, u >> 5, u & 31);
            if (!(F.vcu & 1)) MK_SAMPLE_UNITS();
#undef MK_SAMPLE_UNITS
        }
        MK_REFRESH(); xcd_barrier(bar, F.tid); MK_REFRESH();
        ret_scan(F, outp + O_PRET + (size_t)l * NBATCH * 4 * 16384);
#if defined(DBG_NAIVE_RESID)
        sample_resid_naive(F, (const bf16*)(F.ws + WS_SMP + SM_CATB), (const bf16*)(F.ws + WS_WOUT) + (size_t)l * DM * DM, DM);
#else
        for (int task = bx; task < 256; task += F.G) sample_resid_task<128>(F, (const bf16*)(F.ws + WS_SMP + SM_CATB), (const bf16*)(F.ws + WS_WOUT) + (size_t)l * DM * DM, DM, task);
#endif
        MK_REFRESH(); xcd_barrier(bar, F.tid); MK_REFRESH();
        { for (int u = F.vcu; u < 256; u += F.G) ret_out_pair(F, u, INP(I_GNW) + (size_t)l * 512); combine_prompt(F); }
        MK_REFRESH(); xcd_barrier(bar, F.tid); MK_REFRESH();
        {
            pg8::Gemm g{(const pg8::bf16_t*)(F.ws + WS_CATB), (const pg8::bf16_t*)(F.ws + WS_WOUT) + (size_t)l * DM * DM, MP, DM, DM}; pg8::StaticOrder S; S.init(MP, DM, F.G, bx);
            pg8::EpiResidNorm E{(pg8::bf16_t*)(F.ws + WS_HB), (float*)(F.ws + WS_SS2)};
            pg8::gemm_phase<pg8::EpiResidNorm, pg8::StaticOrder, true, true>(F.lds + RING_OFF, g, S, E, F.tid);
        }
        MK_REFRESH(); xcd_barrier(bar, F.tid); MK_REFRESH();
        {
            pg8::Gemm g{(const pg8::bf16_t*)(F.ws + WS_HB), (const pg8::bf16_t*)(F.ws + WS_WUP) + (size_t)l * DUP * DM, MP, DUP, DM}; pg8::StaticOrder S; S.init(MP, DUP, F.G, bx);
            pg8::EpiUpConv E{(pg8::bf16_t*)(F.ws + WS_AB), (float*)(F.ws + WS_UB), outp + O_PCONV + (size_t)l * NBATCH * 2 * DUP, INP(I_CW) + (size_t)l * 3 * DUP, INP(I_CB) + (size_t)l * DUP, (PG8_LAS float*)(F.lds + EXB_OFF), (const float*)(F.ws + WS_SS2)};
            if (bx >= F.G / 2) for (int task = bx - F.G / 2; task < 352; task += F.G / 2) sample_up_task(F, task, (const bf16*)(F.ws + WS_WUP) + (size_t)l * DUP * DM, INP(I_SCONV) + (size_t)l * DBATCH * 2 * DUP, INP(I_CW) + (size_t)l * 3 * DUP, INP(I_CB) + (size_t)l * DUP, outp + O_SCONV + (size_t)l * DBATCH * 2 * DUP);
            pg8::gemm_phase<pg8::EpiUpConv, pg8::StaticOrder, true, true>(F.lds + RING_OFF, g, S, E, F.tid);
        }
        MK_REFRESH(); xcd_barrier(bar, F.tid); MK_REFRESH();
        {
            conv_fixup_phase(F, INP(I_CW) + (size_t)l * 3 * DUP, INP(I_CB) + (size_t)l * DUP);
#if defined(DBG_NAIVE_RESID)
            sample_resid_naive(F, (const bf16*)(F.ws + WS_SMP + SM_AB), (const bf16*)(F.ws + WS_WDN) + (size_t)l * DM * DFF, DFF);
#else
            for (int task = bx; task < 256; task += F.G) sample_resid_task<352>(F, (const bf16*)(F.ws + WS_SMP + SM_AB), (const bf16*)(F.ws + WS_WDN) + (size_t)l * DM * DFF, DFF, task);
#endif
        }
        MK_REFRESH(); xcd_barrier(bar, F.tid); MK_REFRESH();
        {
            pg8::Gemm g{(const pg8::bf16_t*)(F.ws + WS_AB), (const pg8::bf16_t*)(F.ws + WS_WDN) + (size_t)l * DM * DFF, MP, DM, DFF}; pg8::StaticOrder S; S.init(MP, DM, F.G, bx);
            pg8::EpiResidNorm E{(pg8::bf16_t*)(F.ws + WS_HB), (float*)(F.ws + WS_SS1)};
            pg8::gemm_phase<pg8::EpiResidNorm, pg8::StaticOrder, true, true>(F.lds + RING_OFF, g, S, E, F.tid);
        }
        MK_REFRESH(); xcd_barrier(bar, F.tid); MK_REFRESH();
    }
    final_norm_phase(F, (const bf16*)(F.ws + WS_HB), XS, INP(I_FNW), outp + O_YP, outp + O_YS);
}

extern "C" void kernel_launch(void* const* d_in, const int* in_sizes, int n_in, void* d_out, int out_size, void* d_ws, size_t ws_size, hipStream_t stream) {
    static int grid = 0;
    if (grid == 0) {
        if (n_in != 16 || (size_t)out_size != O_END || ws_size < WS_OPT_END) { fprintf(stderr, "kernel_launch: unexpected sizes (n_in %d out %d ws %zu)\n", n_in, out_size, ws_size); grid = -1; return; }
        int dev = 0, cus = 0, per_cu = 0;
        if (hipGetDevice(&dev) != hipSuccess || hipDeviceGetAttribute(&cus, hipDeviceAttributeMultiprocessorCount, dev) != hipSuccess) { grid = -1; return; }
        if (hipFuncSetAttribute((const void*)mk_fwd, hipFuncAttributeMaxDynamicSharedMemorySize, LDS_BYTES) != hipSuccess) { fprintf(stderr, "kernel_launch: hipFuncSetAttribute failed\n"); grid = -1; return; }
        if (hipOccupancyMaxActiveBlocksPerMultiprocessor(&per_cu, (const void*)mk_fwd, NWAVES * 64, LDS_BYTES) != hipSuccess || per_cu < 1) { fprintf(stderr, "kernel_launch: occupancy query says %d blocks per CU\n", per_cu); }
        (void)hipGetLastError();
        grid = cus;
    }
    if (grid < 0) return;
    if (hipMemsetAsync((char*)d_ws + WS_CTL, 0, CTL_ZERO_BYTES, stream) != hipSuccess) return;
    Args a{}; for (int i = 0; i < 16; ++i) a.in[i] = (const float*)d_in[i];
    a.out = (float*)d_out; a.ws = (unsigned char*)d_ws; a.layer = 0; a.pad = 0;
    hipLaunchKernelGGL(mk_fwd, dim3(grid), dim3(NWAVES * 64), LDS_BYTES, stream, a);
}
```

```cpp
#include <hip/hip_runtime.h>
#include <cstdio>
#include <cstdint>
#include <cmath>
namespace pg8 {
#define PG8_LAS __attribute__((address_space(3)))
typedef unsigned short bf16_t;
typedef short bf16x8 __attribute__((ext_vector_type(8)));
typedef float f32x4 __attribute__((ext_vector_type(4)));
typedef unsigned u32x4 __attribute__((ext_vector_type(4)));
constexpr int BM = 256, BK = 64, HALF = 128, HTB = HALF * BK * 2  , STAGE_BYTES = 8 * HTB, NXCD = 8, WGM = 8;

__host__ __device__ __forceinline__ int lds_byte(int r, int c) { const int st = (r >> 4) * 2 + (c >> 5), rr = r & 15, cc = c & 31, ob = rr * 64 + cc * 2; return st * 1024 + (ob ^ (((ob >> 9) & 1) << 5)); }
__host__ __device__ __forceinline__ void stage_rc(int b, int& R, int& C) { const int st = b / 1024, sb = b % 1024, swz = sb ^ (((sb >> 9) & 1) << 5); R = (st >> 1) * 16 + swz / 64; C = (st & 1) * 32 + (swz % 64) / 2; }
__host__ __device__ __forceinline__ int perm32(int rho) { const int n = rho >> 4, i = rho & 15; return 8 * (i >> 2) + 4 * n + (i & 3); }

struct Unit { int pm, pn; };
struct Gemm { const bf16_t* A; const bf16_t* Bt; int M, N, K; };

struct StaticOrder {
    int nM, nN, nwg, G, c;
    __host__ __device__ void init(int M, int N, int G_, int c_) { nM = M / BM; nN = N / BM; nwg = nM * nN; G = G_; c = c_; }
    __host__ __device__ bool next(int i, Unit& u) const {
        const long L = (long)i * G + c; if (L >= nwg) return false;
        int wgid = (int)L; { const int q = nwg / NXCD, r = nwg % NXCD, xcd = wgid % NXCD, off = wgid / NXCD; wgid = (xcd < r ? xcd * (q + 1) : r * (q + 1) + (xcd - r) * q) + off; }
        const int nig = WGM * nN, gid = wgid / nig, fm = gid * WGM, gsz = (nM - fm) < WGM ? (nM - fm) : WGM;
        u.pm = fm + ((wgid % nig) % gsz); u.pn = (wgid % nig) / gsz; return true;
    }
    __device__ __forceinline__ void a_ready(const Unit&) const {}
    __device__ __forceinline__ void done(const Unit&) const {}
};

__device__ __forceinline__ unsigned cvt_pk_bf16(float lo, float hi) { unsigned r; asm volatile("v_cvt_pk_bf16_f32 %0, %1, %2" : "=v"(r) : "v"(lo), "v"(hi)); return r; }
typedef float f32x2 __attribute__((ext_vector_type(2)));
constexpr float KR_SCALE = 0.08838834764831845f;
constexpr float QA_SCALE = 0.125f * 1.4426950408889634f;
constexpr int ZLD = 3584;
__device__ __forceinline__ float row_rstd(const float* ssp, int row, int fq) {
    const f32x4 a = *(const f32x4*)(ssp + (size_t)row * 16 + 4 * fq); float s = (a[0] + a[1]) + (a[2] + a[3]); s += __shfl_xor(s, 16); s += __shfl_xor(s, 32); return 1.f / sqrtf(s * (1.f / 1024.f) + 1e-6f); }
__device__ __forceinline__ u32x4 pack8(const f32x4& a, const f32x4& b) { u32x4 w; w.x = cvt_pk_bf16(a[0], a[1]); w.y = cvt_pk_bf16(a[2], a[3]); w.z = cvt_pk_bf16(b[0], b[1]); w.w = cvt_pk_bf16(b[2], b[3]); return w; }
struct EpiIn {
    static constexpr bool PERM = true, AFTER_DRAIN = false, APERM = false;
    bf16_t* Z; const float* T64; const float* T32; float* pwk; float* pwv; const float* ss;
    __device__ __forceinline__ void operator()(const f32x4 (&acc)[2][2][4][2], const Unit& u, int wr, int wc, int fr, int fq) const {
        const int pn = u.pn; const int row0 = u.pm * BM + wr * 64 + fr;
        if ((pn >= 4 && pn < 8) || pn >= 12) {
            const int colb = pn * BM + wc * 32 + 8 * fq;
#pragma unroll
            for (int ai = 0; ai < 2; ++ai)
#pragma unroll
                for (int m = 0; m < 4; ++m) { const int row = row0 + ai * HALF + m * 16; bf16_t* rowp = Z + (size_t)row * ZLD + colb; const float rs = row_rstd(ss, row, fq);
#pragma unroll
                    for (int bj = 0; bj < 2; ++bj) { const f32x4 v0 = acc[ai][bj][m][0] * rs, v1 = acc[ai][bj][m][1] * rs;
                        *(u32x4*)(rowp + bj * HALF) = pack8(v0, v1);
                        if (pn >= 12) { const int t = row & 4095; if (t >= 2048) { float* o = pwv + ((size_t)((row >> 12) * 2048 + (t - 2048))) * 512 + (colb + bj * HALF - 3072); *(f32x4*)o = v0; *(f32x4*)(o + 4) = v1; } } } }
        } else {
            const bool hd128 = pn < 4;
            int featbase, d0, half, tstride; const float* T;
            if (hd128) { const int head = 2 * (pn & 1) + (wc >> 1); d0 = 32 * (wc & 1) + 8 * fq; featbase = (pn >> 1) * 512 + head * 128 + d0; half = 64; T = T64; tstride = 64; }
            else { const int head = 4 * (pn & 1) + wc; d0 = 8 * fq; featbase = 2048 + ((pn - 8) >> 1) * 512 + head * 64 + d0; half = 32; T = T32; tstride = 32; }
            const float sc0 = (pn < 2) ? 1.f : (pn < 4) ? KR_SCALE : (pn < 10) ? QA_SCALE : 1.f;
            const bool is_ka = (pn == 10 || pn == 11);
            f32x4 nc0, nc1, nc2, nc3, np;
            { const f32x4* tp = (const f32x4*)(T + ((size_t)(row0 & 4095) * tstride + d0) * 2); nc0 = tp[0]; nc1 = tp[1]; nc2 = tp[2]; nc3 = tp[3]; np = *(const f32x4*)(ss + (size_t)row0 * 16 + 4 * fq); }
#pragma unroll
            for (int ai = 0; ai < 2; ++ai)
#pragma unroll
                for (int m = 0; m < 4; ++m) { const int row = row0 + ai * HALF + m * 16; const int t = row & 4095;
                    const f32x4 cs0 = nc0, cs1 = nc1, cs2 = nc2, cs3 = nc3; const f32x4 pp = np;
                    if (ai * 4 + m < 7) { const int rown = row0 + ((ai * 4 + m + 1) >> 2) * HALF + ((ai * 4 + m + 1) & 3) * 16;
                        const f32x4* tp = (const f32x4*)(T + ((size_t)(rown & 4095) * tstride + d0) * 2); nc0 = tp[0]; nc1 = tp[1]; nc2 = tp[2]; nc3 = tp[3]; np = *(const f32x4*)(ss + (size_t)rown * 16 + 4 * fq); }
                    __builtin_amdgcn_sched_barrier(0);
                    float sq = (pp[0] + pp[1]) + (pp[2] + pp[3]); sq += __shfl_xor(sq, 16); sq += __shfl_xor(sq, 32); const float sc = sc0 / sqrtf(sq * (1.f / 1024.f) + 1e-6f);
                    const f32x4 xa0 = acc[ai][0][m][0], xa1 = acc[ai][0][m][1], xb0 = acc[ai][1][m][0], xb1 = acc[ai][1][m][1];
                    f32x4 o10, o11, o20, o21;
                    o10[0] = (xa0[0] * cs0[0] - xb0[0] * cs0[1]) * sc; o20[0] = (xb0[0] * cs0[0] + xa0[0] * cs0[1]) * sc;
                    o10[1] = (xa0[1] * cs0[2] - xb0[1] * cs0[3]) * sc; o20[1] = (xb0[1] * cs0[2] + xa0[1] * cs0[3]) * sc;
                    o10[2] = (xa0[2] * cs1[0] - xb0[2] * cs1[1]) * sc; o20[2] = (xb0[2] * cs1[0] + xa0[2] * cs1[1]) * sc;
                    o10[3] = (xa0[3] * cs1[2] - xb0[3] * cs1[3]) * sc; o20[3] = (xb0[3] * cs1[2] + xa0[3] * cs1[3]) * sc;
                    o11[0] = (xa1[0] * cs2[0] - xb1[0] * cs2[1]) * sc; o21[0] = (xb1[0] * cs2[0] + xa1[0] * cs2[1]) * sc;
                    o11[1] = (xa1[1] * cs2[2] - xb1[1] * cs2[3]) * sc; o21[1] = (xb1[1] * cs2[2] + xa1[1] * cs2[3]) * sc;
                    o11[2] = (xa1[2] * cs3[0] - xb1[2] * cs3[1]) * sc; o21[2] = (xb1[2] * cs3[0] + xa1[2] * cs3[1]) * sc;
                    o11[3] = (xa1[3] * cs3[2] - xb1[3] * cs3[3]) * sc; o21[3] = (xb1[3] * cs3[2] + xa1[3] * cs3[3]) * sc;
                    bf16_t* rowp = Z + (size_t)row * ZLD + featbase;
                    *(u32x4*)rowp = pack8(o10, o11); *(u32x4*)(rowp + half) = pack8(o20, o21);
                    if (is_ka && t >= 2048) { float* o = pwk + ((size_t)((row >> 12) * 2048 + (t - 2048))) * 512 + (featbase - 2560);
                        *(f32x4*)o = o10; *(f32x4*)(o + 4) = o11; *(f32x4*)(o + half) = o20; *(f32x4*)(o + half + 4) = o21; } }
        }
    }
};
struct EpiResid {
    static constexpr bool PERM = false, AFTER_DRAIN = false, APERM = false;
    const float* base; float* out;
    __device__ __forceinline__ void operator()(const f32x4 (&acc)[2][2][4][2], const Unit& u, int wr, int wc, int fr, int fq) const {
        const int col0 = u.pn * BM + wc * 32 + 4 * fq;
#pragma unroll
        for (int ai = 0; ai < 2; ++ai)
#pragma unroll
            for (int m = 0; m < 4; ++m) { const size_t off = (size_t)(u.pm * BM + ai * HALF + wr * 64 + m * 16 + fr) * 1024 + col0;
#pragma unroll
                for (int bj = 0; bj < 2; ++bj)
#pragma unroll
                    for (int n = 0; n < 2; ++n) { const f32x4 b = *(const f32x4*)(base + off + bj * HALF + n * 16); *(f32x4*)(out + off + bj * HALF + n * 16) = b + acc[ai][bj][m][n]; } }
    }
};
struct EpiResidNorm {
    static constexpr bool PERM = true, AFTER_DRAIN = false, APERM = false;
    bf16_t* xb; float* ss;
    __device__ __forceinline__ void operator()(const f32x4 (&acc)[2][2][4][2], const Unit& u, int wr, int wc, int fr, int fq) const {
        const int col0 = u.pn * BM + wc * 32 + 8 * fq;
#pragma unroll
        for (int ai = 0; ai < 2; ++ai) {
            u32x4 xin[2][4][2];
#pragma unroll
            for (int m = 0; m < 4; ++m)
#pragma unroll
                for (int bj = 0; bj < 2; ++bj) xin[ai][m][bj] = *(const u32x4*)(xb + (size_t)(u.pm * BM + ai * HALF + wr * 64 + m * 16 + fr) * 1024 + col0 + bj * HALF);
#pragma unroll
            for (int m = 0; m < 4; ++m) { const int row = u.pm * BM + ai * HALF + wr * 64 + m * 16 + fr; const size_t off = (size_t)row * 1024 + col0; float s = 0.f;
#pragma unroll
                for (int bj = 0; bj < 2; ++bj) { const u32x4 b = xin[ai][m][bj];
                    f32x4 x0, x1;
                    x0[0] = __uint_as_float(b.x << 16) + acc[ai][bj][m][0][0]; x0[1] = __uint_as_float(b.x & 0xffff0000u) + acc[ai][bj][m][0][1]; x0[2] = __uint_as_float(b.y << 16) + acc[ai][bj][m][0][2]; x0[3] = __uint_as_float(b.y & 0xffff0000u) + acc[ai][bj][m][0][3];
                    x1[0] = __uint_as_float(b.z << 16) + acc[ai][bj][m][1][0]; x1[1] = __uint_as_float(b.z & 0xffff0000u) + acc[ai][bj][m][1][1]; x1[2] = __uint_as_float(b.w << 16) + acc[ai][bj][m][1][2]; x1[3] = __uint_as_float(b.w & 0xffff0000u) + acc[ai][bj][m][1][3];
                    *(u32x4*)(xb + off + bj * HALF) = pack8(x0, x1);
                    s += (x0[0] * x0[0] + x0[1] * x0[1]) + (x0[2] * x0[2] + x0[3] * x0[3]) + (x1[0] * x1[0] + x1[1] * x1[1]) + (x1[2] * x1[2] + x1[3] * x1[3]); }
                s += __shfl_xor(s, 16); s += __shfl_xor(s, 32);
                if (fq == 0) ss[(size_t)row * 16 + u.pn * 4 + wc] = s; }
        }
    }
};
struct EpiUp {
    static constexpr bool PERM = true, AFTER_DRAIN = false, APERM = false;
    bf16_t* U; float* pconv;
    __device__ __forceinline__ void operator()(const f32x4 (&acc)[2][2][4][2], const Unit& u, int wr, int wc, int fr, int fq) const {
        const int row0 = u.pm * BM + wr * 64 + fr, col0 = u.pn * BM + wc * 32 + 8 * fq;
#pragma unroll
        for (int ai = 0; ai < 2; ++ai)
#pragma unroll
            for (int m = 0; m < 4; ++m) { const int row = row0 + ai * HALF + m * 16; bf16_t* rowp = U + (size_t)row * 5632 + col0; const int t = row & 4095;
#pragma unroll
                for (int bj = 0; bj < 2; ++bj) { const f32x4 v0 = acc[ai][bj][m][0], v1 = acc[ai][bj][m][1];
                    *(u32x4*)(rowp + bj * HALF) = pack8(v0, v1);
                    if (t >= 4094) { float* o = pconv + ((size_t)((row >> 12) * 2 + (t - 4094))) * 5632 + col0 + bj * HALF; *(f32x4*)o = v0; *(f32x4*)(o + 4) = v1; } } }
    }
};

#define PG8_DPP(oldv, src, ctrl) __builtin_bit_cast(float, __builtin_amdgcn_update_dpp(__builtin_bit_cast(int, (oldv)), __builtin_bit_cast(int, (src)), (ctrl), 0xf, 0xf, false))
__device__ __forceinline__ float silu_fast(float x) { return x * __builtin_amdgcn_rcpf(1.f + __expf(-x)); }
struct EpiUpConv {
    static constexpr bool PERM = true, AFTER_DRAIN = false, APERM = true;
    bf16_t* AB; float* ubnd; float* pconv; const float* cw; const float* cb; PG8_LAS float* exb; const float* ss;
    __device__ __forceinline__ void operator()(f32x4 (&acc)[2][2][4][2], const Unit& u, int wr, int wc, int fr, int fq) const {
        const int pn = u.pn, pm = u.pm, cloc = wc * 32 + 8 * fq, gcol = 128 * pn + cloc;
        PG8_LAS float* cwl = exb + 2048;
        { int fr_ = fr; asm volatile("" : "+v"(fr_));
          const int tid = ((wr * 4 + wc) * 4 + fq) * 16 + fr_;
#pragma unroll
          for (int k = 0; k < 2; ++k) { const int i = tid + 512 * k, which = i >> 8, col = i & 255; const int feat = col < 128 ? 128 * pn + col : 2816 + 128 * pn + (col - 128);
              cwl[i] = which < 3 ? cw[which * 5632 + feat] : cb[feat]; } }
#pragma unroll
        for (int ai = 0; ai < 2; ++ai)
#pragma unroll
            for (int m = 0; m < 4; ++m) { const float rs = row_rstd(ss, pm * BM + ai * HALF + wr * 64 + 4 * fr + m, fq);
#pragma unroll
                for (int bj = 0; bj < 2; ++bj)
#pragma unroll
                    for (int n = 0; n < 2; ++n) acc[ai][bj][m][n] *= rs; }
        if (fr == 15) {
#pragma unroll
            for (int ai = 0; ai < 2; ++ai)
#pragma unroll
                for (int bj = 0; bj < 2; ++bj)
#pragma unroll
                    for (int n = 0; n < 2; ++n) { PG8_LAS float* d = exb + ((2 * ai + wr) * 2) * 256 + bj * 128 + cloc + 4 * n; *(PG8_LAS f32x4*)d = acc[ai][bj][2][n]; *(PG8_LAS f32x4*)(d + 256) = acc[ai][bj][3][n]; }
            if (wr == 1) {
#pragma unroll
                for (int bj = 0; bj < 2; ++bj)
#pragma unroll
                    for (int n = 0; n < 2; ++n)
#pragma unroll
                        for (int k = 0; k < 2; ++k) { *(f32x4*)(ubnd + ((size_t)(pm * 4 + 2 + k) * 5632 + bj * 2816 + gcol + 4 * n)) = acc[1][bj][2 + k][n];
                            if ((pm & 15) == 15) *(f32x4*)(pconv + ((size_t)((pm >> 4) * 2 + k) * 5632 + bj * 2816 + gcol + 4 * n)) = acc[1][bj][2 + k][n]; }
            }
        }
        if (wr == 0 && fr == 0) {
#pragma unroll
            for (int bj = 0; bj < 2; ++bj)
#pragma unroll
                for (int n = 0; n < 2; ++n)
#pragma unroll
                    for (int k = 0; k < 2; ++k) *(f32x4*)(ubnd + ((size_t)(pm * 4 + k) * 5632 + bj * 2816 + gcol + 4 * n)) = acc[0][bj][k][n];
        }
        asm volatile("s_waitcnt vmcnt(0) lgkmcnt(0)" ::: "memory"); __builtin_amdgcn_s_barrier(); asm volatile("" ::: "memory");
#pragma unroll
        for (int ai = 0; ai < 2; ++ai) {
            const int s = 2 * ai + wr;
#pragma unroll
            for (int n = 0; n < 2; ++n) {
                const int cl = cloc + 4 * n;
                float o[1][4][4];
                f32x4 Bg0 = {0.f, 0.f, 0.f, 0.f}, Bg1 = Bg0, Bv0 = Bg0, Bv1 = Bg0;
                if (s > 0) { const PG8_LAS float* eb = exb + ((s - 1) * 2) * 256 + cl;
                    Bg0 = *(const PG8_LAS f32x4*)eb; Bg1 = *(const PG8_LAS f32x4*)(eb + 256); Bv0 = *(const PG8_LAS f32x4*)(eb + 128); Bv1 = *(const PG8_LAS f32x4*)(eb + 256 + 128); }
                {
                    const f32x4 wg0 = *(const PG8_LAS f32x4*)(cwl + cl), wg1 = *(const PG8_LAS f32x4*)(cwl + 256 + cl), wg2 = *(const PG8_LAS f32x4*)(cwl + 512 + cl), bg = *(const PG8_LAS f32x4*)(cwl + 768 + cl);
#pragma unroll
                    for (int i = 0; i < 4; ++i) {
                        const float g0 = acc[ai][0][0][n][i], g1 = acc[ai][0][1][n][i], g2 = acc[ai][0][2][n][i], g3 = acc[ai][0][3][n][i];
                        float og1 = Bg1[i], og0 = Bg0[i];
                        asm volatile("" : "+v"(og1), "+v"(og0));
                        const float pg3 = PG8_DPP(og1, g3, 0x111), pg2 = PG8_DPP(og0, g2, 0x111);
                        o[0][0][i] = silu_fast(bg[i] + wg2[i] * g0 + wg1[i] * pg3 + wg0[i] * pg2);
                        o[0][1][i] = silu_fast(bg[i] + wg2[i] * g1 + wg1[i] * g0 + wg0[i] * pg3);
                        o[0][2][i] = silu_fast(bg[i] + wg2[i] * g2 + wg1[i] * g1 + wg0[i] * g0);
                        o[0][3][i] = silu_fast(bg[i] + wg2[i] * g3 + wg1[i] * g2 + wg0[i] * g1);
                    }
                }
                {
                    const f32x4 wv0 = *(const PG8_LAS f32x4*)(cwl + 128 + cl), wv1 = *(const PG8_LAS f32x4*)(cwl + 256 + 128 + cl), wv2 = *(const PG8_LAS f32x4*)(cwl + 512 + 128 + cl), bv = *(const PG8_LAS f32x4*)(cwl + 768 + 128 + cl);
#pragma unroll
                    for (int i = 0; i < 4; ++i) {
                        const float v0 = acc[ai][1][0][n][i], v1 = acc[ai][1][1][n][i], v2 = acc[ai][1][2][n][i], v3 = acc[ai][1][3][n][i];
                        float ov1 = Bv1[i], ov0 = Bv0[i];
                        asm volatile("" : "+v"(ov1), "+v"(ov0));
                        const float pv3 = PG8_DPP(ov1, v3, 0x111), pv2 = PG8_DPP(ov0, v2, 0x111);
                        o[0][0][i] *= bv[i] + wv2[i] * v0 + wv1[i] * pv3 + wv0[i] * pv2;
                        o[0][1][i] *= bv[i] + wv2[i] * v1 + wv1[i] * v0 + wv0[i] * pv3;
                        o[0][2][i] *= bv[i] + wv2[i] * v2 + wv1[i] * v1 + wv0[i] * v0;
                        o[0][3][i] *= bv[i] + wv2[i] * v3 + wv1[i] * v2 + wv0[i] * v1;
                    }
                }
#pragma unroll
                for (int m = 0; m < 4; ++m) { const int row = pm * BM + ai * HALF + wr * 64 + 4 * fr + m;
                    typedef unsigned u32x2 __attribute__((ext_vector_type(2)));
                    u32x2 w; w.x = cvt_pk_bf16(o[0][m][0], o[0][m][1]); w.y = cvt_pk_bf16(o[0][m][2], o[0][m][3]);
                    *(u32x2*)(AB + (size_t)row * 2816 + gcol + 4 * n) = w; }
            }
        }
    }
};
template <class Epi, class Sched, bool ALIGN_EPI = false, bool SP2 = false>
__device__ __forceinline__ void gemm_phase(PG8_LAS unsigned char* lds, const Gemm g, const Sched& S, const Epi& E, int tid_in) {
    int tid_ = tid_in; asm volatile("" : "+v"(tid_));
    const int tid = tid_, wid = __builtin_amdgcn_readfirstlane(tid >> 6), lane = tid & 63, wr = wid >> 2, wc = wid & 3, fr = lane & 15, fq = lane >> 4;
    const int K = g.K, nt = K / BK;
    unsigned voffA[2], voffB[2];
#pragma unroll
    for (int i = 0; i < 2; ++i) { int R, C; stage_rc(tid * 16 + i * 8192, R, C); const int Rb = Epi::PERM ? ((R & ~31) + perm32(R & 31)) : R;
        const int Ra = Epi::APERM ? ((R & 64) | ((R & 15) << 2) | ((R >> 4) & 3)) : R;
        voffA[i] = (unsigned)(Ra * K + C) * 2u; voffB[i] = (unsigned)(Rb * K + C) * 2u; }
    const size_t kstep = (size_t)(BK * 2);
    const size_t hstep = (size_t)HALF * K * 2;
    const size_t tstep = 2 * hstep;
    const unsigned ldsw = (unsigned)wid * 1024u;
    const int aoff = lds_byte(wr * 64 + fr, fq * 8), boff = lds_byte(wc * 32 + fr, fq * 8);
#define PG8_SA(b, h) (((b) * 2 + (h)) * HTB)
#define PG8_SB(b, h) ((4 + (b) * 2 + (h)) * HTB)
#define PG8_STAGE(bufoff, gbase, voff) do { _Pragma("unroll") for (int _i = 0; _i < 2; ++_i) \
        __builtin_amdgcn_global_load_lds((const unsigned*)((const char*)(gbase) + (voff)[_i]), (PG8_LAS unsigned*)(lds + (bufoff) + ldsw + _i * 8192), 16, 0, 0); } while (0)
#define PG8_LDA(dst, b, h) do { _Pragma("unroll") for (int m = 0; m < 4; ++m) _Pragma("unroll") for (int k = 0; k < 2; ++k) dst[m][k] = *(const PG8_LAS bf16x8*)(lds + PG8_SA(b, h) + aoff + m * 2048 + k * 1024); } while (0)
#define PG8_LDB(dst, b, h) do { _Pragma("unroll") for (int n = 0; n < 2; ++n) _Pragma("unroll") for (int k = 0; k < 2; ++k) dst[n][k] = *(const PG8_LAS bf16x8*)(lds + PG8_SB(b, h) + boff + n * 2048 + k * 1024); } while (0)
#define PG8_MMA(ai, bj, At, Bt) do { __builtin_amdgcn_s_setprio(1); _Pragma("unroll") for (int m = 0; m < 4; ++m) _Pragma("unroll") for (int n = 0; n < 2; ++n) _Pragma("unroll") for (int k = 0; k < 2; ++k) \
        acc[ai][bj][m][n] = __builtin_amdgcn_mfma_f32_16x16x32_bf16(Bt[n][k], At[m][k], acc[ai][bj][m][n], 0, 0, 0); __builtin_amdgcn_s_setprio(0); } while (0)
#define PG8_WAIT_V(n) asm volatile("s_waitcnt vmcnt(" #n ")" ::: "memory")
#define PG8_WAIT_L(n) asm volatile("s_waitcnt lgkmcnt(" #n ")" ::: "memory")
#define PG8_BAR __builtin_amdgcn_s_barrier()
#define PG8_SCHED __builtin_amdgcn_sched_barrier(0)
    Unit cur, nxt; int ui = 0;
    if (!S.next(0, cur)) return;
    f32x4 acc[2][2][4][2];
#pragma unroll
    for (int a = 0; a < 2; ++a)
#pragma unroll
        for (int b = 0; b < 2; ++b)
#pragma unroll
            for (int m = 0; m < 4; ++m)
#pragma unroll
                for (int n = 0; n < 2; ++n) acc[a][b][m][n] = (f32x4){0.f, 0.f, 0.f, 0.f};
    bf16x8 At[4][2], B0[2][2], B1[2][2];
    const char* cA = (const char*)g.A + (size_t)cur.pm * tstep; const char* cB = (const char*)g.Bt + (size_t)cur.pn * tstep;
    S.a_ready(cur);
    if constexpr (SP2) {
        PG8_STAGE(PG8_SB(0, 0), cB, voffB); PG8_STAGE(PG8_SB(0, 1), cB + hstep, voffB); PG8_STAGE(PG8_SA(0, 0), cA, voffA); PG8_STAGE(PG8_SA(0, 1), cA + hstep, voffA);
        if (wr == 1) PG8_BAR;
        PG8_WAIT_V(2); PG8_BAR;
        PG8_STAGE(PG8_SB(1, 0), cB + kstep, voffB); PG8_STAGE(PG8_SA(1, 0), cA + kstep, voffA); PG8_STAGE(PG8_SB(1, 1), cB + hstep + kstep, voffB);
        PG8_WAIT_V(6); PG8_BAR;
    } else {
        PG8_STAGE(PG8_SB(0, 0), cB, voffB); PG8_STAGE(PG8_SA(0, 0), cA, voffA); PG8_STAGE(PG8_SB(0, 1), cB + hstep, voffB); PG8_STAGE(PG8_SA(0, 1), cA + hstep, voffA);
        if (wr == 1) PG8_BAR;
        PG8_WAIT_V(4); PG8_BAR;
        PG8_STAGE(PG8_SB(1, 0), cB + kstep, voffB); PG8_STAGE(PG8_SA(1, 0), cA + kstep, voffA); PG8_STAGE(PG8_SB(1, 1), cB + hstep + kstep, voffB);
        PG8_WAIT_V(6); PG8_BAR;
    }
    for (;;) {
        const bool has_next = S.next(ui + 1, nxt);
        const char* nA = has_next ? (const char*)g.A + (size_t)nxt.pm * tstep : cA; const char* nB = has_next ? (const char*)g.Bt + (size_t)nxt.pn * tstep : cB;
        for (int t = 0; t < nt; t += 2) {
            const bool last = (t == nt - 2);
            const char* a1 = cA + (size_t)(t + 1) * kstep;
            const char* a2 = last ? nA : cA + (size_t)(t + 2) * kstep; const char* b2 = last ? nB : cB + (size_t)(t + 2) * kstep;
            const char* a3 = a2 + kstep; const char* b3 = b2 + kstep;
            if (last && has_next) S.a_ready(nxt);
            if constexpr (SP2) {
            PG8_LDB(B0, 0, 0); PG8_LDB(B1, 0, 1); PG8_SCHED; PG8_LDA(At, 0, 0); PG8_STAGE(PG8_SA(1, 1), a1 + hstep, voffA);
            PG8_WAIT_V(8); PG8_WAIT_L(0); PG8_BAR; PG8_MMA(0, 0, At, B0); PG8_MMA(0, 1, At, B1); PG8_BAR; PG8_SCHED;
            PG8_LDA(At, 0, 1); PG8_STAGE(PG8_SB(0, 0), b2, voffB); PG8_STAGE(PG8_SB(0, 1), b2 + hstep, voffB); PG8_STAGE(PG8_SA(0, 0), a2, voffA);
            PG8_WAIT_V(8); PG8_WAIT_L(0); PG8_BAR; PG8_MMA(1, 0, At, B0); PG8_MMA(1, 1, At, B1); PG8_BAR; PG8_SCHED;
            PG8_LDB(B0, 1, 0); PG8_LDB(B1, 1, 1); PG8_SCHED; PG8_LDA(At, 1, 0); PG8_STAGE(PG8_SA(0, 1), a2 + hstep, voffA);
            PG8_WAIT_V(8); PG8_WAIT_L(0); PG8_BAR; PG8_MMA(0, 0, At, B0); PG8_MMA(0, 1, At, B1); PG8_BAR; PG8_SCHED;
            PG8_LDA(At, 1, 1); PG8_STAGE(PG8_SB(1, 0), b3, voffB); PG8_STAGE(PG8_SB(1, 1), b3 + hstep, voffB); PG8_STAGE(PG8_SA(1, 0), a3, voffA);
            PG8_WAIT_V(8); PG8_WAIT_L(0); PG8_BAR; PG8_MMA(1, 0, At, B0); PG8_MMA(1, 1, At, B1); PG8_BAR; PG8_SCHED;
            } else {
            PG8_LDB(B0, 0, 0); PG8_SCHED; PG8_LDA(At, 0, 0); PG8_STAGE(PG8_SA(1, 1), a1 + hstep, voffA);
            PG8_WAIT_L(8); PG8_BAR; PG8_WAIT_L(0); PG8_MMA(0, 0, At, B0); PG8_BAR; PG8_SCHED;
            PG8_LDB(B1, 0, 1); PG8_STAGE(PG8_SB(0, 0), b2, voffB);
            PG8_BAR; PG8_WAIT_L(0); PG8_MMA(0, 1, At, B1); PG8_BAR;
            PG8_LDA(At, 0, 1); PG8_STAGE(PG8_SA(0, 0), a2, voffA);
            PG8_BAR; PG8_WAIT_L(0); PG8_MMA(1, 0, At, B0); PG8_BAR; PG8_SCHED;
            PG8_STAGE(PG8_SB(0, 1), b2 + hstep, voffB);
            PG8_WAIT_V(6); PG8_BAR; PG8_MMA(1, 1, At, B1); PG8_BAR;
            PG8_LDB(B0, 1, 0); PG8_SCHED; PG8_LDA(At, 1, 0); PG8_STAGE(PG8_SA(0, 1), a2 + hstep, voffA);
            PG8_WAIT_L(8); PG8_BAR; PG8_WAIT_L(0); PG8_MMA(0, 0, At, B0); PG8_BAR; PG8_SCHED;
            PG8_LDB(B1, 1, 1); PG8_STAGE(PG8_SB(1, 0), b3, voffB);
            PG8_BAR; PG8_WAIT_L(0); PG8_MMA(0, 1, At, B1); PG8_BAR;
            PG8_LDA(At, 1, 1); PG8_STAGE(PG8_SA(1, 0), a3, voffA);
            PG8_BAR; PG8_WAIT_L(0); PG8_MMA(1, 0, At, B0); PG8_BAR; PG8_SCHED;
            PG8_STAGE(PG8_SB(1, 1), b3 + hstep, voffB);
            PG8_WAIT_V(6); PG8_BAR; PG8_MMA(1, 1, At, B1); PG8_BAR;
            }
        }
        if constexpr (ALIGN_EPI) { if (wr == 0) PG8_BAR; }
        if constexpr (!Epi::AFTER_DRAIN) { E(acc, cur, wr, wc, fr, fq); S.done(cur); }
        if (!has_next) break;
#pragma unroll
        for (int a = 0; a < 2; ++a)
#pragma unroll
            for (int b = 0; b < 2; ++b)
#pragma unroll
                for (int m = 0; m < 4; ++m)
#pragma unroll
                    for (int n = 0; n < 2; ++n) acc[a][b][m][n] = (f32x4){0.f, 0.f, 0.f, 0.f};
        cur = nxt; cA = nA; cB = nB; ++ui;
        if constexpr (ALIGN_EPI) { if (wr == 1) PG8_BAR; }
    }
    PG8_WAIT_V(0);
    if constexpr (!ALIGN_EPI) { if (wr == 0) PG8_BAR; }
    PG8_BAR;
    if constexpr (Epi::AFTER_DRAIN) { E.fused(acc, cur, wr, wc, fr, fq, lds, wid, lane); S.done(cur); }
#undef PG8_SA
#undef PG8_SB
#undef PG8_STAGE
#undef PG8_LDA
#undef PG8_LDB
#undef PG8_MMA
#undef PG8_WAIT_V
#undef PG8_WAIT_L
#undef PG8_BAR
#undef PG8_SCHED
}
}
#define GAS __attribute__((address_space(1)))
#define LAS __attribute__((address_space(3)))
typedef unsigned short bf16;
typedef unsigned v4u __attribute__((ext_vector_type(4)));
typedef float f32x4 __attribute__((ext_vector_type(4)));
typedef short bf16x8 __attribute__((ext_vector_type(8)));
typedef GAS unsigned gu32;
typedef GAS unsigned long long gu64;
#define RLX_AGENT __ATOMIC_RELAXED, __HIP_MEMORY_SCOPE_AGENT
#define LDS_WAIT() asm volatile("s_waitcnt lgkmcnt(0)" ::: "memory")
#define VM_WAIT() asm volatile("s_waitcnt vmcnt(0)" ::: "memory")
__device__ __forceinline__ unsigned long long rt() { return __builtin_amdgcn_s_memrealtime(); }
__device__ __forceinline__ unsigned f2bf(float f) { unsigned u = __builtin_bit_cast(unsigned, f); return (u + 0x7fffu + ((u >> 16) & 1u)) >> 16; }
__device__ __forceinline__ unsigned pk2(float lo, float hi) { return f2bf(lo) | (f2bf(hi) << 16); }
#define XB_TMO      128
#define XB_XCNT(j)  (256  + 64 * (j))
#define XB_XSUB(j)  (1280 + 64 * (j))
#define XB_XGEN(j)  (2304 + 64 * (j))
#define XB_TOP      3328
#define XB_TOPGEN   3392
#define XCD_BAR_WORDS 3456
#define XB_SPIN_CAP (1u << 18)

__device__ __forceinline__ unsigned xb_ld(unsigned* p)              { return __hip_atomic_load(p, __ATOMIC_RELAXED, __HIP_MEMORY_SCOPE_AGENT); }
__device__ __forceinline__ unsigned xb_add(unsigned* p, unsigned v) { return __hip_atomic_fetch_add(p, v, __ATOMIC_RELAXED, __HIP_MEMORY_SCOPE_AGENT); }
__device__ __forceinline__ unsigned xb_xcc_id() { return (unsigned)__builtin_amdgcn_s_getreg((3 << 11) | 20) & 0xFu; }
#define XB_SPIN(cond, bar) do { unsigned _sp = 0; while (cond) { __builtin_amdgcn_s_sleep(1); \
    if ((++_sp & 255u) == 0u) { if (xb_ld(&(bar)[XB_TMO])) break; if (_sp > XB_SPIN_CAP) { atomicAdd(&(bar)[XB_TMO], 1u); break; } } } } while (0)

struct XcdBarrier {
    unsigned* bar; unsigned x;
    volatile LAS unsigned* st;
};

__device__ __forceinline__ XcdBarrier xcd_barrier_post(unsigned* bar, volatile LAS unsigned* st) {
    XcdBarrier b; b.bar = bar; b.x = xb_xcc_id(); b.st = st;
    if (threadIdx.x == 0) (void)xb_add(&bar[XB_XCNT(b.x)], 1u);
    return b;
}
__device__ __forceinline__ void xcd_barrier_complete(unsigned* bar, unsigned x, unsigned& nloc, unsigned& nx) {
    const unsigned G = gridDim.x * gridDim.y * gridDim.z;
    unsigned sum, cnt, mine, sp = 0u;
    for (;;) {
        sum = 0u; cnt = 0u; mine = 0u;
#pragma unroll
        for (unsigned j = 0; j < 16; ++j) { const unsigned c = xb_ld(&bar[XB_XCNT(j)]); sum += c; cnt += (c > 0u) ? 1u : 0u; mine = (j == x) ? c : mine; }
        if (sum == G) break;
        __builtin_amdgcn_s_sleep(1);
        if ((++sp & 255u) == 0u) { if (xb_ld(&bar[XB_TMO])) break; if (sp > XB_SPIN_CAP) { atomicAdd(&bar[XB_TMO], 1u); break; } }
    }
    nloc = mine > 0u ? mine : 1u; nx = cnt > 0u ? cnt : 1u;
}

__device__ __forceinline__ void xcd_barrier(const XcdBarrier& b, int tid) {
    asm volatile("s_waitcnt vmcnt(0)" ::: "memory");
    __syncthreads();
    if (tid == 0) {
        unsigned* bar = b.bar; asm volatile("" : "+s"(bar));
        __builtin_amdgcn_s_waitcnt(0);
        unsigned bx_ = b.x; asm volatile("" : "+s"(bx_));
        unsigned nloc = b.st[0], nx = b.st[1];
        if (nloc == 0u) { xcd_barrier_complete(bar, bx_, nloc, nx); b.st[0] = nloc; b.st[1] = nx; }
        const unsigned old = xb_add(&bar[XB_XSUB(bx_)], 1u);
        const unsigned gen = old / nloc;
        if (old + 1u == (gen + 1u) * nloc) {
            __builtin_amdgcn_fence(__ATOMIC_RELEASE, "agent");
            asm volatile("s_waitcnt vmcnt(0)" ::: "memory");
            const unsigned og = xb_add(&bar[XB_TOP], 1u);
            const unsigned tg = og / nx;
            if (og + 1u == (tg + 1u) * nx) xb_add(&bar[XB_TOPGEN], 1u);
            else XB_SPIN(xb_ld(&bar[XB_TOPGEN]) == tg, bar);
            __builtin_amdgcn_fence(__ATOMIC_ACQUIRE, "agent");
            xb_add(&bar[XB_XGEN(bx_)], 1u);
            asm volatile("s_waitcnt vmcnt(0)" ::: "memory");
        } else {
            XB_SPIN(xb_ld(&bar[XB_XGEN(bx_)]) == gen, bar);
            __builtin_amdgcn_fence(__ATOMIC_ACQUIRE, "agent");
            asm volatile("s_waitcnt vmcnt(0)" ::: "memory");
        }
    }
    __syncthreads();
}
constexpr int NWAVES = 8;
constexpr int DM = 1024, NBATCH = 4, SEQ = 4096, DEPTH = 4, DBATCH = 32, DSEQ = 4, PAST = 8192;
constexpr int MP = NBATCH * SEQ, MS = DBATCH * DSEQ;
constexpr int DIN = 3584, DFF = 2816, DUP = 2 * DFF, WCTX = 2048;
constexpr int C_QR = 0, C_KR = 512, C_VR = 1024, C_GR = 1536, C_QA = 2048, C_KA = 2560, C_VA = 3072;
constexpr float EPS = 1e-6f;
constexpr int NPOS = SEQ + DSEQ;

__host__ __device__ __forceinline__ int in_feature(int nrow) {
    const int pn = nrow >> 8, tc = nrow & 255, bj = tc >> 7, j = tc & 127;
    if (pn < 4) return (pn >> 1) * 512 + (2 * (pn & 1) + (j >> 6)) * 128 + (j & 63) + 64 * bj;
    if (pn >= 8 && pn < 12) return 2048 + ((pn - 8) >> 1) * 512 + (4 * (pn & 1) + (j >> 5)) * 64 + (j & 31) + 32 * bj;
    return nrow;
}

__host__ __device__ __forceinline__ int up_feature(int nrow) { const int pn = nrow >> 8, tc = nrow & 255; return tc < 128 ? 128 * pn + tc : 2816 + 128 * pn + (tc - 128); }

constexpr size_t MiB = 1u << 20;
constexpr size_t WS_CTL = 0, CTL_ZERO_BYTES = 1 * MiB;
constexpr size_t WS_T64 = 1 * MiB;
constexpr size_t WS_T32 = 4 * MiB;
constexpr size_t WS_SS1 = 356 * MiB, WS_SS2 = 358 * MiB;
constexpr size_t WS_WIN = 6 * MiB;
constexpr size_t WS_WOUT = 34 * MiB;
constexpr size_t WS_WUP = 42 * MiB;
constexpr size_t WS_WDN = 86 * MiB;
constexpr size_t WS_XRES = 108 * MiB;
constexpr size_t WS_HB = 172 * MiB;
constexpr size_t WS_ZB = 204 * MiB;
constexpr size_t WS_CATB = 316 * MiB;
constexpr size_t WS_UB = 348 * MiB;
constexpr size_t WS_AB = 524 * MiB;
constexpr size_t WS_OG = 612 * MiB;
constexpr size_t WS_LSE = 660 * MiB;
constexpr size_t WS_UPD = 662 * MiB;
constexpr size_t WS_ST = 694 * MiB;
constexpr size_t WS_SMP = 710 * MiB;
constexpr size_t WS_OPT_END = 718 * MiB;
constexpr size_t WS_NAIVE = 720 * MiB;
constexpr size_t SM_X = 0;
constexpr size_t SM_HB = 512 * 1024;
constexpr size_t SM_ZB = 768 * 1024;
constexpr size_t SM_CATB = 1792 * 1024;
constexpr size_t SM_U = 2048 * 1024;
constexpr size_t SM_AB = 5120 * 1024;
constexpr size_t SM_SS = 6144 * 1024;
constexpr int CW_TMO = 0, CW_CODE = 1, CW_BAR = 4096;

constexpr int RING_OFF = 0, RING_BYTES = 131072;
constexpr int LDSCTL_OFF = RING_BYTES, MISC_OFF = LDSCTL_OFF + 320;
constexpr int EXB_OFF = 132096;
constexpr int LDS_BYTES = 147456;
static_assert(MISC_OFF + 128 <= EXB_OFF && EXB_OFF + 8192 + 4096 <= LDS_BYTES, "LDS map");
struct Frame {
    LAS unsigned char* lds;
    volatile LAS unsigned* MISC;
    gu32* ctl;
    int tid, lane, wave;
    int vcu, G;
    unsigned char* ws;
};
struct Args { const float* in[16]; float* out; unsigned char* ws; int layer, pad; };

__device__ __forceinline__ float wave_sum(float v) {
#pragma unroll
    for (int o = 1; o < 64; o <<= 1) v += __shfl_xor(v, o);
    return v;
}
__device__ __forceinline__ float silu_f(float x) { return x / (1.f + __expf(-x)); }

struct P0Item { const float* src; bf16* dst; const float* ksc; int K, N; };
__device__ __forceinline__ void p0_item_load(const P0Item& I, f32x4 (&v)[8], int lane) {
#pragma unroll
    for (int i = 0; i < 8; ++i) v[i] = *(const GAS f32x4*)(I.src + (size_t)((lane >> 3) + 8 * i) * I.N + 4 * (lane & 7));
}
__device__ __forceinline__ void p0_item_store(const P0Item& I, const f32x4 (&v)[8], LAS float* scr, int lane) {
#pragma unroll
    for (int i = 0; i < 8; ++i) { const int kk = (lane >> 3) + 8 * i; const float sc = I.ksc ? I.ksc[kk] : 1.f; LAS float* d = scr + kk * 33 + 4 * (lane & 7);
        d[0] = v[i][0] * sc; d[1] = v[i][1] * sc; d[2] = v[i][2] * sc; d[3] = v[i][3] * sc; }
    LDS_WAIT(); asm volatile("" ::: "memory");
    const int c = lane & 7;
#pragma unroll
    for (int j = 0; j < 4; ++j) { const int n = (lane >> 3) + 8 * j; const LAS float* s = scr + (8 * c) * 33 + n;
        v4u o; o.x = pk2(s[0 * 33], s[1 * 33]); o.y = pk2(s[2 * 33], s[3 * 33]); o.z = pk2(s[4 * 33], s[5 * 33]); o.w = pk2(s[6 * 33], s[7 * 33]);
        *(GAS v4u*)(I.dst + (size_t)n * I.K + 8 * c) = o; }
    LDS_WAIT(); asm volatile("" ::: "memory");
}
constexpr int P0_I_IN = (DM / 64) * (DIN / 32), P0_I_OUT = (DM / 64) * (DM / 32), P0_I_UP = (DM / 64) * (DUP / 32), P0_I_DN = (DFF / 64) * (DM / 32), P0_I_L = P0_I_IN + P0_I_OUT + P0_I_UP + P0_I_DN;
__device__ __forceinline__ void p0_convert(Frame& F, const float* w_in, const float* w_out, const float* w_up, const float* w_dn, const float* n1w, const float* n2w, int it0, int it1, int gw, int NGW) {
    LAS float* scr = (LAS float*)(F.lds + RING_OFF + F.wave * 16384);
    constexpr int I_IN = P0_I_IN, I_OUT = P0_I_OUT, I_UP = P0_I_UP, I_L = P0_I_L;
    bf16* WIN = (bf16*)(F.ws + WS_WIN); bf16* WOUT = (bf16*)(F.ws + WS_WOUT); bf16* WUP = (bf16*)(F.ws + WS_WUP); bf16* WDN = (bf16*)(F.ws + WS_WDN);
    auto resolve = [&](int it) -> P0Item {
        const int l = it / I_L; int r = it % I_L; P0Item I;
        if (r < I_IN) { const int nblk = DIN / 32, kb = r / nblk, nb = r % nblk; I.K = DM; I.N = DIN; I.src = w_in + (size_t)l * DM * DIN + (size_t)(64 * kb) * DIN + in_feature(32 * nb); I.dst = WIN + (size_t)l * DIN * DM + (size_t)(32 * nb) * DM + 64 * kb; I.ksc = n1w + (size_t)l * DM + 64 * kb; return I; } r -= I_IN;
        if (r < I_OUT) { const int nblk = DM / 32, kb = r / nblk, nb = r % nblk; I.K = DM; I.N = DM; I.src = w_out + (size_t)l * DM * DM + (size_t)(64 * kb) * DM + 32 * nb; I.dst = WOUT + (size_t)l * DM * DM + (size_t)(32 * nb) * DM + 64 * kb; I.ksc = nullptr; return I; } r -= I_OUT;
        if (r < I_UP) { const int nblk = DUP / 32, kb = r / nblk, nb = r % nblk; I.K = DM; I.N = DUP; I.src = w_up + (size_t)l * DM * DUP + (size_t)(64 * kb) * DUP + up_feature(32 * nb); I.dst = WUP + (size_t)l * DUP * DM + (size_t)(32 * nb) * DM + 64 * kb; I.ksc = n2w + (size_t)l * DM + 64 * kb; return I; } r -= I_UP;
        { const int nblk = DM / 32, kb = r / nblk, nb = r % nblk; I.K = DFF; I.N = DM; I.src = w_dn + (size_t)l * DFF * DM + (size_t)(64 * kb) * DM + 32 * nb; I.dst = WDN + (size_t)l * DM * DFF + (size_t)(32 * nb) * DFF + 64 * kb; I.ksc = nullptr; return I; }
    };
    if (it0 + gw < it1) {
        P0Item cur = resolve(it0 + gw); f32x4 v[8]; p0_item_load(cur, v, F.lane);
#pragma unroll 1
        for (int it = it0 + gw; it < it1; it += NGW) {
            const bool more = it + NGW < it1; P0Item nxt = cur; f32x4 vn[8];
            if (more) { nxt = resolve(it + NGW); p0_item_load(nxt, vn, F.lane); }
            p0_item_store(cur, v, scr, F.lane);
            if (more) { cur = nxt;
#pragma unroll
                for (int i = 0; i < 8; ++i) v[i] = vn[i]; }
        }
    }
}
__device__ __forceinline__ void p0_prologue(Frame& F, const float* w_in, const float* w_out, const float* w_up, const float* w_dn, const float* n1w, const float* n2w, const float* xp) {
    const int gw = F.vcu * NWAVES + F.wave, NGW = F.G * NWAVES;
    p0_convert(F, w_in, w_out, w_up, w_dn, n1w, n2w, 0, DEPTH * P0_I_L, gw, NGW);
    { bf16* XB = (bf16*)(F.ws + WS_HB); float* SS1 = (float*)(F.ws + WS_SS1);
      for (int m = gw; m < MP; m += NGW) { const GAS f32x4* xr = (const GAS f32x4*)(xp + (size_t)m * DM) + F.lane; GAS unsigned long long* o8 = (GAS unsigned long long*)(XB + (size_t)m * DM) + F.lane; float s = 0.f;
#pragma unroll
          for (int j = 0; j < 4; ++j) { const f32x4 v = xr[64 * j]; s += (v.x * v.x + v.y * v.y) + (v.z * v.z + v.w * v.w); o8[64 * j] = (unsigned long long)pk2(v.x, v.y) | ((unsigned long long)pk2(v.z, v.w) << 32); }
          s = wave_sum(s); if (F.lane < 16) SS1[(size_t)m * 16 + F.lane] = (F.lane == 0) ? s : 0.f; } }
    float* T64 = (float*)(F.ws + WS_T64); float* T32 = (float*)(F.ws + WS_T32);
    const int gt = (F.vcu * NWAVES + F.wave) * 64 + F.lane, NT = F.G * NWAVES * 64;
    for (int i = gt; i < NPOS * 96; i += NT) {
        const int p = i / 96, k = i % 96; const float pos = (float)(p < SEQ ? p : PAST + (p - SEQ));
        float inv; float* dst;
        if (k < 64) { inv = powf(10000.f, -(float)k / 64.f); dst = T64 + ((size_t)p * 64 + k) * 2; }
        else { inv = powf(10000.f, -(float)(k - 64) / 32.f); dst = T32 + ((size_t)p * 32 + (k - 64)) * 2; }
        float sn, cs; sincosf(pos * inv, &sn, &cs); dst[0] = cs; dst[1] = sn;
    }
}
__device__ __forceinline__ void rms_row_to_bf16(const float* xrow, const float* w, bf16* orow, int lane) {
    const GAS f32x4* xr = (const GAS f32x4*)xrow + lane; const GAS f32x4* wr = (const GAS f32x4*)w + lane;
    f32x4 v[4]; float s = 0.f;
#pragma unroll
    for (int j = 0; j < 4; ++j) { v[j] = xr[64 * j]; s += (v[j].x * v[j].x + v[j].y * v[j].y) + (v[j].z * v[j].z + v[j].w * v[j].w); }
    const float rstd = 1.f / sqrtf(wave_sum(s) * (1.f / DM) + EPS);
    GAS unsigned long long* o8 = (GAS unsigned long long*)orow + lane;
#pragma unroll
    for (int j = 0; j < 4; ++j) { const f32x4 ww = wr[64 * j];
        o8[64 * j] = (unsigned long long)pk2(v[j].x * rstd * ww.x, v[j].y * rstd * ww.y) | ((unsigned long long)pk2(v[j].z * rstd * ww.z, v[j].w * rstd * ww.w) << 32); }
}
__device__ __forceinline__ void rms_row_to_f32(const float* xrow, const float* w, float* orow, int lane) {
    const GAS f32x4* xr = (const GAS f32x4*)xrow + lane; const GAS f32x4* wr = (const GAS f32x4*)w + lane;
    f32x4 v[4]; float s = 0.f;
#pragma unroll
    for (int j = 0; j < 4; ++j) { v[j] = xr[64 * j]; s += (v[j].x * v[j].x + v[j].y * v[j].y) + (v[j].z * v[j].z + v[j].w * v[j].w); }
    const float rstd = 1.f / sqrtf(wave_sum(s) * (1.f / DM) + EPS);
    GAS f32x4* o = (GAS f32x4*)orow + lane;
#pragma unroll
    for (int j = 0; j < 4; ++j) { const f32x4 ww = wr[64 * j]; o[64 * j] = (v[j] * rstd) * ww; }
}
__device__ __forceinline__ void norm_phase(Frame& F, const float* xp, const float* xs, const float* w) {
    const int gw = F.vcu * NWAVES + F.wave, NGW = F.G * NWAVES;
    bf16* HB = (bf16*)(F.ws + WS_HB); bf16* HS = (bf16*)(F.ws + WS_SMP + SM_HB);
    for (int m = gw; m < MP; m += NGW) rms_row_to_bf16(xp + (size_t)m * DM, w, HB + (size_t)m * DM, F.lane);
    for (int m = NGW - 1 - gw; m < MS; m += NGW) rms_row_to_bf16(xs + (size_t)m * DM, w, HS + (size_t)m * DM, F.lane);
}
__device__ __forceinline__ void rms_rowb_to_f32(const bf16* xrow, const float* w, float* orow, int lane) {
    const GAS unsigned long long* xr = (const GAS unsigned long long*)xrow + lane; const GAS f32x4* wr = (const GAS f32x4*)w + lane;
    f32x4 v[4]; float s = 0.f;
#pragma unroll
    for (int j = 0; j < 4; ++j) { const unsigned long long q = xr[64 * j]; v[j].x = __uint_as_float((unsigned)q << 16); v[j].y = __uint_as_float((unsigned)q & 0xffff0000u); v[j].z = __uint_as_float((unsigned)(q >> 32) << 16); v[j].w = __uint_as_float((unsigned)(q >> 32) & 0xffff0000u);
        s += (v[j].x * v[j].x + v[j].y * v[j].y) + (v[j].z * v[j].z + v[j].w * v[j].w); }
    const float rstd = 1.f / sqrtf(wave_sum(s) * (1.f / DM) + EPS);
    GAS f32x4* o = (GAS f32x4*)orow + lane;
#pragma unroll
    for (int j = 0; j < 4; ++j) { const f32x4 ww = wr[64 * j]; o[64 * j] = (v[j] * rstd) * ww; }
}
__device__ __forceinline__ void final_norm_phase(Frame& F, const bf16* xpb, const float* xs, const float* w, float* yp, float* ys) {
    const int gw = F.vcu * NWAVES + F.wave, NGW = F.G * NWAVES;
    for (int m = gw; m < MP; m += NGW) rms_rowb_to_f32(xpb + (size_t)m * DM, w, yp + (size_t)m * DM, F.lane);
    for (int m = NGW - 1 - gw; m < MS; m += NGW) rms_row_to_f32(xs + (size_t)m * DM, w, ys + (size_t)m * DM, F.lane);
}
__device__ __forceinline__ void conv_phase_prompt(Frame& F, const float* cw, const float* cb) {
    const bf16* UB = (const bf16*)(F.ws + WS_UB); bf16* AB = (bf16*)(F.ws + WS_AB);
    const int gt = (F.vcu * NWAVES + F.wave) * 64 + F.lane, NT = F.G * NWAVES * 64;
    constexpr int NCH = DFF / 8, NITEM = (MP / 16) * NCH;
    for (int it = gt; it < NITEM; it += NT) {
        const int rb = it / NCH, c8 = it % NCH, r0 = rb * 16, c0 = c8 * 8;
        float wg[3][8], wv[3][8], bg[8], bv[8];
#pragma unroll
        for (int j = 0; j < 3; ++j)
#pragma unroll
            for (int q = 0; q < 2; ++q) { const f32x4 a = *(const GAS f32x4*)(cw + (size_t)j * DUP + c0 + 4 * q), b = *(const GAS f32x4*)(cw + (size_t)j * DUP + DFF + c0 + 4 * q);
#pragma unroll
                for (int e = 0; e < 4; ++e) { wg[j][4 * q + e] = a[e]; wv[j][4 * q + e] = b[e]; } }
#pragma unroll
        for (int q = 0; q < 2; ++q) { const f32x4 a = *(const GAS f32x4*)(cb + c0 + 4 * q), b = *(const GAS f32x4*)(cb + DFF + c0 + 4 * q);
#pragma unroll
            for (int e = 0; e < 4; ++e) { bg[4 * q + e] = a[e]; bv[4 * q + e] = b[e]; } }
        float g2[8], g1[8], v2[8], v1[8];
        const bool has_prev = (r0 & 4095) != 0;
        {
            v4u a2 = {0u, 0u, 0u, 0u}, a1 = a2, b2 = a2, b1 = a2;
            if (has_prev) { a2 = *(const GAS v4u*)(UB + (size_t)(r0 - 2) * DUP + c0); a1 = *(const GAS v4u*)(UB + (size_t)(r0 - 1) * DUP + c0);
                            b2 = *(const GAS v4u*)(UB + (size_t)(r0 - 2) * DUP + DFF + c0); b1 = *(const GAS v4u*)(UB + (size_t)(r0 - 1) * DUP + DFF + c0); }
#pragma unroll
            for (int e = 0; e < 4; ++e) { g2[2 * e] = __uint_as_float(a2[e] << 16); g2[2 * e + 1] = __uint_as_float(a2[e] & 0xffff0000u); g1[2 * e] = __uint_as_float(a1[e] << 16); g1[2 * e + 1] = __uint_as_float(a1[e] & 0xffff0000u);
                                          v2[2 * e] = __uint_as_float(b2[e] << 16); v2[2 * e + 1] = __uint_as_float(b2[e] & 0xffff0000u); v1[2 * e] = __uint_as_float(b1[e] << 16); v1[2 * e + 1] = __uint_as_float(b1[e] & 0xffff0000u); }
        }
#pragma unroll 4
        for (int i = 0; i < 16; ++i) {
            const v4u a0 = *(const GAS v4u*)(UB + (size_t)(r0 + i) * DUP + c0), b0 = *(const GAS v4u*)(UB + (size_t)(r0 + i) * DUP + DFF + c0);
            float g0[8], v0[8], o[8];
#pragma unroll
            for (int e = 0; e < 4; ++e) { g0[2 * e] = __uint_as_float(a0[e] << 16); g0[2 * e + 1] = __uint_as_float(a0[e] & 0xffff0000u); v0[2 * e] = __uint_as_float(b0[e] << 16); v0[2 * e + 1] = __uint_as_float(b0[e] & 0xffff0000u); }
#pragma unroll
            for (int e = 0; e < 8; ++e) { const float gg = bg[e] + wg[0][e] * g2[e] + wg[1][e] * g1[e] + wg[2][e] * g0[e]; const float vv = bv[e] + wv[0][e] * v2[e] + wv[1][e] * v1[e] + wv[2][e] * v0[e];
                o[e] = silu_f(gg) * vv; g2[e] = g1[e]; g1[e] = g0[e]; v2[e] = v1[e]; v1[e] = v0[e]; }
            v4u w; w.x = pk2(o[0], o[1]); w.y = pk2(o[2], o[3]); w.z = pk2(o[4], o[5]); w.w = pk2(o[6], o[7]);
            *(GAS v4u*)(AB + (size_t)(r0 + i) * DFF + c0) = w;
        }
    }
}

__device__ __forceinline__ void conv_fixup_phase(Frame& F, const float* cw, const float* cb) {
    const float* UB = (const float*)(F.ws + WS_UB); bf16* AB = (bf16*)(F.ws + WS_AB);
    const int gt = (F.vcu * NWAVES + F.wave) * 64 + F.lane, NT = F.G * NWAVES * 64;
    for (int it = gt; it < 64 * 2 * DFF; it += NT) { const int c = it % DFF, tr = it / DFF, pm = tr >> 1, r = tr & 1;
        if ((pm & 15) == 0) continue;
        float o[2];
#pragma unroll
        for (int hh = 0; hh < 2; ++hh) { const int cc = c + hh * DFF;
            const float um2 = UB[((size_t)(pm - 1) * 4 + 2) * DUP + cc], um1 = UB[((size_t)(pm - 1) * 4 + 3) * DUP + cc], u0 = UB[((size_t)pm * 4 + 0) * DUP + cc], u1 = UB[((size_t)pm * 4 + 1) * DUP + cc];
            const float a = r ? um1 : um2, b = r ? u0 : um1, d = r ? u1 : u0;
            o[hh] = cb[cc] + cw[cc] * a + cw[DUP + cc] * b + cw[2 * DUP + cc] * d; }
        AB[(size_t)(pm * 256 + r) * DFF + c] = (bf16)f2bf(silu_f(o[0]) * o[1]); }
}

__device__ __forceinline__ void zero_rows_f32(Frame& F, float* p) { const int gt = (F.vcu * NWAVES + F.wave) * 64 + F.lane; if (gt < MP) p[gt] = 0.f; }
typedef float f32x16 __attribute__((ext_vector_type(16)));
typedef short s16x4 __attribute__((ext_vector_type(4)));
typedef float f32x2_t __attribute__((ext_vector_type(2))); typedef __bf16 bf16x2_t __attribute__((ext_vector_type(2)));
__device__ __forceinline__ unsigned cvtpk(float lo, float hi) { f32x2_t v = {lo, hi}; bf16x2_t b = __builtin_convertvector(v, bf16x2_t); return __builtin_bit_cast(unsigned, b); }
__device__ __forceinline__ int crow(int r, int hi) { return (r & 3) + 8 * (r >> 2) + 4 * hi; }
__device__ __forceinline__ s16x4 ds_tr(const LAS unsigned char* p) { return __builtin_bit_cast(s16x4, __builtin_amdgcn_ds_read_tr16_b64_v4i16((LAS s16x4*)p)); }
__device__ __forceinline__ bf16x8 mk8(s16x4 lo, s16x4 hi) { return (bf16x8){lo[0], lo[1], lo[2], lo[3], hi[0], hi[1], hi[2], hi[3]}; }
__device__ __forceinline__ bf16x8 pack_step(const f32x16& x, int s) {
    v4u p; p.x = cvtpk(x[8 * s], x[8 * s + 1]); p.y = cvtpk(x[8 * s + 2], x[8 * s + 3]); p.z = cvtpk(x[8 * s + 4], x[8 * s + 5]); p.w = cvtpk(x[8 * s + 6], x[8 * s + 7]);
    return __builtin_bit_cast(bf16x8, p);
}
#define MFMA32(a, b, c) __builtin_amdgcn_mfma_f32_32x32x16_bf16((a), (b), (c), 0, 0, 0)
__device__ __forceinline__ float log2_gamma(int h) { return log2f(1.f - exp2f(-5.f - (float)h)); }

constexpr int AT_V0 = 49152, AT_V1 = 49152 + 24576 + 128;
struct AttnIds { int g, b, h, r, np; };
__device__ __forceinline__ AttnIds attn_ids(int uid) { AttnIds a; a.g = uid >> 9; const int rem = uid & 511, bh = rem >> 4, rn = rem & 15, npc = 16 >> (2 * a.g); a.b = bh >> 3; a.h = bh & 7; a.r = rn / npc; a.np = rn % npc; return a; }
__device__ __forceinline__ void attn_fetch(Frame& F, const AttnIds& a, v4u (&kreg)[6], v4u (&vreg)[6]) {
    const bf16* ZB = (const bf16*)(F.ws + WS_ZB); const int dsh = 2 * a.g; const size_t brow = (size_t)a.b * SEQ;
#pragma unroll
    for (int i = 0; i < 6; ++i) { const int c = F.tid + 512 * i, key = c >> 3, ch = c & 7; int uk = 256 * a.np - 128 + key; uk = uk < 0 ? 0 : uk;
        const bf16* src = ZB + (brow + a.r + ((size_t)uk << dsh)) * DIN + a.h * 64 + ch * 8;
        kreg[i] = *(const GAS v4u*)(src + C_KA); vreg[i] = *(const GAS v4u*)(src + C_VA); }
}
__device__ __forceinline__ void attn_stage(Frame& F, const v4u (&kreg)[6], const v4u (&vreg)[6]) {
#pragma unroll
    for (int i = 0; i < 6; ++i) { const int c = F.tid + 512 * i, key = c >> 3, ch = c & 7;
        *(LAS v4u*)(F.lds + key * 128 + ((ch ^ ((key >> 1) & 7)) << 4)) = kreg[i];
        *(LAS v4u*)(F.lds + ((ch >> 2) ? AT_V1 : AT_V0) + key * 64 + ((ch & 3) << 4)) = vreg[i]; }
}
__device__ __forceinline__ void attn_compute(Frame& F, const AttnIds& a, const bf16x8 (&qf)[4]) {
    const int g = a.g, b = a.b, h = a.h, r = a.r, np = a.np;
    const int dsh = 2 * g;
    bf16* OG = (bf16*)(F.ws + WS_OG) + (size_t)g * MP * 512; float* LSE = (float*)(F.ws + WS_LSE) + (size_t)g * MP * 8;
    const int lane = F.lane, w = F.wave, r32 = lane & 31, hi = lane >> 5;
    LAS unsigned char* Kl = F.lds;
    const size_t brow = (size_t)b * SEQ;
    const size_t qrow = brow + r + ((size_t)(256 * np + 32 * w + r32) << dsh);
    f32x16 p[5];
#pragma unroll
    for (int kb = 0; kb < 5; ++kb) {
        f32x16 a = {};
        const int key = 32 * w + 32 * kb + r32;
#pragma unroll
        for (int d0 = 0; d0 < 4; ++d0) { const bf16x8 kf = *(const LAS bf16x8*)(Kl + key * 128 + (((2 * d0 + hi) ^ ((key >> 1) & 7)) << 4)); a = MFMA32(kf, qf[d0], a); }
        p[kb] = a;
    }
    float mx = -INFINITY;
#pragma unroll
    for (int kb = 0; kb < 5; ++kb) { const bool blk_dead = (np == 0) && (kb < 4 - w);
#pragma unroll
        for (int rg = 0; rg < 16; ++rg) { const int c = crow(rg, hi); bool ok = !blk_dead; if (kb == 0) ok = ok && (c >= r32); if (kb == 4) ok = ok && (c <= r32);
            const float v = ok ? p[kb][rg] : -INFINITY; p[kb][rg] = v; mx = fmaxf(mx, v); } }
    mx = fmaxf(mx, __shfl_xor(mx, 32));
    float l = 0.f;
#pragma unroll
    for (int kb = 0; kb < 5; ++kb)
#pragma unroll
        for (int rg = 0; rg < 16; ++rg) { const float e = __builtin_amdgcn_exp2f(p[kb][rg] - mx); p[kb][rg] = e; l += e; }
    l += __shfl_xor(l, 32);
    f32x16 o[2]; o[0] = (f32x16){}; o[1] = (f32x16){};
    const int gidx = lane >> 4, ql = (lane & 15) >> 2, pl = lane & 3;
    const int voff = (4 * hi + ql) * 64 + (16 * (gidx & 1) + 4 * pl) * 2;
#pragma unroll
    for (int kb = 0; kb < 5; ++kb)
#pragma unroll
        for (int s = 0; s < 2; ++s) { const bf16x8 pf = pack_step(p[kb], s);
#pragma unroll
            for (int dh = 0; dh < 2; ++dh) { const LAS unsigned char* vb = F.lds + (dh ? AT_V1 : AT_V0) + (32 * w + 32 * kb + 16 * s) * 64 + voff;
                const bf16x8 vf = mk8(ds_tr(vb), ds_tr(vb + 8 * 64)); o[dh] = MFMA32(vf, pf, o[dh]); } }
    const float inv = 1.f / l;
    bf16* orow = OG + qrow * 512 + h * 64;
#pragma unroll
    for (int dh = 0; dh < 2; ++dh)
#pragma unroll
        for (int t = 0; t < 4; ++t) { const int d = 32 * dh + 8 * t + 4 * hi;
            const unsigned lo = cvtpk(o[dh][4 * t] * inv, o[dh][4 * t + 1] * inv), hi2 = cvtpk(o[dh][4 * t + 2] * inv, o[dh][4 * t + 3] * inv);
            *(GAS unsigned long long*)(orow + d) = (unsigned long long)lo | ((unsigned long long)hi2 << 32); }
    if (hi == 0) LSE[qrow * 8 + h] = mx + log2f(l);
}
__device__ __forceinline__ void attn_qfetch(Frame& F, const AttnIds& a, bf16x8 (&qf)[4]) {
    const bf16* ZB = (const bf16*)(F.ws + WS_ZB); const int r32 = F.lane & 31, hi = F.lane >> 5;
    const size_t qrow = (size_t)a.b * SEQ + a.r + ((size_t)(256 * a.np + 32 * F.wave + r32) << (2 * a.g));
#pragma unroll
    for (int d0 = 0; d0 < 4; ++d0) qf[d0] = *(const GAS bf16x8*)(ZB + qrow * DIN + C_QA + a.h * 64 + d0 * 16 + hi * 8);
}
__device__ __forceinline__ void attn_prompt_units(Frame& F) {
    const int per = (1536 + F.G - 1) / F.G, u0 = F.vcu * per, u1 = (u0 + per < 1536) ? u0 + per : 1536;
    if (u0 >= u1) return;
    v4u kreg[6], vreg[6]; bf16x8 qn[4];
    attn_fetch(F, attn_ids(u0), kreg, vreg); attn_qfetch(F, attn_ids(u0), qn);
#pragma unroll 1
    for (int uid = u0; uid < u1; ++uid) {
        const AttnIds a = attn_ids(uid);
        bf16x8 qf[4];
#pragma unroll
        for (int d0 = 0; d0 < 4; ++d0) qf[d0] = qn[d0];
        attn_stage(F, kreg, vreg);
        __syncthreads();
        if (uid + 1 < u1) { attn_fetch(F, attn_ids(uid + 1), kreg, vreg); attn_qfetch(F, attn_ids(uid + 1), qn); }
        attn_compute(F, a, qf);
        __syncthreads();
    }
}
__device__ __forceinline__ void combine_prompt(Frame& F) {
    const bf16* OG = (const bf16*)(F.ws + WS_OG); const float* LSE = (const float*)(F.ws + WS_LSE); bf16* CATB = (bf16*)(F.ws + WS_CATB);
    const int gt = (F.vcu * NWAVES + F.wave) * 64 + F.lane, NT = F.G * NWAVES * 64;
    for (int it0 = gt; it0 < MP * 64; it0 += 4 * NT) {
        float l0[4], l1[4], l2[4]; v4u a[4], b[4], c[4];
#pragma unroll
        for (int q = 0; q < 4; ++q) { const int it = it0 + q * NT; const int row = (it < MP * 64 ? it : gt) >> 6, hc = it & 63, h = hc >> 3;
            l0[q] = *(const GAS float*)(LSE + (size_t)row * 8 + h); l1[q] = *(const GAS float*)(LSE + ((size_t)MP + row) * 8 + h); l2[q] = *(const GAS float*)(LSE + ((size_t)2 * MP + row) * 8 + h);
            a[q] = *(const GAS v4u*)(OG + (size_t)row * 512 + hc * 8); b[q] = *(const GAS v4u*)(OG + ((size_t)MP + row) * 512 + hc * 8); c[q] = *(const GAS v4u*)(OG + ((size_t)2 * MP + row) * 512 + hc * 8); }
        __builtin_amdgcn_sched_barrier(0);
#pragma unroll
        for (int q = 0; q < 4; ++q) { const int it = it0 + q * NT; if (it >= MP * 64) break; const int row = it >> 6, hc = it & 63;
            const float m = fmaxf(l0[q], fmaxf(l1[q], l2[q])); float w0 = __builtin_amdgcn_exp2f(l0[q] - m), w1 = __builtin_amdgcn_exp2f(l1[q] - m), w2 = __builtin_amdgcn_exp2f(l2[q] - m); const float inv = 1.f / (w0 + w1 + w2); w0 *= inv; w1 *= inv; w2 *= inv;
            v4u o;
#pragma unroll
            for (int e = 0; e < 4; ++e) { const float x0 = w0 * __uint_as_float(a[q][e] << 16) + w1 * __uint_as_float(b[q][e] << 16) + w2 * __uint_as_float(c[q][e] << 16);
                const float x1 = w0 * __uint_as_float(a[q][e] & 0xffff0000u) + w1 * __uint_as_float(b[q][e] & 0xffff0000u) + w2 * __uint_as_float(c[q][e] & 0xffff0000u); o[e] = cvtpk(x0, x1); }
            *(GAS v4u*)(CATB + (size_t)row * DM + 512 + hc * 8) = o; }
    }
}
__device__ __forceinline__ void ret_upd_unit(Frame& F, int bh, int n) {
    const bf16* ZB = (const bf16*)(F.ws + WS_ZB); float* UPD = (float*)(F.ws + WS_UPD) + ((size_t)bh * 32 + n) * 16384;
    const int tid = F.tid, lane = F.lane, w = F.wave, r32 = lane & 31, hi = lane >> 5;
    const int b = bh >> 2, h = bh & 3; const size_t row0 = (size_t)b * SEQ + 128 * n; const float lg = log2_gamma(h);
    {
        v4u kreg[4], vreg[4];
#pragma unroll
        for (int i = 0; i < 4; ++i) { const int c = tid + 512 * i, tok = c >> 4, ch = c & 15; const bf16* src = ZB + (row0 + tok) * DIN + h * 128 + ch * 8;
            kreg[i] = *(const GAS v4u*)(src + C_KR); vreg[i] = *(const GAS v4u*)(src + C_VR); }
#pragma unroll
        for (int i = 0; i < 4; ++i) { const int c = tid + 512 * i, tok = c >> 4, ch = c & 15; const float dec = exp2f((float)(127 - tok) * lg);
            v4u kk;
#pragma unroll
            for (int e = 0; e < 4; ++e) kk[e] = cvtpk(__uint_as_float(kreg[i][e] << 16) * dec, __uint_as_float(kreg[i][e] & 0xffff0000u) * dec);
            const int dst = (ch >> 2) * 8192 + tok * 64 + ((ch & 3) << 4);
            *(LAS v4u*)(F.lds + dst) = kk; *(LAS v4u*)(F.lds + 32768 + dst) = vreg[i]; }
    }
    __syncthreads();
    const int eb = w >> 1, db0 = 2 * (w & 1);
    const int gidx = lane >> 4, ql = (lane & 15) >> 2, pl = lane & 3;
    const int toff = (4 * hi + ql) * 64 + (16 * (gidx & 1) + 4 * pl) * 2;
    f32x16 acc[2]; acc[0] = (f32x16){}; acc[1] = (f32x16){};
#pragma unroll
    for (int s = 0; s < 8; ++s) { const LAS unsigned char* vb = F.lds + 32768 + eb * 8192 + (16 * s) * 64 + toff; const bf16x8 vf = mk8(ds_tr(vb), ds_tr(vb + 8 * 64));
#pragma unroll
        for (int q = 0; q < 2; ++q) { const LAS unsigned char* kb = F.lds + (db0 + q) * 8192 + (16 * s) * 64 + toff; const bf16x8 kf = mk8(ds_tr(kb), ds_tr(kb + 8 * 64)); acc[q] = MFMA32(vf, kf, acc[q]); } }
#pragma unroll
    for (int q = 0; q < 2; ++q)
#pragma unroll
        for (int rg = 0; rg < 16; ++rg) UPD[(size_t)(32 * eb + crow(rg, hi)) * 128 + 32 * (db0 + q) + r32] = acc[q][rg];
    __syncthreads();
}
__device__ __forceinline__ void ret_scan(Frame& F, float* pret) {
    const float* UPD = (const float*)(F.ws + WS_UPD); bf16* ST = (bf16*)(F.ws + WS_ST);
    const int gt = (F.vcu * NWAVES + F.wave) * 64 + F.lane, NT = F.G * NWAVES * 64;
    for (int it = gt; it < 16 * 16384; it += NT) { const int bh = it >> 14, ed = it & 16383, e = ed >> 7, d = ed & 127;
        const float cd = exp2f(128.f * log2_gamma(bh & 3));
        float u[32];
#pragma unroll
        for (int n = 0; n < 32; ++n) u[n] = UPD[((size_t)bh * 32 + n) * 16384 + ed];
        float S = 0.f;
#pragma unroll
        for (int n = 0; n < 32; ++n) { ST[((size_t)bh * 32 + n) * 16384 + ed] = (bf16)f2bf(S); S = cd * S + u[n]; }
        pret[(size_t)bh * 16384 + d * 128 + e] = S; }
}
__device__ __forceinline__ void ret_out_pair(Frame& F, int upair, const float* gnw) {
    const bf16* ZB = (const bf16*)(F.ws + WS_ZB); bf16* CATB = (bf16*)(F.ws + WS_CATB);
    const int tid = F.tid, lane = F.lane, w = F.wave, r32 = lane & 31, hi = lane >> 5, qd = w >> 2, wq = w & 3, tq = tid & 255;
    const int unit = 2 * upair + qd, bh = unit >> 5, n = unit & 31, b = bh >> 2, h = bh & 3;
    const size_t row0 = (size_t)b * SEQ + 128 * n; const float lg = log2_gamma(h);
    const bf16* STu = (const bf16*)(F.ws + WS_ST) + ((size_t)bh * 32 + n) * 16384;
    LAS unsigned char* Vl = F.lds + qd * 32768;
    {
        v4u vreg[8];
#pragma unroll
        for (int i = 0; i < 8; ++i) { const int c = tq + 256 * i, tok = c >> 4, ch = c & 15; vreg[i] = *(const GAS v4u*)(ZB + (row0 + tok) * DIN + C_VR + h * 128 + ch * 8); }
#pragma unroll
        for (int i = 0; i < 8; ++i) { const int c = tq + 256 * i, tok = c >> 4, ch = c & 15; *(LAS v4u*)(Vl + (ch >> 2) * 8192 + tok * 64 + ((ch & 3) << 4)) = vreg[i]; }
    }
    const int iq = 32 * wq + r32; const size_t qrow = row0 + iq;
    bf16x8 qf[8];
#pragma unroll
    for (int ks = 0; ks < 8; ++ks) qf[ks] = *(const GAS bf16x8*)(ZB + qrow * DIN + C_QR + h * 128 + ks * 16 + hi * 8);
    __syncthreads();
    f32x16 acc[4];
#pragma unroll
    for (int eb = 0; eb < 4; ++eb) { f32x16 a = {};
        bf16x8 sf[8];
#pragma unroll
        for (int ks = 0; ks < 8; ++ks) sf[ks] = *(const GAS bf16x8*)(STu + (size_t)(32 * eb + r32) * 128 + ks * 16 + hi * 8);
        __builtin_amdgcn_sched_barrier(0);
#pragma unroll
        for (int ks = 0; ks < 8; ++ks) a = MFMA32(sf[ks], qf[ks], a);
        acc[eb] = a; __builtin_amdgcn_sched_barrier(0); }
    { const float cdec = exp2f((float)(iq + 1) * lg);
#pragma unroll
        for (int eb = 0; eb < 4; ++eb)
#pragma unroll
            for (int rg = 0; rg < 16; ++rg) acc[eb][rg] *= cdec; }
    const int gidx = lane >> 4, ql = (lane & 15) >> 2, pl = lane & 3;
    const int toff = (4 * hi + ql) * 64 + (16 * (gidx & 1) + 4 * pl) * 2;
#pragma unroll 1
    for (int kb = 0; kb <= wq; ++kb) {
        {
            f32x16 p = {};
            bf16x8 kfr[8];
#pragma unroll
            for (int ks = 0; ks < 8; ++ks) kfr[ks] = *(const GAS bf16x8*)(ZB + (row0 + 32 * kb + r32) * DIN + C_KR + h * 128 + ks * 16 + hi * 8);
            __builtin_amdgcn_sched_barrier(0);
#pragma unroll
            for (int ks = 0; ks < 8; ++ks) p = MFMA32(kfr[ks], qf[ks], p);
#pragma unroll
            for (int rg = 0; rg < 16; ++rg) { const int j = 32 * kb + crow(rg, hi); p[rg] = (j <= iq) ? p[rg] * __builtin_amdgcn_exp2f((float)(iq - j) * lg) : 0.f; }
#pragma unroll
            for (int s = 0; s < 2; ++s) { const bf16x8 pf = pack_step(p, s);
#pragma unroll
                for (int eb = 0; eb < 4; ++eb) { const LAS unsigned char* vb = Vl + eb * 8192 + (32 * kb + 16 * s) * 64 + toff; const bf16x8 vf = mk8(ds_tr(vb), ds_tr(vb + 8 * 64)); acc[eb] = MFMA32(vf, pf, acc[eb]); } }
        }
    }
    float s1 = 0.f;
#pragma unroll
    for (int eb = 0; eb < 4; ++eb)
#pragma unroll
        for (int rg = 0; rg < 16; ++rg) s1 += acc[eb][rg];
    s1 += __shfl_xor(s1, 32); const float mu = s1 * (1.f / 128.f);
    float s2 = 0.f;
#pragma unroll
    for (int eb = 0; eb < 4; ++eb)
#pragma unroll
        for (int rg = 0; rg < 16; ++rg) { const float dlt = acc[eb][rg] - mu; s2 += dlt * dlt; }
    s2 += __shfl_xor(s2, 32); const float rstd = 1.f / sqrtf(s2 * (1.f / 128.f) + EPS);
#pragma unroll
    for (int eb = 0; eb < 4; ++eb)
#pragma unroll
        for (int t = 0; t < 4; ++t) { const int e = 32 * eb + 8 * t + 4 * hi;
            const unsigned long long gg = *(const GAS unsigned long long*)(ZB + qrow * DIN + C_GR + h * 128 + e);
            const f32x4 gw = *(const GAS f32x4*)(gnw + h * 128 + e);
            float gv[4] = {__uint_as_float((unsigned)gg << 16), __uint_as_float((unsigned)gg & 0xffff0000u), __uint_as_float((unsigned)(gg >> 32) << 16), __uint_as_float((unsigned)(gg >> 32) & 0xffff0000u)};
            float y[4];
#pragma unroll
            for (int k = 0; k < 4; ++k) y[k] = silu_f(gv[k]) * ((acc[eb][4 * t + k] - mu) * rstd * gw[k]);
            *(GAS unsigned long long*)(CATB + qrow * DM + h * 128 + e) = (unsigned long long)cvtpk(y[0], y[1]) | ((unsigned long long)cvtpk(y[2], y[3]) << 32); }
    __syncthreads();
}
#define MFMA16(a, b, c) __builtin_amdgcn_mfma_f32_16x16x32_bf16((a), (b), (c), 0, 0, 0)
template <int KW, class Pre> __device__ __forceinline__ f32x4 smp_task_core(Frame& F, const bf16* A, const bf16* Bt, int K, int wrow, Pre&& pre) {
#if defined(DBG_NAIVE_CORE)
    { const int lane = F.lane, fr = lane & 15, fq = lane >> 4, row = 16 * F.wave + fr; f32x4 s;
      for (int i = 0; i < 4; ++i) { const int wr_i = __shfl(wrow, 4 * fq + i); float a = 0.f;
          for (int k = 0; k < K; ++k) a += __uint_as_float((unsigned)A[(size_t)row * K + k] << 16) * __uint_as_float((unsigned)Bt[(size_t)wr_i * K + k] << 16);
          s[i] = a; }
      __syncthreads(); return s; }
#endif
    const int lane = F.lane, w = F.wave, fr = lane & 15, fq = lane >> 4;
    const bf16* ap = A + (size_t)fr * K + w * KW + 8 * fq; const bf16* bp = Bt + (size_t)wrow * K + w * KW + 8 * fq;
    f32x4 acc[8];
#pragma unroll
    for (int mb = 0; mb < 8; ++mb) acc[mb] = (f32x4){0.f, 0.f, 0.f, 0.f};
    static_assert(KW % 32 == 0 && KW / 32 <= 4, "K slice");
    constexpr int NS = KW / 32;
    bf16x8 bf[NS], af[NS][8];
#pragma unroll
    for (int q = 0; q < NS; ++q) { bf[q] = *(const GAS bf16x8*)(bp + q * 32);
#pragma unroll
        for (int mb = 0; mb < 8; ++mb) af[q][mb] = *(const GAS bf16x8*)(ap + (size_t)(16 * mb) * K + q * 32); }
    __builtin_amdgcn_sched_barrier(0);
#pragma unroll
    for (int q = 0; q < NS; ++q)
#pragma unroll
        for (int mb = 0; mb < 8; ++mb) acc[mb] = MFMA16(bf[q], af[q][mb], acc[mb]);
    __builtin_amdgcn_sched_barrier(0);
    pre();
    __builtin_amdgcn_sched_barrier(0);
    LAS f32x4* red = (LAS f32x4*)F.lds;
#pragma unroll
    for (int mb = 0; mb < 8; ++mb) red[(w * 8 + mb) * 64 + lane] = acc[mb];
    __syncthreads();
    f32x4 s = red[(0 * 8 + w) * 64 + lane];
#pragma unroll
    for (int ww = 1; ww < 8; ++ww) s += red[(ww * 8 + w) * 64 + lane];
    return s;
}
struct SmpSS { f32x4 a, b, c, d; };
__device__ __forceinline__ SmpSS smp_rstd_issue(Frame& F) {
    const float* SSs = (const float*)(F.ws + WS_SMP + SM_SS); const int fr = F.lane & 15, fq = F.lane >> 4, row = 16 * F.wave + fr;
    const GAS f32x4* p = (const GAS f32x4*)(SSs + (size_t)row * 64 + 16 * fq); SmpSS r; r.a = p[0]; r.b = p[1]; r.c = p[2]; r.d = p[3]; return r;
}
__device__ __forceinline__ float smp_rstd_finish(const SmpSS& q) {
    const f32x4 a = q.a, b = q.b, c = q.c, d = q.d;
    float s = (((a[0] + a[1]) + (a[2] + a[3])) + ((b[0] + b[1]) + (b[2] + b[3]))) + (((c[0] + c[1]) + (c[2] + c[3])) + ((d[0] + d[1]) + (d[2] + d[3])));
    s += __shfl_xor(s, 16); s += __shfl_xor(s, 32); return 1.f / sqrtf(s * (1.f / DM) + EPS);
}
__device__ __forceinline__ float smp_rstd(Frame& F) { return smp_rstd_finish(smp_rstd_issue(F)); }

__device__ __forceinline__ void smp_load_a(Frame& F, const bf16* A, bf16x8 (&af)[4][8]) {
    const int fr = F.lane & 15, fq = F.lane >> 4; const bf16* ap = A + (size_t)fr * DM + F.wave * 128 + 8 * fq;
#pragma unroll
    for (int q = 0; q < 4; ++q)
#pragma unroll
        for (int mb = 0; mb < 8; ++mb) af[q][mb] = *(const GAS bf16x8*)(ap + (size_t)(16 * mb) * DM + q * 32);
}
__device__ __forceinline__ void smp_load_b(Frame& F, const bf16* Bt, int wrow, bf16x8 (&bf)[4]) {
    const int fq = F.lane >> 4; const bf16* bp = Bt + (size_t)wrow * DM + F.wave * 128 + 8 * fq;
#pragma unroll
    for (int q = 0; q < 4; ++q) bf[q] = *(const GAS bf16x8*)(bp + q * 32);
}
template <class Pre> __device__ __forceinline__ f32x4 smp_mma_reduce(Frame& F, const bf16x8 (&af)[4][8], const bf16x8 (&bf)[4], Pre&& pre) {
    const int lane = F.lane, w = F.wave;
    f32x4 acc[8];
#pragma unroll
    for (int mb = 0; mb < 8; ++mb) acc[mb] = (f32x4){0.f, 0.f, 0.f, 0.f};
#pragma unroll
    for (int q = 0; q < 4; ++q)
#pragma unroll
        for (int mb = 0; mb < 8; ++mb) acc[mb] = MFMA16(bf[q], af[q][mb], acc[mb]);
    __builtin_amdgcn_sched_barrier(0);
    pre();
    __builtin_amdgcn_sched_barrier(0);
    LAS f32x4* red = (LAS f32x4*)F.lds;
#pragma unroll
    for (int mb = 0; mb < 8; ++mb) red[(w * 8 + mb) * 64 + lane] = acc[mb];
    __syncthreads();
    f32x4 s = red[(0 * 8 + w) * 64 + lane];
#pragma unroll
    for (int ww = 1; ww < 8; ++ww) s += red[(ww * 8 + w) * 64 + lane];
    return s;
}

#if defined(DBG_RSTD_DIRECT)
#define smp_rstd smp_rstd_direct
__device__ __forceinline__ float smp_rstd_direct(Frame& F) {
    const float* XSf = (const float*)(F.ws + WS_SMP + SM_X); const int fr = F.lane & 15, fq = F.lane >> 4, row = 16 * F.wave + fr;
    const GAS f32x4* p = (const GAS f32x4*)(XSf + (size_t)row * DM + 256 * fq); float s = 0.f;
    for (int i = 0; i < 64; ++i) { const f32x4 a = p[i]; s += (a[0] * a[0] + a[1] * a[1]) + (a[2] * a[2] + a[3] * a[3]); }
    s += __shfl_xor(s, 16); s += __shfl_xor(s, 32); return 1.f / sqrtf(s * (1.f / DM) + EPS);
}
#endif
__device__ __forceinline__ int smp_pair_wrow(int task, int fr) { const int pn = task >> 4, j0 = (task & 15) * 8; return pn * 256 + (fr < 8 ? j0 + fr : 128 + j0 + (fr - 8)); }
__device__ __forceinline__ void sample_win_tasks(Frame& F, int task0, int tstep, const bf16* Wl, float* swk, float* swv) {
    if (task0 >= 224) return;
    const bf16* XSB = (const bf16*)(F.ws + WS_SMP + SM_HB); bf16* ZS = (bf16*)(F.ws + WS_SMP + SM_ZB);
    const float* T64 = (const float*)(F.ws + WS_T64); const float* T32 = (const float*)(F.ws + WS_T32);
    const int lane = F.lane, fr = lane & 15, fq = lane >> 4;
    bf16x8 af[4][8], bf[4];
    smp_load_a(F, XSB, af); smp_load_b(F, Wl, smp_pair_wrow(task0, fr), bf);
#pragma unroll 1
    for (int task = task0; task < 224; task += tstep) {
        const bool more = task + tstep < 224; bf16x8 bn[4];
        if (more) smp_load_b(F, Wl, smp_pair_wrow(task + tstep, fr), bn);
        const int pn = task >> 4, j0 = (task & 15) * 8;
        const int bj = fq >> 1, j = j0 + 4 * (fq & 1);
        const bool rot = (pn < 4) || (pn >= 8 && pn < 12);
        int feat; const float* T = T64; int tstride = 64, fidx = 0; float sc = 1.f;
        if (pn < 4) { feat = (pn >> 1) * 512 + (2 * (pn & 1) + (j >> 6)) * 128 + (j & 63) + 64 * bj; fidx = j & 63; sc = (pn >= 2) ? pg8::KR_SCALE : 1.f; }
        else if (pn >= 8 && pn < 12) { feat = 2048 + ((pn - 8) >> 1) * 512 + (4 * (pn & 1) + (j >> 5)) * 64 + (j & 31) + 32 * bj; fidx = j & 31; T = T32; tstride = 32; sc = (pn < 10) ? pg8::QA_SCALE : 1.f; }
        else feat = pn * 256 + 128 * bj + j;
        const int row = 16 * F.wave + fr;
        SmpSS ssq; f32x4 cs0, cs1;
        const float* tp = T + ((size_t)(SEQ + (row & 3)) * tstride + fidx) * 2;
        f32x4 v = smp_mma_reduce(F, af, bf, [&]() { ssq = smp_rstd_issue(F); cs0 = *(const GAS f32x4*)tp; cs1 = *(const GAS f32x4*)(tp + 4); });
        v *= smp_rstd_finish(ssq);
        f32x4 pr; pr[0] = __shfl_xor(v[0], 32); pr[1] = __shfl_xor(v[1], 32); pr[2] = __shfl_xor(v[2], 32); pr[3] = __shfl_xor(v[3], 32);
        if (rot) {
            const float c[4] = {cs0[0], cs0[2], cs1[0], cs1[2]}, s[4] = {cs0[1], cs0[3], cs1[1], cs1[3]};
#pragma unroll
            for (int i = 0; i < 4; ++i) v[i] = (bj == 0 ? (v[i] * c[i] - pr[i] * s[i]) : (v[i] * c[i] + pr[i] * s[i])) * sc; }
        *(GAS unsigned long long*)(ZS + (size_t)row * DIN + feat) = (unsigned long long)cvtpk(v[0], v[1]) | ((unsigned long long)cvtpk(v[2], v[3]) << 32);
        if (pn == 10 || pn == 11) *(GAS f32x4*)(swk + (size_t)row * 512 + (feat - C_KA)) = v;
        if (pn >= 12) *(GAS f32x4*)(swv + (size_t)row * 512 + (feat - C_VA)) = v;
        __syncthreads();
        if (more) {
#pragma unroll
            for (int q = 0; q < 4; ++q) bf[q] = bn[q]; }
    }
}
template <int KW> __device__ __forceinline__ void sample_resid_task(Frame& F, const bf16* A, const bf16* Bt, int K, int task) {
    float* XS = (float*)(F.ws + WS_SMP + SM_X); bf16* XSB = (bf16*)(F.ws + WS_SMP + SM_HB); float* SSs = (float*)(F.ws + WS_SMP + SM_SS);
    const int lane = F.lane, w = F.wave, fr = lane & 15, fq = lane >> 4, cg = task >> 2, rq = task & 3;
    constexpr int NS = KW / 32;
    const bf16* ap = A + (size_t)(32 * rq + fr) * K + w * KW + 8 * fq; const bf16* bp = Bt + (size_t)(16 * cg + fr) * K + w * KW + 8 * fq;
    bf16x8 bf[NS], a0[NS], a1[NS];
#pragma unroll
    for (int s = 0; s < NS; ++s) { bf[s] = *(const GAS bf16x8*)(bp + s * 32); a0[s] = *(const GAS bf16x8*)(ap + s * 32); a1[s] = *(const GAS bf16x8*)(ap + (size_t)16 * K + s * 32); }
    __builtin_amdgcn_sched_barrier(0);
    f32x4 acc0 = {0.f, 0.f, 0.f, 0.f}, acc1 = acc0;
#pragma unroll
    for (int s = 0; s < NS; ++s) { acc0 = MFMA16(bf[s], a0[s], acc0); acc1 = MFMA16(bf[s], a1[s], acc1); }
    LAS f32x4* red = (LAS f32x4*)F.lds;
    red[(w * 2 + 0) * 64 + lane] = acc0; red[(w * 2 + 1) * 64 + lane] = acc1;
    __syncthreads();
    if (w < 2) {
        f32x4 d = red[(0 * 2 + w) * 64 + lane];
#pragma unroll
        for (int ww = 1; ww < 8; ++ww) d += red[(ww * 2 + w) * 64 + lane];
        const int row = 32 * rq + 16 * w + fr;
        float* xp = XS + (size_t)row * DM + 16 * cg + 4 * fq;
        const f32x4 x = *(const GAS f32x4*)xp + d;
        *(GAS f32x4*)xp = x;
        *(GAS unsigned long long*)(XSB + (size_t)row * DM + 16 * cg + 4 * fq) = (unsigned long long)cvtpk(x[0], x[1]) | ((unsigned long long)cvtpk(x[2], x[3]) << 32);
        float s = (x[0] * x[0] + x[1] * x[1]) + (x[2] * x[2] + x[3] * x[3]); s += __shfl_xor(s, 16); s += __shfl_xor(s, 32);
        if (fq == 0) SSs[(size_t)row * 64 + cg] = s;
    }
    __syncthreads();
}

#if defined(DBG_NAIVE_RESID)
__device__ __forceinline__ void sample_resid_naive(Frame& F, const bf16* A, const bf16* Bt, int K) {
    float* XSf = (float*)(F.ws + WS_SMP + SM_X); bf16* XSB = (bf16*)(F.ws + WS_SMP + SM_HB);
    const int gt = (F.vcu * NWAVES + F.wave) * 64 + F.lane, NT = F.G * NWAVES * 64;
    for (int it = gt; it < MS * DM; it += NT) { const int row = it / DM, col = it % DM; float s = 0.f;
        for (int k = 0; k < K; ++k) s += __uint_as_float((unsigned)A[(size_t)row * K + k] << 16) * __uint_as_float((unsigned)Bt[(size_t)col * K + k] << 16);
        const float x = XSf[it] + s; XSf[it] = x; XSB[it] = (bf16)f2bf(x); }
}
#endif
__device__ __forceinline__ void sample_up_tasks(Frame& F, int task0, int tstep, const bf16* Wl, const float* sconv_in, const float* cw, const float* cb, float* sconv_out) {
    if (task0 >= 352) return;
    const bf16* XSB = (const bf16*)(F.ws + WS_SMP + SM_HB); bf16* AS = (bf16*)(F.ws + WS_SMP + SM_AB);
    const int lane = F.lane, fr = lane & 15, fq = lane >> 4;
    bf16x8 af[4][8], bf[4];
    smp_load_a(F, XSB, af); smp_load_b(F, Wl, smp_pair_wrow(task0, fr), bf);
#pragma unroll 1
    for (int task = task0; task < 352; task += tstep) {
        const bool more = task + tstep < 352; bf16x8 bn[4];
        if (more) smp_load_b(F, Wl, smp_pair_wrow(task + tstep, fr), bn);
        const int pn = task >> 4, j0 = (task & 15) * 8;
        const int row = 16 * F.wave + fr, b = row >> 2, t = row & 3;
        const int feat = (fq >> 1) * DFF + 128 * pn + j0 + 4 * (fq & 1);
        SmpSS ssq; f32x4 c0, c1, w0, w1, w2, bb;
        const f32x4 u_raw = smp_mma_reduce(F, af, bf, [&]() { ssq = smp_rstd_issue(F);
            c0 = *(const GAS f32x4*)(sconv_in + ((size_t)b * 2 + 0) * DUP + feat); c1 = *(const GAS f32x4*)(sconv_in + ((size_t)b * 2 + 1) * DUP + feat);
            w0 = *(const GAS f32x4*)(cw + feat); w1 = *(const GAS f32x4*)(cw + DUP + feat); w2 = *(const GAS f32x4*)(cw + 2 * DUP + feat); bb = *(const GAS f32x4*)(cb + feat); });
        const f32x4 u = u_raw * smp_rstd_finish(ssq);
        f32x4 r;
#pragma unroll
        for (int i = 0; i < 4; ++i) { const float s1 = __shfl_up(u[i], 1, 16), s2 = __shfl_up(u[i], 2, 16);
            const float p1 = (t >= 1) ? s1 : c1[i], p2 = (t >= 2) ? s2 : (t == 1 ? c1[i] : c0[i]);
            r[i] = bb[i] + w0[i] * p2 + w1[i] * p1 + w2[i] * u[i]; }
        f32x4 pr; pr[0] = __shfl_xor(r[0], 32); pr[1] = __shfl_xor(r[1], 32); pr[2] = __shfl_xor(r[2], 32); pr[3] = __shfl_xor(r[3], 32);
        if (fq < 2) { const int c = 128 * pn + j0 + 4 * fq;
            *(GAS unsigned long long*)(AS + (size_t)row * DFF + c) = (unsigned long long)cvtpk(silu_f(r[0]) * pr[0], silu_f(r[1]) * pr[1]) | ((unsigned long long)cvtpk(silu_f(r[2]) * pr[2], silu_f(r[3]) * pr[3]) << 32); }
        if (t >= 2) *(GAS f32x4*)(sconv_out + ((size_t)b * 2 + (t - 2)) * DUP + feat) = u;
        __syncthreads();
        if (more) {
#pragma unroll
            for (int q = 0; q < 4; ++q) bf[q] = bn[q]; }
    }
}

__device__ __forceinline__ void sample_attn_unit(Frame& F, int b, int h, const float* ck, const float* cv) {
    const bf16* ZS = (const bf16*)(F.ws + WS_SMP + SM_ZB); bf16* CATS = (bf16*)(F.ws + WS_SMP + SM_CATB);
    LAS float* sc = (LAS float*)F.lds; LAS float* part = sc + 4 * 388; LAS float* ml = part + 8 * 64;
    const int lane = F.lane, w = F.wave, t = w & 3, hf = w >> 2, sub = lane >> 4, l16 = lane & 15;
    float q[4];
    { const unsigned long long qq = *(const GAS unsigned long long*)(ZS + (size_t)(b * 4 + t) * DIN + C_QA + h * 64 + 4 * l16);
      q[0] = __uint_as_float((unsigned)qq << 16); q[1] = __uint_as_float((unsigned)qq & 0xffff0000u); q[2] = __uint_as_float((unsigned)(qq >> 32) << 16); q[3] = __uint_as_float((unsigned)(qq >> 32) & 0xffff0000u); }
    const float* ckb = ck + ((size_t)b * WCTX * 8 + h) * 64 + 4 * l16; const float* cvb = cv + ((size_t)b * WCTX * 8 + h) * 64 + 4 * l16;
#pragma unroll 1
    for (int c0 = 0; c0 < 50; c0 += 25) {
        f32x4 kvv[25];
#pragma unroll
        for (int u = 0; u < 25; ++u) { const int k = 4 * (hf + 2 * (c0 + u)) + sub; const int kk = k < 387 ? k : 386;
            const int g = kk / 129, j = kk - 129 * g; const int idx = WCTX + t - (j << (2 * g)); const int ic = idx >= WCTX ? WCTX - 1 : idx;
            kvv[u] = *(const GAS f32x4*)(ckb + (size_t)ic * 512); }
        __builtin_amdgcn_sched_barrier(0);
#pragma unroll
        for (int u = 0; u < 25; ++u) { const int k = 4 * (hf + 2 * (c0 + u)) + sub; const bool valid = k < 387; const int kk = valid ? k : 386;
            const int g = kk / 129, j = kk - 129 * g; const int idx = WCTX + t - (j << (2 * g)); const bool isnew = idx >= WCTX;
            const f32x4 kv = kvv[u];
            float s = q[0] * kv[0] + q[1] * kv[1] + q[2] * kv[2] + q[3] * kv[3];
            s += __shfl_xor(s, 1); s += __shfl_xor(s, 2); s += __shfl_xor(s, 4); s += __shfl_xor(s, 8);
            if (l16 == 0 && valid && !isnew) sc[t * 388 + k] = s; }
        __builtin_amdgcn_sched_barrier(0);
    }
#define SMP_NEWPAIR(pi, kvar, rvar) const bool pv_ = (pi) < t + 3; const int kvar = (pi) <= t ? (pi) : ((pi) == t + 1 ? 129 : 258); const int rvar = (pi) <= t ? t - (pi) : t;
    if (hf == 0) {
#pragma unroll
        for (int i = 0; i < 2; ++i) { SMP_NEWPAIR(4 * i + sub, kn, rn)
            const unsigned long long x = *(const GAS unsigned long long*)(ZS + (size_t)(b * 4 + rn) * DIN + C_KA + h * 64 + 4 * l16);
            float s = q[0] * __uint_as_float((unsigned)x << 16) + q[1] * __uint_as_float((unsigned)x & 0xffff0000u) + q[2] * __uint_as_float((unsigned)(x >> 32) << 16) + q[3] * __uint_as_float((unsigned)(x >> 32) & 0xffff0000u);
            s += __shfl_xor(s, 1); s += __shfl_xor(s, 2); s += __shfl_xor(s, 4); s += __shfl_xor(s, 8);
            if (l16 == 0 && pv_) sc[t * 388 + kn] = s; }
    }
    __syncthreads();
    if (w < 4) {
        float m = -INFINITY;
        for (int k = lane; k < 387; k += 64) m = fmaxf(m, sc[t * 388 + k]);
#pragma unroll
        for (int o = 1; o < 64; o <<= 1) m = fmaxf(m, __shfl_xor(m, o));
        float l = 0.f;
        for (int k = lane; k < 387; k += 64) { const float e = exp2f(sc[t * 388 + k] - m); sc[t * 388 + k] = e; l += e; }
        l = wave_sum(l);
        if (lane == 0) { ml[t] = l; sc[t * 388 + 387] = 0.f; }
    }
    __syncthreads();
    float a4[4] = {0.f, 0.f, 0.f, 0.f};
#pragma unroll 1
    for (int c0 = 0; c0 < 50; c0 += 25) {
        f32x4 vvv[25];
#pragma unroll
        for (int u = 0; u < 25; ++u) { const int k = 4 * (hf + 2 * (c0 + u)) + sub; const int kk = k < 387 ? k : 386;
            const int g = kk / 129, j = kk - 129 * g; const int idx = WCTX + t - (j << (2 * g)); const int ic = idx >= WCTX ? WCTX - 1 : idx;
            vvv[u] = *(const GAS f32x4*)(cvb + (size_t)ic * 512); }
        __builtin_amdgcn_sched_barrier(0);
#pragma unroll
        for (int u = 0; u < 25; ++u) { const int k = 4 * (hf + 2 * (c0 + u)) + sub; const bool valid = k < 387; const int kk = valid ? k : 386;
            const int g = kk / 129, j = kk - 129 * g; const int idx = WCTX + t - (j << (2 * g)); const bool isnew = idx >= WCTX;
            const f32x4 vv = vvv[u];
            const float p = (valid && !isnew) ? sc[t * 388 + kk] : 0.f;
#pragma unroll
            for (int i = 0; i < 4; ++i) a4[i] += p * vv[i]; }
        __builtin_amdgcn_sched_barrier(0);
    }
    if (hf == 0) {
#pragma unroll
        for (int i = 0; i < 2; ++i) { SMP_NEWPAIR(4 * i + sub, kn, rn)
            const unsigned long long x = *(const GAS unsigned long long*)(ZS + (size_t)(b * 4 + rn) * DIN + C_VA + h * 64 + 4 * l16);
            const float p = pv_ ? sc[t * 388 + kn] : 0.f;
            a4[0] += p * __uint_as_float((unsigned)x << 16); a4[1] += p * __uint_as_float((unsigned)x & 0xffff0000u); a4[2] += p * __uint_as_float((unsigned)(x >> 32) << 16); a4[3] += p * __uint_as_float((unsigned)(x >> 32) & 0xffff0000u); }
    }
#undef SMP_NEWPAIR
#pragma unroll
    for (int i = 0; i < 4; ++i) { a4[i] += __shfl_xor(a4[i], 16); a4[i] += __shfl_xor(a4[i], 32); }
    if (lane < 16) { part[w * 64 + 4 * l16 + 0] = a4[0]; part[w * 64 + 4 * l16 + 1] = a4[1]; part[w * 64 + 4 * l16 + 2] = a4[2]; part[w * 64 + 4 * l16 + 3] = a4[3]; }
    __syncthreads();
    if (w < 4) { const float o = (part[w * 64 + lane] + part[(w + 4) * 64 + lane]) / ml[w];
        CATS[(size_t)(b * 4 + w) * DM + 512 + h * 64 + lane] = (bf16)f2bf(o); }
    __syncthreads();
}
__device__ __forceinline__ void sample_ret_unit(Frame& F, int b, int h, const float* s0, float* s1, const float* gnw) {
    const bf16* ZS = (const bf16*)(F.ws + WS_SMP + SM_ZB); bf16* CATS = (bf16*)(F.ws + WS_SMP + SM_CATB);
    LAS float* qs = (LAS float*)F.lds; LAS float* ks = qs + 512; LAS float* vs = ks + 512; LAS float* part = vs + 512; LAS float* ob = part + 512;
    const int tid = F.tid, lane = F.lane, w = F.wave, e = tid & 127, dq = tid >> 7;
    { const int tt = tid >> 7, dd = tid & 127; const bf16* zr = ZS + (size_t)(b * 4 + tt) * DIN + h * 128 + dd;
      qs[tid] = __uint_as_float((unsigned)zr[C_QR] << 16); ks[tid] = __uint_as_float((unsigned)zr[C_KR] << 16); vs[tid] = __uint_as_float((unsigned)zr[C_VR] << 16); }
    const size_t sbase = ((size_t)b * 4 + h) * 16384;
    float S[32];
#pragma unroll
    for (int d = 0; d < 32; ++d) S[d] = s0[sbase + (size_t)(32 * dq + d) * 128 + e];
    const float gam = 1.f - exp2f(-5.f - (float)h);
    __syncthreads();
#pragma unroll 1
    for (int t = 0; t < 4; ++t) {
        const float v = vs[t * 128 + e]; float po = 0.f;
#pragma unroll
        for (int d = 0; d < 32; ++d) { S[d] = gam * S[d] + ks[t * 128 + 32 * dq + d] * v; po += qs[t * 128 + 32 * dq + d] * S[d]; }
        part[dq * 128 + e] = po;
        __syncthreads();
        if (dq == 0) ob[t * 128 + e] = (part[e] + part[128 + e]) + (part[256 + e] + part[384 + e]);
        __syncthreads();
    }
#pragma unroll
    for (int d = 0; d < 32; ++d) s1[sbase + (size_t)(32 * dq + d) * 128 + e] = S[d];
    if (w < 4) { const int t = w; const float a = ob[t * 128 + lane], c = ob[t * 128 + 64 + lane];
        const float mu = wave_sum(a + c) * (1.f / 128.f); const float var = wave_sum((a - mu) * (a - mu) + (c - mu) * (c - mu)) * (1.f / 128.f); const float rstd = 1.f / sqrtf(var + EPS);
        const bf16* zr = ZS + (size_t)(b * 4 + t) * DIN + C_GR + h * 128;
        const float g0 = __uint_as_float((unsigned)zr[lane] << 16), g1 = __uint_as_float((unsigned)zr[64 + lane] << 16);
        CATS[(size_t)(b * 4 + t) * DM + h * 128 + lane] = (bf16)f2bf(silu_f(g0) * ((a - mu) * rstd * gnw[h * 128 + lane]));
        CATS[(size_t)(b * 4 + t) * DM + h * 128 + 64 + lane] = (bf16)f2bf(silu_f(g1) * ((c - mu) * rstd * gnw[h * 128 + 64 + lane])); }
    __syncthreads();
}
#if defined(__HIP_DEVICE_COMPILE__)
#define MK_ASSUME_GLOBAL(p) do { __builtin_assume(!__builtin_amdgcn_is_shared((const void*)(p))); __builtin_assume(!__builtin_amdgcn_is_private((const void*)(p))); } while (0)
#else
#define MK_ASSUME_GLOBAL(p) do { } while (0)
#endif
#define MK_REFRESH() do { int t_; asm volatile("v_mbcnt_lo_u32_b32 %0, -1, 0\n\tv_mbcnt_hi_u32_b32 %0, -1, %0" : "=v"(t_)); t_ += wave_s * 64;     F.tid = t_; F.lane = t_ & 63; F.wave = __builtin_amdgcn_readfirstlane(t_ >> 6); \
    GAS unsigned char* w_ = (GAS unsigned char*)args.ws; asm volatile("" : "+s"(w_)); F.ws = (unsigned char*)w_;     F.ctl = (gu32*)(w_ + WS_CTL); { GAS float* o_ = (GAS float*)args.out; asm volatile("" : "+s"(o_)); outp = (float*)o_; } \
    bx = blockIdx.x; asm volatile("" : "+s"(bx)); F.G = gridDim.x; F.vcu = (F.G % 8 == 0) ? (bx % 8) * (F.G / 8) + bx / 8 : bx; } while (0)
#define MK_FRAME_SETUP() \
    extern __shared__ __attribute__((aligned(16))) unsigned char lds[]; \
    Frame F; F.lds = (LAS unsigned char*)lds; F.MISC = (volatile LAS unsigned*)(F.lds + MISC_OFF); \
    F.tid = threadIdx.x; F.lane = F.tid & 63; F.wave = __builtin_amdgcn_readfirstlane(F.tid >> 6); \
    F.G = gridDim.x; { const int bx = blockIdx.x; F.vcu = (F.G % 8 == 0) ? (bx % 8) * (F.G / 8) + bx / 8 : bx; } \
    F.ws = args.ws; F.ctl = (gu32*)(args.ws + WS_CTL);

enum { I_XP = 0, I_XS = 1, I_CK = 2, I_CV = 3, I_SRET = 4, I_SCONV = 5, I_N1W = 6, I_WIN = 7, I_GNW = 8, I_WOUT = 9, I_N2W = 10, I_WUP = 11, I_CW = 12, I_CB = 13, I_WDN = 14, I_FNW = 15 };
constexpr size_t O_YP = 0, O_YS = O_YP + (size_t)MP * DM, O_PWK = O_YS + (size_t)MS * DM, O_PWV = O_PWK + (size_t)DEPTH * NBATCH * 2048 * 512,
                 O_PRET = O_PWV + (size_t)DEPTH * NBATCH * 2048 * 512, O_PCONV = O_PRET + (size_t)DEPTH * NBATCH * 4 * 16384, O_SWK = O_PCONV + (size_t)DEPTH * NBATCH * 2 * DUP,
                 O_SWV = O_SWK + (size_t)DEPTH * MS * 512, O_SRET = O_SWV + (size_t)DEPTH * MS * 512, O_SCONV = O_SRET + (size_t)DEPTH * DBATCH * 4 * 16384, O_END = O_SCONV + (size_t)DEPTH * DBATCH * 2 * DUP;


__global__ void __launch_bounds__(NWAVES * 64, 2) mk_fwd(Args args) {
    MK_FRAME_SETUP();
#define INP(i) ((const float*)(const GAS float*)args.in[i])
    float* outp = args.out; int bx = blockIdx.x; const int wave_s = __builtin_amdgcn_readfirstlane((int)threadIdx.x >> 6);
    for (int u = F.tid; u < (LDS_BYTES - LDSCTL_OFF) / 4; u += NWAVES * 64) ((LAS unsigned*)(F.lds + LDSCTL_OFF))[u] = 0u;
    __syncthreads();
    XcdBarrier bar = xcd_barrier_post((unsigned*)(F.ctl + CW_BAR), F.MISC + 8);
#define XRES ((float*)(F.ws + WS_XRES))
#define XS ((float*)(F.ws + WS_SMP + SM_X))
    p0_prologue(F, INP(I_WIN), INP(I_WOUT), INP(I_WUP), INP(I_WDN), INP(I_N1W), INP(I_N2W), INP(I_XP));
    { const int gw = F.vcu * NWAVES + F.wave, NGW = F.G * NWAVES;
      for (int r = NGW - 1 - gw; r < MS; r += NGW) { const GAS f32x4* xr = (const GAS f32x4*)(INP(I_XS) + (size_t)r * DM) + F.lane; GAS f32x4* xo = (GAS f32x4*)(XS + (size_t)r * DM) + F.lane;
          GAS unsigned long long* o8 = (GAS unsigned long long*)((bf16*)(F.ws + WS_SMP + SM_HB) + (size_t)r * DM) + F.lane; float s = 0.f;
#pragma unroll
          for (int j = 0; j < 4; ++j) { const f32x4 v = xr[64 * j]; xo[64 * j] = v; s += (v.x * v.x + v.y * v.y) + (v.z * v.z + v.w * v.w); o8[64 * j] = (unsigned long long)pk2(v.x, v.y) | ((unsigned long long)pk2(v.z, v.w) << 32); }
          s = wave_sum(s); ((float*)(F.ws + WS_SMP + SM_SS))[(size_t)r * 64 + F.lane] = (F.lane == 0) ? s : 0.f; } }
    MK_REFRESH(); xcd_barrier(bar, F.tid); MK_REFRESH();
    for (int l = 0; l < DEPTH; ++l) {
        {
            pg8::Gemm g{(const pg8::bf16_t*)(F.ws + WS_HB), (const pg8::bf16_t*)(F.ws + WS_WIN) + (size_t)l * DIN * DM, MP, DIN, DM}; pg8::StaticOrder S; S.init(MP, DIN, F.G, bx);
            pg8::EpiIn E{(pg8::bf16_t*)(F.ws + WS_ZB), (const float*)(F.ws + WS_T64), (const float*)(F.ws + WS_T32), outp + O_PWK + (size_t)l * NBATCH * 2048 * 512, outp + O_PWV + (size_t)l * NBATCH * 2048 * 512, (const float*)(F.ws + WS_SS1)};
            if (bx >= F.G / 2) sample_win_tasks(F, bx - F.G / 2, F.G - F.G / 2, (const bf16*)(F.ws + WS_WIN) + (size_t)l * DIN * DM, outp + O_SWK + (size_t)l * MS * 512, outp + O_SWV + (size_t)l * MS * 512);
            pg8::gemm_phase<pg8::EpiIn, pg8::StaticOrder, true, true>(F.lds + RING_OFF, g, S, E, F.tid);
        }
        MK_REFRESH(); xcd_barrier(bar, F.tid); MK_REFRESH();
        {
#define MK_SAMPLE_UNITS() do { \
                for (int u = F.G - 1 - F.vcu; u < 256; u += F.G) sample_attn_unit(F, u >> 3, u & 7, INP(I_CK) + (size_t)l * DBATCH * WCTX * 512, INP(I_CV) + (size_t)l * DBATCH * WCTX * 512); \
                for (int u = F.vcu; u < 128; u += F.G) sample_ret_unit(F, u >> 2, u & 3, INP(I_SRET) + (size_t)l * DBATCH * 4 * 16384, outp + O_SRET + (size_t)l * DBATCH * 4 * 16384, INP(I_GNW) + (size_t)l * 512); } while (0)
            if (F.vcu & 1) MK_SAMPLE_UNITS();
            attn_prompt_units(F);
            for (int u = F.vcu; u < 512; u += F.G) ret_upd_unit(F, u >> 5, u & 31);
            if (!(F.vcu & 1)) MK_SAMPLE_UNITS();
#undef MK_SAMPLE_UNITS
        }
        MK_REFRESH(); xcd_barrier(bar, F.tid); MK_REFRESH();
        ret_scan(F, outp + O_PRET + (size_t)l * NBATCH * 4 * 16384);
#if defined(DBG_NAIVE_RESID)
        sample_resid_naive(F, (const bf16*)(F.ws + WS_SMP + SM_CATB), (const bf16*)(F.ws + WS_WOUT) + (size_t)l * DM * DM, DM);
#else
        for (int task = bx; task < 256; task += F.G) sample_resid_task<128>(F, (const bf16*)(F.ws + WS_SMP + SM_CATB), (const bf16*)(F.ws + WS_WOUT) + (size_t)l * DM * DM, DM, task);
#endif
        MK_REFRESH(); xcd_barrier(bar, F.tid); MK_REFRESH();
        { for (int u = F.vcu; u < 256; u += F.G) ret_out_pair(F, u, INP(I_GNW) + (size_t)l * 512); combine_prompt(F); }
        MK_REFRESH(); xcd_barrier(bar, F.tid); MK_REFRESH();
        {
            pg8::Gemm g{(const pg8::bf16_t*)(F.ws + WS_CATB), (const pg8::bf16_t*)(F.ws + WS_WOUT) + (size_t)l * DM * DM, MP, DM, DM}; pg8::StaticOrder S; S.init(MP, DM, F.G, bx);
            pg8::EpiResidNorm E{(pg8::bf16_t*)(F.ws + WS_HB), (float*)(F.ws + WS_SS2)};
            pg8::gemm_phase<pg8::EpiResidNorm, pg8::StaticOrder, true, true>(F.lds + RING_OFF, g, S, E, F.tid);
        }
        MK_REFRESH(); xcd_barrier(bar, F.tid); MK_REFRESH();
        {
            pg8::Gemm g{(const pg8::bf16_t*)(F.ws + WS_HB), (const pg8::bf16_t*)(F.ws + WS_WUP) + (size_t)l * DUP * DM, MP, DUP, DM}; pg8::StaticOrder S; S.init(MP, DUP, F.G, bx);
            pg8::EpiUpConv E{(pg8::bf16_t*)(F.ws + WS_AB), (float*)(F.ws + WS_UB), outp + O_PCONV + (size_t)l * NBATCH * 2 * DUP, INP(I_CW) + (size_t)l * 3 * DUP, INP(I_CB) + (size_t)l * DUP, (PG8_LAS float*)(F.lds + EXB_OFF), (const float*)(F.ws + WS_SS2)};
            if (bx >= F.G / 2) sample_up_tasks(F, bx - F.G / 2, F.G - F.G / 2, (const bf16*)(F.ws + WS_WUP) + (size_t)l * DUP * DM, INP(I_SCONV) + (size_t)l * DBATCH * 2 * DUP, INP(I_CW) + (size_t)l * 3 * DUP, INP(I_CB) + (size_t)l * DUP, outp + O_SCONV + (size_t)l * DBATCH * 2 * DUP);
            pg8::gemm_phase<pg8::EpiUpConv, pg8::StaticOrder, true, true>(F.lds + RING_OFF, g, S, E, F.tid);
        }
        MK_REFRESH(); xcd_barrier(bar, F.tid); MK_REFRESH();
        {
            conv_fixup_phase(F, INP(I_CW) + (size_t)l * 3 * DUP, INP(I_CB) + (size_t)l * DUP);
#if defined(DBG_NAIVE_RESID)
            sample_resid_naive(F, (const bf16*)(F.ws + WS_SMP + SM_AB), (const bf16*)(F.ws + WS_WDN) + (size_t)l * DM * DFF, DFF);
#else
            for (int task = bx; task < 256; task += F.G) sample_resid_task<352>(F, (const bf16*)(F.ws + WS_SMP + SM_AB), (const bf16*)(F.ws + WS_WDN) + (size_t)l * DM * DFF, DFF, task);
#endif
        }
        MK_REFRESH(); xcd_barrier(bar, F.tid); MK_REFRESH();
        {
            pg8::Gemm g{(const pg8::bf16_t*)(F.ws + WS_AB), (const pg8::bf16_t*)(F.ws + WS_WDN) + (size_t)l * DM * DFF, MP, DM, DFF}; pg8::StaticOrder S; S.init(MP, DM, F.G, bx);
            pg8::EpiResidNorm E{(pg8::bf16_t*)(F.ws + WS_HB), (float*)(F.ws + WS_SS1)};
            pg8::gemm_phase<pg8::EpiResidNorm, pg8::StaticOrder, true, true>(F.lds + RING_OFF, g, S, E, F.tid);
        }
        MK_REFRESH(); xcd_barrier(bar, F.tid); MK_REFRESH();
    }
    final_norm_phase(F, (const bf16*)(F.ws + WS_HB), XS, INP(I_FNW), outp + O_YP, outp + O_YS);
}

extern "C" void kernel_launch(void* const* d_in, const int* in_sizes, int n_in, void* d_out, int out_size, void* d_ws, size_t ws_size, hipStream_t stream) {
    static int grid = 0;
    if (grid == 0) {
        if (n_in != 16 || (size_t)out_size != O_END || ws_size < WS_OPT_END) { fprintf(stderr, "kernel_launch: unexpected sizes (n_in %d out %d ws %zu)\n", n_in, out_size, ws_size); grid = -1; return; }
        int dev = 0, cus = 0, per_cu = 0;
        if (hipGetDevice(&dev) != hipSuccess || hipDeviceGetAttribute(&cus, hipDeviceAttributeMultiprocessorCount, dev) != hipSuccess) { grid = -1; return; }
        if (hipFuncSetAttribute((const void*)mk_fwd, hipFuncAttributeMaxDynamicSharedMemorySize, LDS_BYTES) != hipSuccess) { fprintf(stderr, "kernel_launch: hipFuncSetAttribute failed\n"); grid = -1; return; }
        if (hipOccupancyMaxActiveBlocksPerMultiprocessor(&per_cu, (const void*)mk_fwd, NWAVES * 64, LDS_BYTES) != hipSuccess || per_cu < 1) { fprintf(stderr, "kernel_launch: occupancy query says %d blocks per CU\n", per_cu); }
        (void)hipGetLastError();
        grid = cus;
    }
    if (grid < 0) return;
    if (hipMemsetAsync((char*)d_ws + WS_CTL, 0, CTL_ZERO_BYTES, stream) != hipSuccess) return;
    Args a{}; for (int i = 0; i < 16; ++i) a.in[i] = (const float*)d_in[i];
    a.out = (float*)d_out; a.ws = (unsigned char*)d_ws; a.layer = 0; a.pad = 0;
    hipLaunchKernelGGL(mk_fwd, dim3(grid), dim3(NWAVES * 64), LDS_BYTES, stream, a);
}
```

```cpp
#include <hip/hip_runtime.h>
#include <cstdio>
#include <cstdint>
#include <cmath>
namespace pg8 {
#define PG8_LAS __attribute__((address_space(3)))
typedef unsigned short bf16_t;
typedef short bf16x8 __attribute__((ext_vector_type(8)));
typedef float f32x4 __attribute__((ext_vector_type(4)));
typedef unsigned u32x4 __attribute__((ext_vector_type(4)));
constexpr int BM = 256, BK = 64, HALF = 128, HTB = HALF * BK * 2  , STAGE_BYTES = 8 * HTB, NXCD = 8, WGM = 8;

__host__ __device__ __forceinline__ int lds_byte(int r, int c) { const int st = (r >> 4) * 2 + (c >> 5), rr = r & 15, cc = c & 31, ob = rr * 64 + cc * 2; return st * 1024 + (ob ^ (((ob >> 9) & 1) << 5)); }
__host__ __device__ __forceinline__ void stage_rc(int b, int& R, int& C) { const int st = b / 1024, sb = b % 1024, swz = sb ^ (((sb >> 9) & 1) << 5); R = (st >> 1) * 16 + swz / 64; C = (st & 1) * 32 + (swz % 64) / 2; }
__host__ __device__ __forceinline__ int perm32(int rho) { const int n = rho >> 4, i = rho & 15; return 8 * (i >> 2) + 4 * n + (i & 3); }

struct Unit { int pm, pn; };
struct Gemm { const bf16_t* A; const bf16_t* Bt; int M, N, K; };

struct StaticOrder {
    int nM, nN, nwg, G, c; bool wperm = false;
    __host__ __device__ void init(int M, int N, int G_, int c_) { nM = M / BM; nN = N / BM; nwg = nM * nN; G = G_; c = c_; }
    __host__ __device__ bool next(int i, Unit& u) const {
        const long L = (long)i * G + c; if (L >= nwg) return false;
        int wgid = (int)L; { const int q = nwg / NXCD, r = nwg % NXCD, xcd = wgid % NXCD, off = wgid / NXCD; wgid = (xcd < r ? xcd * (q + 1) : r * (q + 1) + (xcd - r) * q) + off; }
        const int nig = WGM * nN, gid = wgid / nig, fm = gid * WGM, gsz = (nM - fm) < WGM ? (nM - fm) : WGM;
        u.pm = fm + ((wgid % nig) % gsz); u.pn = (wgid % nig) / gsz; if (wperm) u.pn = (int)(((u.pn < 8 ? 0xDC32BA10u >> (4 * u.pn) : 0x987654u >> (4 * (u.pn - 8)))) & 15u); return true;
    }
    __device__ __forceinline__ void a_ready(const Unit&) const {}
    __device__ __forceinline__ void done(const Unit&) const {}
};

__device__ __forceinline__ unsigned cvt_pk_bf16(float lo, float hi) { unsigned r; asm volatile("v_cvt_pk_bf16_f32 %0, %1, %2" : "=v"(r) : "v"(lo), "v"(hi)); return r; }
typedef float f32x2 __attribute__((ext_vector_type(2)));
constexpr float KR_SCALE = 0.08838834764831845f;
constexpr float QA_SCALE = 0.125f * 1.4426950408889634f;
constexpr int ZLD = 3584;
__device__ __forceinline__ float row_rstd(const float* ssp, int row, int fq) {
    const f32x4 a = *(const f32x4*)(ssp + (size_t)row * 16 + 4 * fq); float s = (a[0] + a[1]) + (a[2] + a[3]); s += __shfl_xor(s, 16); s += __shfl_xor(s, 32); return 1.f / sqrtf(s * (1.f / 1024.f) + 1e-6f); }
__device__ __forceinline__ u32x4 pack8(const f32x4& a, const f32x4& b) { u32x4 w; w.x = cvt_pk_bf16(a[0], a[1]); w.y = cvt_pk_bf16(a[2], a[3]); w.z = cvt_pk_bf16(b[0], b[1]); w.w = cvt_pk_bf16(b[2], b[3]); return w; }
struct EpiIn {
    static constexpr bool PERM = true, AFTER_DRAIN = false, APERM = false;
    bf16_t* Z; const float* T64; const float* T32; float* pwk; float* pwv; const float* ss;
    __device__ __forceinline__ void operator()(const f32x4 (&acc)[2][2][4][2], const Unit& u, int wr, int wc, int fr, int fq) const {
        const int pn = u.pn; const int row0 = u.pm * BM + wr * 64 + fr;
        if ((pn >= 4 && pn < 8) || pn >= 12) {
            const int colb = pn * BM + wc * 32 + 8 * fq;
#pragma unroll
            for (int ai = 0; ai < 2; ++ai)
#pragma unroll
                for (int m = 0; m < 4; ++m) { const int row = row0 + ai * HALF + m * 16; bf16_t* rowp = Z + (size_t)row * ZLD + colb; const float rs = row_rstd(ss, row, fq);
#pragma unroll
                    for (int bj = 0; bj < 2; ++bj) { const f32x4 v0 = acc[ai][bj][m][0] * rs, v1 = acc[ai][bj][m][1] * rs;
                        *(u32x4*)(rowp + bj * HALF) = pack8(v0, v1);
                        if (pn >= 12) { const int t = row & 4095; if (t >= 2048) { float* o = pwv + ((size_t)((row >> 12) * 2048 + (t - 2048))) * 512 + (colb + bj * HALF - 3072); *(f32x4*)o = v0; *(f32x4*)(o + 4) = v1; } } } }
        } else {
            const bool hd128 = pn < 4;
            int featbase, d0, half, tstride; const float* T;
            if (hd128) { const int head = 2 * (pn & 1) + (wc >> 1); d0 = 32 * (wc & 1) + 8 * fq; featbase = (pn >> 1) * 512 + head * 128 + d0; half = 64; T = T64; tstride = 64; }
            else { const int head = 4 * (pn & 1) + wc; d0 = 8 * fq; featbase = 2048 + ((pn - 8) >> 1) * 512 + head * 64 + d0; half = 32; T = T32; tstride = 32; }
            const float sc0 = (pn < 2) ? 1.f : (pn < 4) ? KR_SCALE : (pn < 10) ? QA_SCALE : 1.f;
            const bool is_ka = (pn == 10 || pn == 11);
            f32x4 nc0, nc1, nc2, nc3, np;
            { const f32x4* tp = (const f32x4*)(T + ((size_t)(row0 & 4095) * tstride + d0) * 2); nc0 = tp[0]; nc1 = tp[1]; nc2 = tp[2]; nc3 = tp[3]; np = *(const f32x4*)(ss + (size_t)row0 * 16 + 4 * fq); }
#pragma unroll
            for (int ai = 0; ai < 2; ++ai)
#pragma unroll
                for (int m = 0; m < 4; ++m) { const int row = row0 + ai * HALF + m * 16; const int t = row & 4095;
                    const f32x4 cs0 = nc0, cs1 = nc1, cs2 = nc2, cs3 = nc3; const f32x4 pp = np;
                    if (ai * 4 + m < 7) { const int rown = row0 + ((ai * 4 + m + 1) >> 2) * HALF + ((ai * 4 + m + 1) & 3) * 16;
                        const f32x4* tp = (const f32x4*)(T + ((size_t)(rown & 4095) * tstride + d0) * 2); nc0 = tp[0]; nc1 = tp[1]; nc2 = tp[2]; nc3 = tp[3]; np = *(const f32x4*)(ss + (size_t)rown * 16 + 4 * fq); }
                    __builtin_amdgcn_sched_barrier(0);
                    float sq = (pp[0] + pp[1]) + (pp[2] + pp[3]); sq += __shfl_xor(sq, 16); sq += __shfl_xor(sq, 32); const float sc = sc0 / sqrtf(sq * (1.f / 1024.f) + 1e-6f);
                    const f32x4 xa0 = acc[ai][0][m][0], xa1 = acc[ai][0][m][1], xb0 = acc[ai][1][m][0], xb1 = acc[ai][1][m][1];
                    f32x4 o10, o11, o20, o21;
                    o10[0] = (xa0[0] * cs0[0] - xb0[0] * cs0[1]) * sc; o20[0] = (xb0[0] * cs0[0] + xa0[0] * cs0[1]) * sc;
                    o10[1] = (xa0[1] * cs0[2] - xb0[1] * cs0[3]) * sc; o20[1] = (xb0[1] * cs0[2] + xa0[1] * cs0[3]) * sc;
                    o10[2] = (xa0[2] * cs1[0] - xb0[2] * cs1[1]) * sc; o20[2] = (xb0[2] * cs1[0] + xa0[2] * cs1[1]) * sc;
                    o10[3] = (xa0[3] * cs1[2] - xb0[3] * cs1[3]) * sc; o20[3] = (xb0[3] * cs1[2] + xa0[3] * cs1[3]) * sc;
                    o11[0] = (xa1[0] * cs2[0] - xb1[0] * cs2[1]) * sc; o21[0] = (xb1[0] * cs2[0] + xa1[0] * cs2[1]) * sc;
                    o11[1] = (xa1[1] * cs2[2] - xb1[1] * cs2[3]) * sc; o21[1] = (xb1[1] * cs2[2] + xa1[1] * cs2[3]) * sc;
                    o11[2] = (xa1[2] * cs3[0] - xb1[2] * cs3[1]) * sc; o21[2] = (xb1[2] * cs3[0] + xa1[2] * cs3[1]) * sc;
                    o11[3] = (xa1[3] * cs3[2] - xb1[3] * cs3[3]) * sc; o21[3] = (xb1[3] * cs3[2] + xa1[3] * cs3[3]) * sc;
                    bf16_t* rowp = Z + (size_t)row * ZLD + featbase;
                    *(u32x4*)rowp = pack8(o10, o11); *(u32x4*)(rowp + half) = pack8(o20, o21);
                    if (is_ka && t >= 2048) { float* o = pwk + ((size_t)((row >> 12) * 2048 + (t - 2048))) * 512 + (featbase - 2560);
                        *(f32x4*)o = o10; *(f32x4*)(o + 4) = o11; *(f32x4*)(o + half) = o20; *(f32x4*)(o + half + 4) = o21; } }
        }
    }
};
struct EpiResid {
    static constexpr bool PERM = false, AFTER_DRAIN = false, APERM = false;
    const float* base; float* out;
    __device__ __forceinline__ void operator()(const f32x4 (&acc)[2][2][4][2], const Unit& u, int wr, int wc, int fr, int fq) const {
        const int col0 = u.pn * BM + wc * 32 + 4 * fq;
#pragma unroll
        for (int ai = 0; ai < 2; ++ai)
#pragma unroll
            for (int m = 0; m < 4; ++m) { const size_t off = (size_t)(u.pm * BM + ai * HALF + wr * 64 + m * 16 + fr) * 1024 + col0;
#pragma unroll
                for (int bj = 0; bj < 2; ++bj)
#pragma unroll
                    for (int n = 0; n < 2; ++n) { const f32x4 b = *(const f32x4*)(base + off + bj * HALF + n * 16); *(f32x4*)(out + off + bj * HALF + n * 16) = b + acc[ai][bj][m][n]; } }
    }
};
struct EpiResidNorm {
    static constexpr bool PERM = true, AFTER_DRAIN = false, APERM = false;
    bf16_t* xb; float* ss;
    __device__ __forceinline__ void operator()(const f32x4 (&acc)[2][2][4][2], const Unit& u, int wr, int wc, int fr, int fq) const {
        const int col0 = u.pn * BM + wc * 32 + 8 * fq;
#pragma unroll
        for (int ai = 0; ai < 2; ++ai) {
            u32x4 xin[2][4][2];
#pragma unroll
            for (int m = 0; m < 4; ++m)
#pragma unroll
                for (int bj = 0; bj < 2; ++bj) xin[ai][m][bj] = *(const u32x4*)(xb + (size_t)(u.pm * BM + ai * HALF + wr * 64 + m * 16 + fr) * 1024 + col0 + bj * HALF);
#pragma unroll
            for (int m = 0; m < 4; ++m) { const int row = u.pm * BM + ai * HALF + wr * 64 + m * 16 + fr; const size_t off = (size_t)row * 1024 + col0; float s = 0.f;
#pragma unroll
                for (int bj = 0; bj < 2; ++bj) { const u32x4 b = xin[ai][m][bj];
                    f32x4 x0, x1;
                    x0[0] = __uint_as_float(b.x << 16) + acc[ai][bj][m][0][0]; x0[1] = __uint_as_float(b.x & 0xffff0000u) + acc[ai][bj][m][0][1]; x0[2] = __uint_as_float(b.y << 16) + acc[ai][bj][m][0][2]; x0[3] = __uint_as_float(b.y & 0xffff0000u) + acc[ai][bj][m][0][3];
                    x1[0] = __uint_as_float(b.z << 16) + acc[ai][bj][m][1][0]; x1[1] = __uint_as_float(b.z & 0xffff0000u) + acc[ai][bj][m][1][1]; x1[2] = __uint_as_float(b.w << 16) + acc[ai][bj][m][1][2]; x1[3] = __uint_as_float(b.w & 0xffff0000u) + acc[ai][bj][m][1][3];
                    *(u32x4*)(xb + off + bj * HALF) = pack8(x0, x1);
                    s += (x0[0] * x0[0] + x0[1] * x0[1]) + (x0[2] * x0[2] + x0[3] * x0[3]) + (x1[0] * x1[0] + x1[1] * x1[1]) + (x1[2] * x1[2] + x1[3] * x1[3]); }
                s += __shfl_xor(s, 16); s += __shfl_xor(s, 32);
                if (fq == 0) ss[(size_t)row * 16 + u.pn * 4 + wc] = s; }
        }
    }
};
struct EpiUp {
    static constexpr bool PERM = true, AFTER_DRAIN = false, APERM = false;
    bf16_t* U; float* pconv;
    __device__ __forceinline__ void operator()(const f32x4 (&acc)[2][2][4][2], const Unit& u, int wr, int wc, int fr, int fq) const {
        const int row0 = u.pm * BM + wr * 64 + fr, col0 = u.pn * BM + wc * 32 + 8 * fq;
#pragma unroll
        for (int ai = 0; ai < 2; ++ai)
#pragma unroll
            for (int m = 0; m < 4; ++m) { const int row = row0 + ai * HALF + m * 16; bf16_t* rowp = U + (size_t)row * 5632 + col0; const int t = row & 4095;
#pragma unroll
                for (int bj = 0; bj < 2; ++bj) { const f32x4 v0 = acc[ai][bj][m][0], v1 = acc[ai][bj][m][1];
                    *(u32x4*)(rowp + bj * HALF) = pack8(v0, v1);
                    if (t >= 4094) { float* o = pconv + ((size_t)((row >> 12) * 2 + (t - 4094))) * 5632 + col0 + bj * HALF; *(f32x4*)o = v0; *(f32x4*)(o + 4) = v1; } } }
    }
};

#define PG8_DPP(oldv, src, ctrl) __builtin_bit_cast(float, __builtin_amdgcn_update_dpp(__builtin_bit_cast(int, (oldv)), __builtin_bit_cast(int, (src)), (ctrl), 0xf, 0xf, false))
__device__ __forceinline__ float silu_fast(float x) { return x * __builtin_amdgcn_rcpf(1.f + __expf(-x)); }
struct EpiUpConv {
    static constexpr bool PERM = true, AFTER_DRAIN = false, APERM = true;
    bf16_t* AB; float* ubnd; float* pconv; const float* cw; const float* cb; PG8_LAS float* exb; const float* ss;
    __device__ __forceinline__ void operator()(f32x4 (&acc)[2][2][4][2], const Unit& u, int wr, int wc, int fr, int fq) const {
        const int pn = u.pn, pm = u.pm, cloc = wc * 32 + 8 * fq, gcol = 128 * pn + cloc;
        PG8_LAS float* cwl = exb + 2048;
        { int fr_ = fr; asm volatile("" : "+v"(fr_));
          const int tid = ((wr * 4 + wc) * 4 + fq) * 16 + fr_;
#pragma unroll
          for (int k = 0; k < 2; ++k) { const int i = tid + 512 * k, which = i >> 8, col = i & 255; const int feat = col < 128 ? 128 * pn + col : 2816 + 128 * pn + (col - 128);
              cwl[i] = which < 3 ? cw[which * 5632 + feat] : cb[feat]; } }
#pragma unroll
        for (int ai = 0; ai < 2; ++ai)
#pragma unroll
            for (int m = 0; m < 4; ++m) { const float rs = row_rstd(ss, pm * BM + ai * HALF + wr * 64 + 4 * fr + m, fq);
#pragma unroll
                for (int bj = 0; bj < 2; ++bj)
#pragma unroll
                    for (int n = 0; n < 2; ++n) acc[ai][bj][m][n] *= rs; }
        if (fr == 15) {
#pragma unroll
            for (int ai = 0; ai < 2; ++ai)
#pragma unroll
                for (int bj = 0; bj < 2; ++bj)
#pragma unroll
                    for (int n = 0; n < 2; ++n) { PG8_LAS float* d = exb + ((2 * ai + wr) * 2) * 256 + bj * 128 + cloc + 4 * n; *(PG8_LAS f32x4*)d = acc[ai][bj][2][n]; *(PG8_LAS f32x4*)(d + 256) = acc[ai][bj][3][n]; }
            if (wr == 1) {
#pragma unroll
                for (int bj = 0; bj < 2; ++bj)
#pragma unroll
                    for (int n = 0; n < 2; ++n)
#pragma unroll
                        for (int k = 0; k < 2; ++k) { *(f32x4*)(ubnd + ((size_t)(pm * 4 + 2 + k) * 5632 + bj * 2816 + gcol + 4 * n)) = acc[1][bj][2 + k][n];
                            if ((pm & 15) == 15) *(f32x4*)(pconv + ((size_t)((pm >> 4) * 2 + k) * 5632 + bj * 2816 + gcol + 4 * n)) = acc[1][bj][2 + k][n]; }
            }
        }
        if (wr == 0 && fr == 0) {
#pragma unroll
            for (int bj = 0; bj < 2; ++bj)
#pragma unroll
                for (int n = 0; n < 2; ++n)
#pragma unroll
                    for (int k = 0; k < 2; ++k) *(f32x4*)(ubnd + ((size_t)(pm * 4 + k) * 5632 + bj * 2816 + gcol + 4 * n)) = acc[0][bj][k][n];
        }
        asm volatile("s_waitcnt vmcnt(0) lgkmcnt(0)" ::: "memory"); __builtin_amdgcn_s_barrier(); asm volatile("" ::: "memory");
#pragma unroll
        for (int ai = 0; ai < 2; ++ai) {
            const int s = 2 * ai + wr;
#pragma unroll
            for (int n = 0; n < 2; ++n) {
                const int cl = cloc + 4 * n;
                float o[1][4][4];
                f32x4 Bg0 = {0.f, 0.f, 0.f, 0.f}, Bg1 = Bg0, Bv0 = Bg0, Bv1 = Bg0;
                if (s > 0) { const PG8_LAS float* eb = exb + ((s - 1) * 2) * 256 + cl;
                    Bg0 = *(const PG8_LAS f32x4*)eb; Bg1 = *(const PG8_LAS f32x4*)(eb + 256); Bv0 = *(const PG8_LAS f32x4*)(eb + 128); Bv1 = *(const PG8_LAS f32x4*)(eb + 256 + 128); }
                {
                    const f32x4 wg0 = *(const PG8_LAS f32x4*)(cwl + cl), wg1 = *(const PG8_LAS f32x4*)(cwl + 256 + cl), wg2 = *(const PG8_LAS f32x4*)(cwl + 512 + cl), bg = *(const PG8_LAS f32x4*)(cwl + 768 + cl);
#pragma unroll
                    for (int i = 0; i < 4; ++i) {
                        const float g0 = acc[ai][0][0][n][i], g1 = acc[ai][0][1][n][i], g2 = acc[ai][0][2][n][i], g3 = acc[ai][0][3][n][i];
                        float og1 = Bg1[i], og0 = Bg0[i];
                        asm volatile("" : "+v"(og1), "+v"(og0));
                        const float pg3 = PG8_DPP(og1, g3, 0x111), pg2 = PG8_DPP(og0, g2, 0x111);
                        o[0][0][i] = silu_fast(bg[i] + wg2[i] * g0 + wg1[i] * pg3 + wg0[i] * pg2);
                        o[0][1][i] = silu_fast(bg[i] + wg2[i] * g1 + wg1[i] * g0 + wg0[i] * pg3);
                        o[0][2][i] = silu_fast(bg[i] + wg2[i] * g2 + wg1[i] * g1 + wg0[i] * g0);
                        o[0][3][i] = silu_fast(bg[i] + wg2[i] * g3 + wg1[i] * g2 + wg0[i] * g1);
                    }
                }
                {
                    const f32x4 wv0 = *(const PG8_LAS f32x4*)(cwl + 128 + cl), wv1 = *(const PG8_LAS f32x4*)(cwl + 256 + 128 + cl), wv2 = *(const PG8_LAS f32x4*)(cwl + 512 + 128 + cl), bv = *(const PG8_LAS f32x4*)(cwl + 768 + 128 + cl);
#pragma unroll
                    for (int i = 0; i < 4; ++i) {
                        const float v0 = acc[ai][1][0][n][i], v1 = acc[ai][1][1][n][i], v2 = acc[ai][1][2][n][i], v3 = acc[ai][1][3][n][i];
                        float ov1 = Bv1[i], ov0 = Bv0[i];
                        asm volatile("" : "+v"(ov1), "+v"(ov0));
                        const float pv3 = PG8_DPP(ov1, v3, 0x111), pv2 = PG8_DPP(ov0, v2, 0x111);
                        o[0][0][i] *= bv[i] + wv2[i] * v0 + wv1[i] * pv3 + wv0[i] * pv2;
                        o[0][1][i] *= bv[i] + wv2[i] * v1 + wv1[i] * v0 + wv0[i] * pv3;
                        o[0][2][i] *= bv[i] + wv2[i] * v2 + wv1[i] * v1 + wv0[i] * v0;
                        o[0][3][i] *= bv[i] + wv2[i] * v3 + wv1[i] * v2 + wv0[i] * v1;
                    }
                }
#pragma unroll
                for (int m = 0; m < 4; ++m) { const int row = pm * BM + ai * HALF + wr * 64 + 4 * fr + m;
                    typedef unsigned u32x2 __attribute__((ext_vector_type(2)));
                    u32x2 w; w.x = cvt_pk_bf16(o[0][m][0], o[0][m][1]); w.y = cvt_pk_bf16(o[0][m][2], o[0][m][3]);
                    *(u32x2*)(AB + (size_t)row * 2816 + gcol + 4 * n) = w; }
            }
        }
    }
};
template <class Epi, class Sched, bool ALIGN_EPI = false, bool SP2 = false>
__device__ __forceinline__ void gemm_phase(PG8_LAS unsigned char* lds, const Gemm g, const Sched& S, const Epi& E, int tid_in) {
    int tid_ = tid_in; asm volatile("" : "+v"(tid_));
    const int tid = tid_, wid = __builtin_amdgcn_readfirstlane(tid >> 6), lane = tid & 63, wr = wid >> 2, wc = wid & 3, fr = lane & 15, fq = lane >> 4;
    const int K = g.K, nt = K / BK;
    unsigned voffA[2], voffB[2];
#pragma unroll
    for (int i = 0; i < 2; ++i) { int R, C; stage_rc(tid * 16 + i * 8192, R, C); const int Rb = Epi::PERM ? ((R & ~31) + perm32(R & 31)) : R;
        const int Ra = Epi::APERM ? ((R & 64) | ((R & 15) << 2) | ((R >> 4) & 3)) : R;
        voffA[i] = (unsigned)(Ra * K + C) * 2u; voffB[i] = (unsigned)(Rb * K + C) * 2u; }
    const size_t kstep = (size_t)(BK * 2);
    const size_t hstep = (size_t)HALF * K * 2;
    const size_t tstep = 2 * hstep;
    const unsigned ldsw = (unsigned)wid * 1024u;
    const int aoff = lds_byte(wr * 64 + fr, fq * 8), boff = lds_byte(wc * 32 + fr, fq * 8);
#define PG8_SA(b, h) (((b) * 2 + (h)) * HTB)
#define PG8_SB(b, h) ((4 + (b) * 2 + (h)) * HTB)
#define PG8_STAGE(bufoff, gbase, voff) do { _Pragma("unroll") for (int _i = 0; _i < 2; ++_i) \
        __builtin_amdgcn_global_load_lds((const unsigned*)((const char*)(gbase) + (voff)[_i]), (PG8_LAS unsigned*)(lds + (bufoff) + ldsw + _i * 8192), 16, 0, 0); } while (0)
#define PG8_LDA(dst, b, h) do { _Pragma("unroll") for (int m = 0; m < 4; ++m) _Pragma("unroll") for (int k = 0; k < 2; ++k) dst[m][k] = *(const PG8_LAS bf16x8*)(lds + PG8_SA(b, h) + aoff + m * 2048 + k * 1024); } while (0)
#define PG8_LDB(dst, b, h) do { _Pragma("unroll") for (int n = 0; n < 2; ++n) _Pragma("unroll") for (int k = 0; k < 2; ++k) dst[n][k] = *(const PG8_LAS bf16x8*)(lds + PG8_SB(b, h) + boff + n * 2048 + k * 1024); } while (0)
#define PG8_MMA(ai, bj, At, Bt) do { __builtin_amdgcn_s_setprio(1); _Pragma("unroll") for (int m = 0; m < 4; ++m) _Pragma("unroll") for (int n = 0; n < 2; ++n) _Pragma("unroll") for (int k = 0; k < 2; ++k) \
        acc[ai][bj][m][n] = __builtin_amdgcn_mfma_f32_16x16x32_bf16(Bt[n][k], At[m][k], acc[ai][bj][m][n], 0, 0, 0); __builtin_amdgcn_s_setprio(0); } while (0)
#define PG8_WAIT_V(n) asm volatile("s_waitcnt vmcnt(" #n ")" ::: "memory")
#define PG8_WAIT_L(n) asm volatile("s_waitcnt lgkmcnt(" #n ")" ::: "memory")
#define PG8_BAR __builtin_amdgcn_s_barrier()
#define PG8_SCHED __builtin_amdgcn_sched_barrier(0)
    Unit cur, nxt; int ui = 0;
    if (!S.next(0, cur)) return;
    f32x4 acc[2][2][4][2];
#pragma unroll
    for (int a = 0; a < 2; ++a)
#pragma unroll
        for (int b = 0; b < 2; ++b)
#pragma unroll
            for (int m = 0; m < 4; ++m)
#pragma unroll
                for (int n = 0; n < 2; ++n) acc[a][b][m][n] = (f32x4){0.f, 0.f, 0.f, 0.f};
    bf16x8 At[4][2], B0[2][2], B1[2][2];
    const char* cA = (const char*)g.A + (size_t)cur.pm * tstep; const char* cB = (const char*)g.Bt + (size_t)cur.pn * tstep;
    S.a_ready(cur);
    if constexpr (SP2) {
        PG8_STAGE(PG8_SB(0, 0), cB, voffB); PG8_STAGE(PG8_SB(0, 1), cB + hstep, voffB); PG8_STAGE(PG8_SA(0, 0), cA, voffA); PG8_STAGE(PG8_SA(0, 1), cA + hstep, voffA);
        if (wr == 1) PG8_BAR;
        PG8_WAIT_V(2); PG8_BAR;
        PG8_STAGE(PG8_SB(1, 0), cB + kstep, voffB); PG8_STAGE(PG8_SA(1, 0), cA + kstep, voffA); PG8_STAGE(PG8_SB(1, 1), cB + hstep + kstep, voffB);
        PG8_WAIT_V(6); PG8_BAR;
    } else {
        PG8_STAGE(PG8_SB(0, 0), cB, voffB); PG8_STAGE(PG8_SA(0, 0), cA, voffA); PG8_STAGE(PG8_SB(0, 1), cB + hstep, voffB); PG8_STAGE(PG8_SA(0, 1), cA + hstep, voffA);
        if (wr == 1) PG8_BAR;
        PG8_WAIT_V(4); PG8_BAR;
        PG8_STAGE(PG8_SB(1, 0), cB + kstep, voffB); PG8_STAGE(PG8_SA(1, 0), cA + kstep, voffA); PG8_STAGE(PG8_SB(1, 1), cB + hstep + kstep, voffB);
        PG8_WAIT_V(6); PG8_BAR;
    }
    for (;;) {
        const bool has_next = S.next(ui + 1, nxt);
        const char* nA = has_next ? (const char*)g.A + (size_t)nxt.pm * tstep : cA; const char* nB = has_next ? (const char*)g.Bt + (size_t)nxt.pn * tstep : cB;
        for (int t = 0; t < nt; t += 2) {
            const bool last = (t == nt - 2);
            const char* a1 = cA + (size_t)(t + 1) * kstep;
            const char* a2 = last ? nA : cA + (size_t)(t + 2) * kstep; const char* b2 = last ? nB : cB + (size_t)(t + 2) * kstep;
            const char* a3 = a2 + kstep; const char* b3 = b2 + kstep;
            if (last && has_next) S.a_ready(nxt);
            if constexpr (SP2) {
            PG8_LDB(B0, 0, 0); PG8_LDB(B1, 0, 1); PG8_SCHED; PG8_LDA(At, 0, 0); PG8_STAGE(PG8_SA(1, 1), a1 + hstep, voffA);
            PG8_WAIT_V(8); PG8_WAIT_L(0); PG8_BAR; PG8_MMA(0, 0, At, B0); PG8_MMA(0, 1, At, B1); PG8_BAR; PG8_SCHED;
            PG8_LDA(At, 0, 1); PG8_STAGE(PG8_SB(0, 0), b2, voffB); PG8_STAGE(PG8_SB(0, 1), b2 + hstep, voffB); PG8_STAGE(PG8_SA(0, 0), a2, voffA);
            PG8_WAIT_V(8); PG8_WAIT_L(0); PG8_BAR; PG8_MMA(1, 0, At, B0); PG8_MMA(1, 1, At, B1); PG8_BAR; PG8_SCHED;
            PG8_LDB(B0, 1, 0); PG8_LDB(B1, 1, 1); PG8_SCHED; PG8_LDA(At, 1, 0); PG8_STAGE(PG8_SA(0, 1), a2 + hstep, voffA);
            PG8_WAIT_V(8); PG8_WAIT_L(0); PG8_BAR; PG8_MMA(0, 0, At, B0); PG8_MMA(0, 1, At, B1); PG8_BAR; PG8_SCHED;
            PG8_LDA(At, 1, 1); PG8_STAGE(PG8_SB(1, 0), b3, voffB); PG8_STAGE(PG8_SB(1, 1), b3 + hstep, voffB); PG8_STAGE(PG8_SA(1, 0), a3, voffA);
            PG8_WAIT_V(8); PG8_WAIT_L(0); PG8_BAR; PG8_MMA(1, 0, At, B0); PG8_MMA(1, 1, At, B1); PG8_BAR; PG8_SCHED;
            } else {
            PG8_LDB(B0, 0, 0); PG8_SCHED; PG8_LDA(At, 0, 0); PG8_STAGE(PG8_SA(1, 1), a1 + hstep, voffA);
            PG8_WAIT_L(8); PG8_BAR; PG8_WAIT_L(0); PG8_MMA(0, 0, At, B0); PG8_BAR; PG8_SCHED;
            PG8_LDB(B1, 0, 1); PG8_STAGE(PG8_SB(0, 0), b2, voffB);
            PG8_BAR; PG8_WAIT_L(0); PG8_MMA(0, 1, At, B1); PG8_BAR;
            PG8_LDA(At, 0, 1); PG8_STAGE(PG8_SA(0, 0), a2, voffA);
            PG8_BAR; PG8_WAIT_L(0); PG8_MMA(1, 0, At, B0); PG8_BAR; PG8_SCHED;
            PG8_STAGE(PG8_SB(0, 1), b2 + hstep, voffB);
            PG8_WAIT_V(6); PG8_BAR; PG8_MMA(1, 1, At, B1); PG8_BAR;
            PG8_LDB(B0, 1, 0); PG8_SCHED; PG8_LDA(At, 1, 0); PG8_STAGE(PG8_SA(0, 1), a2 + hstep, voffA);
            PG8_WAIT_L(8); PG8_BAR; PG8_WAIT_L(0); PG8_MMA(0, 0, At, B0); PG8_BAR; PG8_SCHED;
            PG8_LDB(B1, 1, 1); PG8_STAGE(PG8_SB(1, 0), b3, voffB);
            PG8_BAR; PG8_WAIT_L(0); PG8_MMA(0, 1, At, B1); PG8_BAR;
            PG8_LDA(At, 1, 1); PG8_STAGE(PG8_SA(1, 0), a3, voffA);
            PG8_BAR; PG8_WAIT_L(0); PG8_MMA(1, 0, At, B0); PG8_BAR; PG8_SCHED;
            PG8_STAGE(PG8_SB(1, 1), b3 + hstep, voffB);
            PG8_WAIT_V(6); PG8_BAR; PG8_MMA(1, 1, At, B1); PG8_BAR;
            }
        }
        if constexpr (ALIGN_EPI) { if (wr == 0) PG8_BAR; }
        if constexpr (!Epi::AFTER_DRAIN) { E(acc, cur, wr, wc, fr, fq); S.done(cur); }
        if (!has_next) break;
#pragma unroll
        for (int a = 0; a < 2; ++a)
#pragma unroll
            for (int b = 0; b < 2; ++b)
#pragma unroll
                for (int m = 0; m < 4; ++m)
#pragma unroll
                    for (int n = 0; n < 2; ++n) acc[a][b][m][n] = (f32x4){0.f, 0.f, 0.f, 0.f};
        cur = nxt; cA = nA; cB = nB; ++ui;
        if constexpr (ALIGN_EPI) { if (wr == 1) PG8_BAR; }
    }
    PG8_WAIT_V(0);
    if constexpr (!ALIGN_EPI) { if (wr == 0) PG8_BAR; }
    PG8_BAR;
    if constexpr (Epi::AFTER_DRAIN) { E.fused(acc, cur, wr, wc, fr, fq, lds, wid, lane); S.done(cur); }
#undef PG8_SA
#undef PG8_SB
#undef PG8_STAGE
#undef PG8_LDA
#undef PG8_LDB
#undef PG8_MMA
#undef PG8_WAIT_V
#undef PG8_WAIT_L
#undef PG8_BAR
#undef PG8_SCHED
}
}
#define GAS __attribute__((address_space(1)))
#define LAS __attribute__((address_space(3)))
typedef unsigned short bf16;
typedef unsigned v4u __attribute__((ext_vector_type(4)));
typedef float f32x4 __attribute__((ext_vector_type(4)));
typedef short bf16x8 __attribute__((ext_vector_type(8)));
typedef GAS unsigned gu32;
typedef GAS unsigned long long gu64;
#define RLX_AGENT __ATOMIC_RELAXED, __HIP_MEMORY_SCOPE_AGENT
#define LDS_WAIT() asm volatile("s_waitcnt lgkmcnt(0)" ::: "memory")
#define VM_WAIT() asm volatile("s_waitcnt vmcnt(0)" ::: "memory")
__device__ __forceinline__ unsigned long long rt() { return __builtin_amdgcn_s_memrealtime(); }
__device__ __forceinline__ unsigned f2bf(float f) { unsigned u = __builtin_bit_cast(unsigned, f); return (u + 0x7fffu + ((u >> 16) & 1u)) >> 16; }
__device__ __forceinline__ unsigned pk2(float lo, float hi) { return f2bf(lo) | (f2bf(hi) << 16); }
#define XB_TMO      128
#define XB_XCNT(j)  (256  + 64 * (j))
#define XB_XSUB(j)  (1280 + 64 * (j))
#define XB_XGEN(j)  (2304 + 64 * (j))
#define XB_TOP      3328
#define XB_TOPGEN   3392
#define XCD_BAR_WORDS 3456
#define XB_SPIN_CAP (1u << 18)

__device__ __forceinline__ unsigned xb_ld(unsigned* p)              { return __hip_atomic_load(p, __ATOMIC_RELAXED, __HIP_MEMORY_SCOPE_AGENT); }
__device__ __forceinline__ unsigned xb_add(unsigned* p, unsigned v) { return __hip_atomic_fetch_add(p, v, __ATOMIC_RELAXED, __HIP_MEMORY_SCOPE_AGENT); }
__device__ __forceinline__ unsigned xb_xcc_id() { return (unsigned)__builtin_amdgcn_s_getreg((3 << 11) | 20) & 0xFu; }
#define XB_SPIN(cond, bar) do { unsigned _sp = 0; while (cond) { __builtin_amdgcn_s_sleep(1); \
    if ((++_sp & 255u) == 0u) { if (xb_ld(&(bar)[XB_TMO])) break; if (_sp > XB_SPIN_CAP) { atomicAdd(&(bar)[XB_TMO], 1u); break; } } } } while (0)

struct XcdBarrier {
    unsigned* bar; unsigned x;
    volatile LAS unsigned* st;
};

__device__ __forceinline__ XcdBarrier xcd_barrier_post(unsigned* bar, volatile LAS unsigned* st) {
    XcdBarrier b; b.bar = bar; b.x = xb_xcc_id(); b.st = st;
    if (threadIdx.x == 0) (void)xb_add(&bar[XB_XCNT(b.x)], 1u);
    return b;
}
__device__ __forceinline__ void xcd_barrier_complete(unsigned* bar, unsigned x, unsigned& nloc, unsigned& nx) {
    const unsigned G = gridDim.x * gridDim.y * gridDim.z;
    unsigned sum, cnt, mine, sp = 0u;
    for (;;) {
        sum = 0u; cnt = 0u; mine = 0u;
#pragma unroll
        for (unsigned j = 0; j < 16; ++j) { const unsigned c = xb_ld(&bar[XB_XCNT(j)]); sum += c; cnt += (c > 0u) ? 1u : 0u; mine = (j == x) ? c : mine; }
        if (sum == G) break;
        __builtin_amdgcn_s_sleep(1);
        if ((++sp & 255u) == 0u) { if (xb_ld(&bar[XB_TMO])) break; if (sp > XB_SPIN_CAP) { atomicAdd(&bar[XB_TMO], 1u); break; } }
    }
    nloc = mine > 0u ? mine : 1u; nx = cnt > 0u ? cnt : 1u;
}

__device__ __forceinline__ void xcd_barrier(const XcdBarrier& b, int tid) {
    asm volatile("s_waitcnt vmcnt(0)" ::: "memory");
    __syncthreads();
    if (tid == 0) {
        unsigned* bar = b.bar; asm volatile("" : "+s"(bar));
        __builtin_amdgcn_s_waitcnt(0);
        unsigned bx_ = b.x; asm volatile("" : "+s"(bx_));
        unsigned nloc = b.st[0], nx = b.st[1];
        if (nloc == 0u) { xcd_barrier_complete(bar, bx_, nloc, nx); b.st[0] = nloc; b.st[1] = nx; }
        const unsigned old = xb_add(&bar[XB_XSUB(bx_)], 1u);
        const unsigned gen = old / nloc;
        if (old + 1u == (gen + 1u) * nloc) {
            __builtin_amdgcn_fence(__ATOMIC_RELEASE, "agent");
            asm volatile("s_waitcnt vmcnt(0)" ::: "memory");
            const unsigned og = xb_add(&bar[XB_TOP], 1u);
            const unsigned tg = og / nx;
            if (og + 1u == (tg + 1u) * nx) xb_add(&bar[XB_TOPGEN], 1u);
            else XB_SPIN(xb_ld(&bar[XB_TOPGEN]) == tg, bar);
            __builtin_amdgcn_fence(__ATOMIC_ACQUIRE, "agent");
            xb_add(&bar[XB_XGEN(bx_)], 1u);
            asm volatile("s_waitcnt vmcnt(0)" ::: "memory");
        } else {
            XB_SPIN(xb_ld(&bar[XB_XGEN(bx_)]) == gen, bar);
            __builtin_amdgcn_fence(__ATOMIC_ACQUIRE, "agent");
            asm volatile("s_waitcnt vmcnt(0)" ::: "memory");
        }
    }
    __syncthreads();
}
constexpr int NWAVES = 8;
constexpr int DM = 1024, NBATCH = 4, SEQ = 4096, DEPTH = 4, DBATCH = 32, DSEQ = 4, PAST = 8192;
constexpr int MP = NBATCH * SEQ, MS = DBATCH * DSEQ;
constexpr int DIN = 3584, DFF = 2816, DUP = 2 * DFF, WCTX = 2048;
constexpr int C_QR = 0, C_KR = 512, C_VR = 1024, C_GR = 1536, C_QA = 2048, C_KA = 2560, C_VA = 3072;
constexpr float EPS = 1e-6f;
constexpr int NPOS = SEQ + DSEQ;

__host__ __device__ __forceinline__ int in_feature(int nrow) {
    const int pn = nrow >> 8, tc = nrow & 255, bj = tc >> 7, j = tc & 127;
    if (pn < 4) return (pn >> 1) * 512 + (2 * (pn & 1) + (j >> 6)) * 128 + (j & 63) + 64 * bj;
    if (pn >= 8 && pn < 12) return 2048 + ((pn - 8) >> 1) * 512 + (4 * (pn & 1) + (j >> 5)) * 64 + (j & 31) + 32 * bj;
    return nrow;
}

__host__ __device__ __forceinline__ int up_feature(int nrow) { const int pn = nrow >> 8, tc = nrow & 255; return tc < 128 ? 128 * pn + tc : 2816 + 128 * pn + (tc - 128); }

constexpr size_t MiB = 1u << 20;
constexpr size_t WS_CTL = 0, CTL_ZERO_BYTES = 1 * MiB;
constexpr size_t WS_T64 = 1 * MiB;
constexpr size_t WS_T32 = 4 * MiB;
constexpr size_t WS_SS1 = 356 * MiB, WS_SS2 = 358 * MiB;
constexpr size_t WS_WIN = 6 * MiB;
constexpr size_t WS_WOUT = 34 * MiB;
constexpr size_t WS_WUP = 42 * MiB;
constexpr size_t WS_WDN = 86 * MiB;
constexpr size_t WS_XRES = 108 * MiB;
constexpr size_t WS_HB = 172 * MiB;
constexpr size_t WS_ZB = 204 * MiB;
constexpr size_t WS_CATB = 316 * MiB;
constexpr size_t WS_UB = 348 * MiB;
constexpr size_t WS_AB = 524 * MiB;
constexpr size_t WS_OG = 612 * MiB;
constexpr size_t WS_LSE = 660 * MiB;
constexpr size_t WS_UPD = 662 * MiB;
constexpr size_t WS_ST = 694 * MiB;
constexpr size_t WS_SMP = 710 * MiB;
constexpr size_t WS_OPT_END = 718 * MiB;
constexpr size_t WS_NAIVE = 720 * MiB;
constexpr size_t SM_X = 0;
constexpr size_t SM_HB = 512 * 1024;
constexpr size_t SM_ZB = 768 * 1024;
constexpr size_t SM_CATB = 1792 * 1024;
constexpr size_t SM_U = 2048 * 1024;
constexpr size_t SM_AB = 5120 * 1024;
constexpr size_t SM_SS = 6144 * 1024;
constexpr int CW_TMO = 0, CW_CODE = 1, CW_BAR = 4096;

constexpr int RING_OFF = 0, RING_BYTES = 131072;
constexpr int LDSCTL_OFF = RING_BYTES, MISC_OFF = LDSCTL_OFF + 320;
constexpr int EXB_OFF = 132096;
constexpr int LDS_BYTES = 147456;
static_assert(MISC_OFF + 128 <= EXB_OFF && EXB_OFF + 8192 + 4096 <= LDS_BYTES, "LDS map");
struct Frame {
    LAS unsigned char* lds;
    volatile LAS unsigned* MISC;
    gu32* ctl;
    int tid, lane, wave;
    int vcu, G;
    unsigned char* ws;
};
struct Args { const float* in[16]; float* out; unsigned char* ws; int layer, pad; };

__device__ __forceinline__ float wave_sum(float v) {
#pragma unroll
    for (int o = 1; o < 64; o <<= 1) v += __shfl_xor(v, o);
    return v;
}
__device__ __forceinline__ float silu_f(float x) { return x / (1.f + __expf(-x)); }

struct P0Item { const float* src; bf16* dst; const float* ksc; int K, N; };
__device__ __forceinline__ void p0_item_load(const P0Item& I, f32x4 (&v)[8], int lane) {
#pragma unroll
    for (int i = 0; i < 8; ++i) v[i] = *(const GAS f32x4*)(I.src + (size_t)((lane >> 3) + 8 * i) * I.N + 4 * (lane & 7));
}
__device__ __forceinline__ void p0_item_store(const P0Item& I, const f32x4 (&v)[8], LAS float* scr, int lane) {
#pragma unroll
    for (int i = 0; i < 8; ++i) { const int kk = (lane >> 3) + 8 * i; const float sc = I.ksc ? I.ksc[kk] : 1.f; LAS float* d = scr + kk * 33 + 4 * (lane & 7);
        d[0] = v[i][0] * sc; d[1] = v[i][1] * sc; d[2] = v[i][2] * sc; d[3] = v[i][3] * sc; }
    LDS_WAIT(); asm volatile("" ::: "memory");
    const int c = lane & 7;
#pragma unroll
    for (int j = 0; j < 4; ++j) { const int n = (lane >> 3) + 8 * j; const LAS float* s = scr + (8 * c) * 33 + n;
        v4u o; o.x = pk2(s[0 * 33], s[1 * 33]); o.y = pk2(s[2 * 33], s[3 * 33]); o.z = pk2(s[4 * 33], s[5 * 33]); o.w = pk2(s[6 * 33], s[7 * 33]);
        *(GAS v4u*)(I.dst + (size_t)n * I.K + 8 * c) = o; }
    LDS_WAIT(); asm volatile("" ::: "memory");
}
constexpr int P0_I_IN = (DM / 64) * (DIN / 32), P0_I_OUT = (DM / 64) * (DM / 32), P0_I_UP = (DM / 64) * (DUP / 32), P0_I_DN = (DFF / 64) * (DM / 32), P0_I_L = P0_I_IN + P0_I_OUT + P0_I_UP + P0_I_DN;
__device__ __forceinline__ void p0_convert(Frame& F, const float* w_in, const float* w_out, const float* w_up, const float* w_dn, const float* n1w, const float* n2w, int it0, int it1, int gw, int NGW) {
    LAS float* scr = (LAS float*)(F.lds + RING_OFF + F.wave * 16384);
    constexpr int I_IN = P0_I_IN, I_OUT = P0_I_OUT, I_UP = P0_I_UP, I_L = P0_I_L;
    bf16* WIN = (bf16*)(F.ws + WS_WIN); bf16* WOUT = (bf16*)(F.ws + WS_WOUT); bf16* WUP = (bf16*)(F.ws + WS_WUP); bf16* WDN = (bf16*)(F.ws + WS_WDN);
    auto resolve = [&](int it) -> P0Item {
        const int l = it / I_L; int r = it % I_L; P0Item I;
        if (r < I_IN) { const int nblk = DIN / 32, kb = r / nblk, nb = r % nblk; I.K = DM; I.N = DIN; I.src = w_in + (size_t)l * DM * DIN + (size_t)(64 * kb) * DIN + in_feature(32 * nb); I.dst = WIN + (size_t)l * DIN * DM + (size_t)(32 * nb) * DM + 64 * kb; I.ksc = n1w + (size_t)l * DM + 64 * kb; return I; } r -= I_IN;
        if (r < I_OUT) { const int nblk = DM / 32, kb = r / nblk, nb = r % nblk; I.K = DM; I.N = DM; I.src = w_out + (size_t)l * DM * DM + (size_t)(64 * kb) * DM + 32 * nb; I.dst = WOUT + (size_t)l * DM * DM + (size_t)(32 * nb) * DM + 64 * kb; I.ksc = nullptr; return I; } r -= I_OUT;
        if (r < I_UP) { const int nblk = DUP / 32, kb = r / nblk, nb = r % nblk; I.K = DM; I.N = DUP; I.src = w_up + (size_t)l * DM * DUP + (size_t)(64 * kb) * DUP + up_feature(32 * nb); I.dst = WUP + (size_t)l * DUP * DM + (size_t)(32 * nb) * DM + 64 * kb; I.ksc = n2w + (size_t)l * DM + 64 * kb; return I; } r -= I_UP;
        { const int nblk = DM / 32, kb = r / nblk, nb = r % nblk; I.K = DFF; I.N = DM; I.src = w_dn + (size_t)l * DFF * DM + (size_t)(64 * kb) * DM + 32 * nb; I.dst = WDN + (size_t)l * DM * DFF + (size_t)(32 * nb) * DFF + 64 * kb; I.ksc = nullptr; return I; }
    };
    if (it0 + gw < it1) {
        P0Item cur = resolve(it0 + gw); f32x4 v[8]; p0_item_load(cur, v, F.lane);
#pragma unroll 1
        for (int it = it0 + gw; it < it1; it += NGW) {
            const bool more = it + NGW < it1; P0Item nxt = cur; f32x4 vn[8];
            if (more) { nxt = resolve(it + NGW); p0_item_load(nxt, vn, F.lane); }
            p0_item_store(cur, v, scr, F.lane);
            if (more) { cur = nxt;
#pragma unroll
                for (int i = 0; i < 8; ++i) v[i] = vn[i]; }
        }
    }
}
__device__ __forceinline__ void p0_prologue(Frame& F, const float* w_in, const float* w_out, const float* w_up, const float* w_dn, const float* n1w, const float* n2w, const float* xp) {
    const int gw = F.vcu * NWAVES + F.wave, NGW = F.G * NWAVES;
    p0_convert(F, w_in, w_out, w_up, w_dn, n1w, n2w, 0, DEPTH * P0_I_L, gw, NGW);
    { bf16* XB = (bf16*)(F.ws + WS_HB); float* SS1 = (float*)(F.ws + WS_SS1);
      for (int m = gw; m < MP; m += NGW) { const GAS f32x4* xr = (const GAS f32x4*)(xp + (size_t)m * DM) + F.lane; GAS unsigned long long* o8 = (GAS unsigned long long*)(XB + (size_t)m * DM) + F.lane; float s = 0.f;
#pragma unroll
          for (int j = 0; j < 4; ++j) { const f32x4 v = xr[64 * j]; s += (v.x * v.x + v.y * v.y) + (v.z * v.z + v.w * v.w); o8[64 * j] = (unsigned long long)pk2(v.x, v.y) | ((unsigned long long)pk2(v.z, v.w) << 32); }
          s = wave_sum(s); if (F.lane < 16) SS1[(size_t)m * 16 + F.lane] = (F.lane == 0) ? s : 0.f; } }
    float* T64 = (float*)(F.ws + WS_T64); float* T32 = (float*)(F.ws + WS_T32);
    const int gt = (F.vcu * NWAVES + F.wave) * 64 + F.lane, NT = F.G * NWAVES * 64;
    for (int i = gt; i < NPOS * 96; i += NT) {
        const int p = i / 96, k = i % 96; const float pos = (float)(p < SEQ ? p : PAST + (p - SEQ));
        float inv; float* dst;
        if (k < 64) { inv = powf(10000.f, -(float)k / 64.f); dst = T64 + ((size_t)p * 64 + k) * 2; }
        else { inv = powf(10000.f, -(float)(k - 64) / 32.f); dst = T32 + ((size_t)p * 32 + (k - 64)) * 2; }
        float sn, cs; sincosf(pos * inv, &sn, &cs); dst[0] = cs; dst[1] = sn;
    }
}
__device__ __forceinline__ void rms_row_to_bf16(const float* xrow, const float* w, bf16* orow, int lane) {
    const GAS f32x4* xr = (const GAS f32x4*)xrow + lane; const GAS f32x4* wr = (const GAS f32x4*)w + lane;
    f32x4 v[4]; float s = 0.f;
#pragma unroll
    for (int j = 0; j < 4; ++j) { v[j] = xr[64 * j]; s += (v[j].x * v[j].x + v[j].y * v[j].y) + (v[j].z * v[j].z + v[j].w * v[j].w); }
    const float rstd = 1.f / sqrtf(wave_sum(s) * (1.f / DM) + EPS);
    GAS unsigned long long* o8 = (GAS unsigned long long*)orow + lane;
#pragma unroll
    for (int j = 0; j < 4; ++j) { const f32x4 ww = wr[64 * j];
        o8[64 * j] = (unsigned long long)pk2(v[j].x * rstd * ww.x, v[j].y * rstd * ww.y) | ((unsigned long long)pk2(v[j].z * rstd * ww.z, v[j].w * rstd * ww.w) << 32); }
}
__device__ __forceinline__ void rms_row_to_f32(const float* xrow, const float* w, float* orow, int lane) {
    const GAS f32x4* xr = (const GAS f32x4*)xrow + lane; const GAS f32x4* wr = (const GAS f32x4*)w + lane;
    f32x4 v[4]; float s = 0.f;
#pragma unroll
    for (int j = 0; j < 4; ++j) { v[j] = xr[64 * j]; s += (v[j].x * v[j].x + v[j].y * v[j].y) + (v[j].z * v[j].z + v[j].w * v[j].w); }
    const float rstd = 1.f / sqrtf(wave_sum(s) * (1.f / DM) + EPS);
    GAS f32x4* o = (GAS f32x4*)orow + lane;
#pragma unroll
    for (int j = 0; j < 4; ++j) { const f32x4 ww = wr[64 * j]; o[64 * j] = (v[j] * rstd) * ww; }
}
__device__ __forceinline__ void norm_phase(Frame& F, const float* xp, const float* xs, const float* w) {
    const int gw = F.vcu * NWAVES + F.wave, NGW = F.G * NWAVES;
    bf16* HB = (bf16*)(F.ws + WS_HB); bf16* HS = (bf16*)(F.ws + WS_SMP + SM_HB);
    for (int m = gw; m < MP; m += NGW) rms_row_to_bf16(xp + (size_t)m * DM, w, HB + (size_t)m * DM, F.lane);
    for (int m = NGW - 1 - gw; m < MS; m += NGW) rms_row_to_bf16(xs + (size_t)m * DM, w, HS + (size_t)m * DM, F.lane);
}
__device__ __forceinline__ void rms_rowb_to_f32(const bf16* xrow, const float* w, float* orow, int lane) {
    const GAS unsigned long long* xr = (const GAS unsigned long long*)xrow + lane; const GAS f32x4* wr = (const GAS f32x4*)w + lane;
    f32x4 v[4]; float s = 0.f;
#pragma unroll
    for (int j = 0; j < 4; ++j) { const unsigned long long q = xr[64 * j]; v[j].x = __uint_as_float((unsigned)q << 16); v[j].y = __uint_as_float((unsigned)q & 0xffff0000u); v[j].z = __uint_as_float((unsigned)(q >> 32) << 16); v[j].w = __uint_as_float((unsigned)(q >> 32) & 0xffff0000u);
        s += (v[j].x * v[j].x + v[j].y * v[j].y) + (v[j].z * v[j].z + v[j].w * v[j].w); }
    const float rstd = 1.f / sqrtf(wave_sum(s) * (1.f / DM) + EPS);
    GAS f32x4* o = (GAS f32x4*)orow + lane;
#pragma unroll
    for (int j = 0; j < 4; ++j) { const f32x4 ww = wr[64 * j]; o[64 * j] = (v[j] * rstd) * ww; }
}
__device__ __forceinline__ void final_norm_phase(Frame& F, const bf16* xpb, const float* xs, const float* w, float* yp, float* ys) {
    const int gw = F.vcu * NWAVES + F.wave, NGW = F.G * NWAVES;
    for (int m = gw; m < MP; m += NGW) rms_rowb_to_f32(xpb + (size_t)m * DM, w, yp + (size_t)m * DM, F.lane);
    for (int m = NGW - 1 - gw; m < MS; m += NGW) rms_row_to_f32(xs + (size_t)m * DM, w, ys + (size_t)m * DM, F.lane);
}
__device__ __forceinline__ void conv_phase_prompt(Frame& F, const float* cw, const float* cb) {
    const bf16* UB = (const bf16*)(F.ws + WS_UB); bf16* AB = (bf16*)(F.ws + WS_AB);
    const int gt = (F.vcu * NWAVES + F.wave) * 64 + F.lane, NT = F.G * NWAVES * 64;
    constexpr int NCH = DFF / 8, NITEM = (MP / 16) * NCH;
    for (int it = gt; it < NITEM; it += NT) {
        const int rb = it / NCH, c8 = it % NCH, r0 = rb * 16, c0 = c8 * 8;
        float wg[3][8], wv[3][8], bg[8], bv[8];
#pragma unroll
        for (int j = 0; j < 3; ++j)
#pragma unroll
            for (int q = 0; q < 2; ++q) { const f32x4 a = *(const GAS f32x4*)(cw + (size_t)j * DUP + c0 + 4 * q), b = *(const GAS f32x4*)(cw + (size_t)j * DUP + DFF + c0 + 4 * q);
#pragma unroll
                for (int e = 0; e < 4; ++e) { wg[j][4 * q + e] = a[e]; wv[j][4 * q + e] = b[e]; } }
#pragma unroll
        for (int q = 0; q < 2; ++q) { const f32x4 a = *(const GAS f32x4*)(cb + c0 + 4 * q), b = *(const GAS f32x4*)(cb + DFF + c0 + 4 * q);
#pragma unroll
            for (int e = 0; e < 4; ++e) { bg[4 * q + e] = a[e]; bv[4 * q + e] = b[e]; } }
        float g2[8], g1[8], v2[8], v1[8];
        const bool has_prev = (r0 & 4095) != 0;
        {
            v4u a2 = {0u, 0u, 0u, 0u}, a1 = a2, b2 = a2, b1 = a2;
            if (has_prev) { a2 = *(const GAS v4u*)(UB + (size_t)(r0 - 2) * DUP + c0); a1 = *(const GAS v4u*)(UB + (size_t)(r0 - 1) * DUP + c0);
                            b2 = *(const GAS v4u*)(UB + (size_t)(r0 - 2) * DUP + DFF + c0); b1 = *(const GAS v4u*)(UB + (size_t)(r0 - 1) * DUP + DFF + c0); }
#pragma unroll
            for (int e = 0; e < 4; ++e) { g2[2 * e] = __uint_as_float(a2[e] << 16); g2[2 * e + 1] = __uint_as_float(a2[e] & 0xffff0000u); g1[2 * e] = __uint_as_float(a1[e] << 16); g1[2 * e + 1] = __uint_as_float(a1[e] & 0xffff0000u);
                                          v2[2 * e] = __uint_as_float(b2[e] << 16); v2[2 * e + 1] = __uint_as_float(b2[e] & 0xffff0000u); v1[2 * e] = __uint_as_float(b1[e] << 16); v1[2 * e + 1] = __uint_as_float(b1[e] & 0xffff0000u); }
        }
#pragma unroll 4
        for (int i = 0; i < 16; ++i) {
            const v4u a0 = *(const GAS v4u*)(UB + (size_t)(r0 + i) * DUP + c0), b0 = *(const GAS v4u*)(UB + (size_t)(r0 + i) * DUP + DFF + c0);
            float g0[8], v0[8], o[8];
#pragma unroll
            for (int e = 0; e < 4; ++e) { g0[2 * e] = __uint_as_float(a0[e] << 16); g0[2 * e + 1] = __uint_as_float(a0[e] & 0xffff0000u); v0[2 * e] = __uint_as_float(b0[e] << 16); v0[2 * e + 1] = __uint_as_float(b0[e] & 0xffff0000u); }
#pragma unroll
            for (int e = 0; e < 8; ++e) { const float gg = bg[e] + wg[0][e] * g2[e] + wg[1][e] * g1[e] + wg[2][e] * g0[e]; const float vv = bv[e] + wv[0][e] * v2[e] + wv[1][e] * v1[e] + wv[2][e] * v0[e];
                o[e] = silu_f(gg) * vv; g2[e] = g1[e]; g1[e] = g0[e]; v2[e] = v1[e]; v1[e] = v0[e]; }
            v4u w; w.x = pk2(o[0], o[1]); w.y = pk2(o[2], o[3]); w.z = pk2(o[4], o[5]); w.w = pk2(o[6], o[7]);
            *(GAS v4u*)(AB + (size_t)(r0 + i) * DFF + c0) = w;
        }
    }
}

__device__ __forceinline__ void conv_fixup_phase(Frame& F, const float* cw, const float* cb) {
    const float* UB = (const float*)(F.ws + WS_UB); bf16* AB = (bf16*)(F.ws + WS_AB);
    const int gt = (F.vcu * NWAVES + F.wave) * 64 + F.lane, NT = F.G * NWAVES * 64;
    for (int it = gt; it < 64 * 2 * DFF; it += NT) { const int c = it % DFF, tr = it / DFF, pm = tr >> 1, r = tr & 1;
        if ((pm & 15) == 0) continue;
        float o[2];
#pragma unroll
        for (int hh = 0; hh < 2; ++hh) { const int cc = c + hh * DFF;
            const float um2 = UB[((size_t)(pm - 1) * 4 + 2) * DUP + cc], um1 = UB[((size_t)(pm - 1) * 4 + 3) * DUP + cc], u0 = UB[((size_t)pm * 4 + 0) * DUP + cc], u1 = UB[((size_t)pm * 4 + 1) * DUP + cc];
            const float a = r ? um1 : um2, b = r ? u0 : um1, d = r ? u1 : u0;
            o[hh] = cb[cc] + cw[cc] * a + cw[DUP + cc] * b + cw[2 * DUP + cc] * d; }
        AB[(size_t)(pm * 256 + r) * DFF + c] = (bf16)f2bf(silu_f(o[0]) * o[1]); }
}

__device__ __forceinline__ void zero_rows_f32(Frame& F, float* p) { const int gt = (F.vcu * NWAVES + F.wave) * 64 + F.lane; if (gt < MP) p[gt] = 0.f; }
typedef float f32x16 __attribute__((ext_vector_type(16)));
typedef short s16x4 __attribute__((ext_vector_type(4)));
typedef float f32x2_t __attribute__((ext_vector_type(2))); typedef __bf16 bf16x2_t __attribute__((ext_vector_type(2)));
__device__ __forceinline__ unsigned cvtpk(float lo, float hi) { f32x2_t v = {lo, hi}; bf16x2_t b = __builtin_convertvector(v, bf16x2_t); return __builtin_bit_cast(unsigned, b); }
__device__ __forceinline__ int crow(int r, int hi) { return (r & 3) + 8 * (r >> 2) + 4 * hi; }
__device__ __forceinline__ s16x4 ds_tr(const LAS unsigned char* p) { return __builtin_bit_cast(s16x4, __builtin_amdgcn_ds_read_tr16_b64_v4i16((LAS s16x4*)p)); }
__device__ __forceinline__ bf16x8 mk8(s16x4 lo, s16x4 hi) { return (bf16x8){lo[0], lo[1], lo[2], lo[3], hi[0], hi[1], hi[2], hi[3]}; }
__device__ __forceinline__ bf16x8 pack_step(const f32x16& x, int s) {
    v4u p; p.x = cvtpk(x[8 * s], x[8 * s + 1]); p.y = cvtpk(x[8 * s + 2], x[8 * s + 3]); p.z = cvtpk(x[8 * s + 4], x[8 * s + 5]); p.w = cvtpk(x[8 * s + 6], x[8 * s + 7]);
    return __builtin_bit_cast(bf16x8, p);
}
#define MFMA32(a, b, c) __builtin_amdgcn_mfma_f32_32x32x16_bf16((a), (b), (c), 0, 0, 0)
__device__ __forceinline__ float log2_gamma(int h) { return log2f(1.f - exp2f(-5.f - (float)h)); }

constexpr int AT_V0 = 49152, AT_V1 = 49152 + 24576 + 128;
struct AttnIds { int g, b, h, r, np; };
__device__ __forceinline__ AttnIds attn_ids(int uid) { AttnIds a; a.g = uid >> 9; const int rem = uid & 511, bh = rem >> 4, rn = rem & 15, npc = 16 >> (2 * a.g); a.b = bh >> 3; a.h = bh & 7; a.r = rn / npc; a.np = rn % npc; return a; }
__device__ __forceinline__ void attn_fetch(Frame& F, const AttnIds& a, v4u (&kreg)[6], v4u (&vreg)[6]) {
    const bf16* ZB = (const bf16*)(F.ws + WS_ZB); const int dsh = 2 * a.g; const size_t brow = (size_t)a.b * SEQ;
#pragma unroll
    for (int i = 0; i < 6; ++i) { const int c = F.tid + 512 * i, key = c >> 3, ch = c & 7; int uk = 256 * a.np - 128 + key; uk = uk < 0 ? 0 : uk;
        const bf16* src = ZB + (brow + a.r + ((size_t)uk << dsh)) * DIN + a.h * 64 + ch * 8;
        kreg[i] = *(const GAS v4u*)(src + C_KA); vreg[i] = *(const GAS v4u*)(src + C_VA); }
}
__device__ __forceinline__ void attn_stage(Frame& F, const v4u (&kreg)[6], const v4u (&vreg)[6]) {
#pragma unroll
    for (int i = 0; i < 6; ++i) { const int c = F.tid + 512 * i, key = c >> 3, ch = c & 7;
        *(LAS v4u*)(F.lds + key * 128 + ((ch ^ ((key >> 1) & 7)) << 4)) = kreg[i];
        *(LAS v4u*)(F.lds + ((ch >> 2) ? AT_V1 : AT_V0) + key * 64 + ((ch & 3) << 4)) = vreg[i]; }
}
__device__ __forceinline__ void attn_compute(Frame& F, const AttnIds& a, const bf16x8 (&qf)[4]) {
    const int g = a.g, b = a.b, h = a.h, r = a.r, np = a.np;
    const int dsh = 2 * g;
    bf16* OG = (bf16*)(F.ws + WS_OG) + (size_t)g * MP * 512; float* LSE = (float*)(F.ws + WS_LSE) + (size_t)g * MP * 8;
    const int lane = F.lane, w = F.wave, r32 = lane & 31, hi = lane >> 5;
    LAS unsigned char* Kl = F.lds;
    const size_t brow = (size_t)b * SEQ;
    const size_t qrow = brow + r + ((size_t)(256 * np + 32 * w + r32) << dsh);
    f32x16 p[5];
#pragma unroll
    for (int kb = 0; kb < 5; ++kb) {
        f32x16 a = {};
        const int key = 32 * w + 32 * kb + r32;
#pragma unroll
        for (int d0 = 0; d0 < 4; ++d0) { const bf16x8 kf = *(const LAS bf16x8*)(Kl + key * 128 + (((2 * d0 + hi) ^ ((key >> 1) & 7)) << 4)); a = MFMA32(kf, qf[d0], a); }
        p[kb] = a;
    }
    float mx = -INFINITY;
#pragma unroll
    for (int kb = 0; kb < 5; ++kb) { const bool blk_dead = (np == 0) && (kb < 4 - w);
#pragma unroll
        for (int rg = 0; rg < 16; ++rg) { const int c = crow(rg, hi); bool ok = !blk_dead; if (kb == 0) ok = ok && (c >= r32); if (kb == 4) ok = ok && (c <= r32);
            const float v = ok ? p[kb][rg] : -INFINITY; p[kb][rg] = v; mx = fmaxf(mx, v); } }
    mx = fmaxf(mx, __shfl_xor(mx, 32));
    float l = 0.f;
#pragma unroll
    for (int kb = 0; kb < 5; ++kb)
#pragma unroll
        for (int rg = 0; rg < 16; ++rg) { const float e = __builtin_amdgcn_exp2f(p[kb][rg] - mx); p[kb][rg] = e; l += e; }
    l += __shfl_xor(l, 32);
    f32x16 o[2]; o[0] = (f32x16){}; o[1] = (f32x16){};
    const int gidx = lane >> 4, ql = (lane & 15) >> 2, pl = lane & 3;
    const int voff = (4 * hi + ql) * 64 + (16 * (gidx & 1) + 4 * pl) * 2;
#pragma unroll
    for (int kb = 0; kb < 5; ++kb)
#pragma unroll
        for (int s = 0; s < 2; ++s) { const bf16x8 pf = pack_step(p[kb], s);
#pragma unroll
            for (int dh = 0; dh < 2; ++dh) { const LAS unsigned char* vb = F.lds + (dh ? AT_V1 : AT_V0) + (32 * w + 32 * kb + 16 * s) * 64 + voff;
                const bf16x8 vf = mk8(ds_tr(vb), ds_tr(vb + 8 * 64)); o[dh] = MFMA32(vf, pf, o[dh]); } }
    const float inv = 1.f / l;
    bf16* orow = OG + qrow * 512 + h * 64;
#pragma unroll
    for (int dh = 0; dh < 2; ++dh)
#pragma unroll
        for (int t = 0; t < 4; ++t) { const int d = 32 * dh + 8 * t + 4 * hi;
            const unsigned lo = cvtpk(o[dh][4 * t] * inv, o[dh][4 * t + 1] * inv), hi2 = cvtpk(o[dh][4 * t + 2] * inv, o[dh][4 * t + 3] * inv);
            *(GAS unsigned long long*)(orow + d) = (unsigned long long)lo | ((unsigned long long)hi2 << 32); }
    if (hi == 0) LSE[qrow * 8 + h] = mx + log2f(l);
}
__device__ __forceinline__ void attn_qfetch(Frame& F, const AttnIds& a, bf16x8 (&qf)[4]) {
    const bf16* ZB = (const bf16*)(F.ws + WS_ZB); const int r32 = F.lane & 31, hi = F.lane >> 5;
    const size_t qrow = (size_t)a.b * SEQ + a.r + ((size_t)(256 * a.np + 32 * F.wave + r32) << (2 * a.g));
#pragma unroll
    for (int d0 = 0; d0 < 4; ++d0) qf[d0] = *(const GAS bf16x8*)(ZB + qrow * DIN + C_QA + a.h * 64 + d0 * 16 + hi * 8);
}
__device__ __forceinline__ void attn_prompt_units(Frame& F) {
    const int per = (1536 + F.G - 1) / F.G, u0 = F.vcu * per, u1 = (u0 + per < 1536) ? u0 + per : 1536;
    if (u0 >= u1) return;
    v4u kreg[6], vreg[6]; bf16x8 qn[4];
    attn_fetch(F, attn_ids(u0), kreg, vreg); attn_qfetch(F, attn_ids(u0), qn);
#pragma unroll 1
    for (int uid = u0; uid < u1; ++uid) {
        const AttnIds a = attn_ids(uid);
        bf16x8 qf[4];
#pragma unroll
        for (int d0 = 0; d0 < 4; ++d0) qf[d0] = qn[d0];
        attn_stage(F, kreg, vreg);
        __syncthreads();
        if (uid + 1 < u1) { attn_fetch(F, attn_ids(uid + 1), kreg, vreg); attn_qfetch(F, attn_ids(uid + 1), qn); }
        attn_compute(F, a, qf);
        __syncthreads();
    }
}
__device__ __forceinline__ void combine_prompt(Frame& F) {
    const bf16* OG = (const bf16*)(F.ws + WS_OG); const float* LSE = (const float*)(F.ws + WS_LSE); bf16* CATB = (bf16*)(F.ws + WS_CATB);
    const int gt = (F.vcu * NWAVES + F.wave) * 64 + F.lane, NT = F.G * NWAVES * 64;
    for (int it0 = gt; it0 < MP * 64; it0 += 4 * NT) {
        float l0[4], l1[4], l2[4]; v4u a[4], b[4], c[4];
#pragma unroll
        for (int q = 0; q < 4; ++q) { const int it = it0 + q * NT; const int row = (it < MP * 64 ? it : gt) >> 6, hc = it & 63, h = hc >> 3;
            l0[q] = *(const GAS float*)(LSE + (size_t)row * 8 + h); l1[q] = *(const GAS float*)(LSE + ((size_t)MP + row) * 8 + h); l2[q] = *(const GAS float*)(LSE + ((size_t)2 * MP + row) * 8 + h);
            a[q] = *(const GAS v4u*)(OG + (size_t)row * 512 + hc * 8); b[q] = *(const GAS v4u*)(OG + ((size_t)MP + row) * 512 + hc * 8); c[q] = *(const GAS v4u*)(OG + ((size_t)2 * MP + row) * 512 + hc * 8); }
        __builtin_amdgcn_sched_barrier(0);
#pragma unroll
        for (int q = 0; q < 4; ++q) { const int it = it0 + q * NT; if (it >= MP * 64) break; const int row = it >> 6, hc = it & 63;
            const float m = fmaxf(l0[q], fmaxf(l1[q], l2[q])); float w0 = __builtin_amdgcn_exp2f(l0[q] - m), w1 = __builtin_amdgcn_exp2f(l1[q] - m), w2 = __builtin_amdgcn_exp2f(l2[q] - m); const float inv = 1.f / (w0 + w1 + w2); w0 *= inv; w1 *= inv; w2 *= inv;
            v4u o;
#pragma unroll
            for (int e = 0; e < 4; ++e) { const float x0 = w0 * __uint_as_float(a[q][e] << 16) + w1 * __uint_as_float(b[q][e] << 16) + w2 * __uint_as_float(c[q][e] << 16);
                const float x1 = w0 * __uint_as_float(a[q][e] & 0xffff0000u) + w1 * __uint_as_float(b[q][e] & 0xffff0000u) + w2 * __uint_as_float(c[q][e] & 0xffff0000u); o[e] = cvtpk(x0, x1); }
            *(GAS v4u*)(CATB + (size_t)row * DM + 512 + hc * 8) = o; }
    }
}
__device__ __forceinline__ void ret_upd_unit(Frame& F, int bh, int n) {
    const bf16* ZB = (const bf16*)(F.ws + WS_ZB); float* UPD = (float*)(F.ws + WS_UPD) + ((size_t)bh * 32 + n) * 16384;
    const int tid = F.tid, lane = F.lane, w = F.wave, r32 = lane & 31, hi = lane >> 5;
    const int b = bh >> 2, h = bh & 3; const size_t row0 = (size_t)b * SEQ + 128 * n; const float lg = log2_gamma(h);
    {
        v4u kreg[4], vreg[4];
#pragma unroll
        for (int i = 0; i < 4; ++i) { const int c = tid + 512 * i, tok = c >> 4, ch = c & 15; const bf16* src = ZB + (row0 + tok) * DIN + h * 128 + ch * 8;
            kreg[i] = *(const GAS v4u*)(src + C_KR); vreg[i] = *(const GAS v4u*)(src + C_VR); }
#pragma unroll
        for (int i = 0; i < 4; ++i) { const int c = tid + 512 * i, tok = c >> 4, ch = c & 15; const float dec = exp2f((float)(127 - tok) * lg);
            v4u kk;
#pragma unroll
            for (int e = 0; e < 4; ++e) kk[e] = cvtpk(__uint_as_float(kreg[i][e] << 16) * dec, __uint_as_float(kreg[i][e] & 0xffff0000u) * dec);
            const int dst = (ch >> 2) * 8192 + tok * 64 + ((ch & 3) << 4);
            *(LAS v4u*)(F.lds + dst) = kk; *(LAS v4u*)(F.lds + 32768 + dst) = vreg[i]; }
    }
    __syncthreads();
    const int eb = w >> 1, db0 = 2 * (w & 1);
    const int gidx = lane >> 4, ql = (lane & 15) >> 2, pl = lane & 3;
    const int toff = (4 * hi + ql) * 64 + (16 * (gidx & 1) + 4 * pl) * 2;
    f32x16 acc[2]; acc[0] = (f32x16){}; acc[1] = (f32x16){};
#pragma unroll
    for (int s = 0; s < 8; ++s) { const LAS unsigned char* vb = F.lds + 32768 + eb * 8192 + (16 * s) * 64 + toff; const bf16x8 vf = mk8(ds_tr(vb), ds_tr(vb + 8 * 64));
#pragma unroll
        for (int q = 0; q < 2; ++q) { const LAS unsigned char* kb = F.lds + (db0 + q) * 8192 + (16 * s) * 64 + toff; const bf16x8 kf = mk8(ds_tr(kb), ds_tr(kb + 8 * 64)); acc[q] = MFMA32(vf, kf, acc[q]); } }
#pragma unroll
    for (int q = 0; q < 2; ++q)
#pragma unroll
        for (int rg = 0; rg < 16; ++rg) UPD[(size_t)(32 * eb + crow(rg, hi)) * 128 + 32 * (db0 + q) + r32] = acc[q][rg];
    __syncthreads();
}
__device__ __forceinline__ void ret_scan(Frame& F, float* pret) {
    const float* UPD = (const float*)(F.ws + WS_UPD); bf16* ST = (bf16*)(F.ws + WS_ST);
    const int gt = (F.vcu * NWAVES + F.wave) * 64 + F.lane, NT = F.G * NWAVES * 64;
    for (int it = gt; it < 16 * 16384; it += NT) { const int bh = it >> 14, ed = it & 16383, e = ed >> 7, d = ed & 127;
        const float cd = exp2f(128.f * log2_gamma(bh & 3));
        float u[32];
#pragma unroll
        for (int n = 0; n < 32; ++n) u[n] = UPD[((size_t)bh * 32 + n) * 16384 + ed];
        float S = 0.f;
#pragma unroll
        for (int n = 0; n < 32; ++n) { ST[((size_t)bh * 32 + n) * 16384 + ed] = (bf16)f2bf(S); S = cd * S + u[n]; }
        pret[(size_t)bh * 16384 + d * 128 + e] = S; }
}
__device__ __forceinline__ void ret_out_pair(Frame& F, int upair, const float* gnw) {
    const bf16* ZB = (const bf16*)(F.ws + WS_ZB); bf16* CATB = (bf16*)(F.ws + WS_CATB);
    const int tid = F.tid, lane = F.lane, w = F.wave, r32 = lane & 31, hi = lane >> 5, qd = w >> 2, wq = w & 3, tq = tid & 255;
    const int unit = 2 * upair + qd, bh = unit >> 5, n = unit & 31, b = bh >> 2, h = bh & 3;
    const size_t row0 = (size_t)b * SEQ + 128 * n; const float lg = log2_gamma(h);
    const bf16* STu = (const bf16*)(F.ws + WS_ST) + ((size_t)bh * 32 + n) * 16384;
    LAS unsigned char* Vl = F.lds + qd * 32768;
    {
        v4u vreg[8];
#pragma unroll
        for (int i = 0; i < 8; ++i) { const int c = tq + 256 * i, tok = c >> 4, ch = c & 15; vreg[i] = *(const GAS v4u*)(ZB + (row0 + tok) * DIN + C_VR + h * 128 + ch * 8); }
#pragma unroll
        for (int i = 0; i < 8; ++i) { const int c = tq + 256 * i, tok = c >> 4, ch = c & 15; *(LAS v4u*)(Vl + (ch >> 2) * 8192 + tok * 64 + ((ch & 3) << 4)) = vreg[i]; }
    }
    const int iq = 32 * wq + r32; const size_t qrow = row0 + iq;
    bf16x8 qf[8];
#pragma unroll
    for (int ks = 0; ks < 8; ++ks) qf[ks] = *(const GAS bf16x8*)(ZB + qrow * DIN + C_QR + h * 128 + ks * 16 + hi * 8);
    __syncthreads();
    f32x16 acc[4];
#pragma unroll
    for (int eb = 0; eb < 4; ++eb) { f32x16 a = {};
        bf16x8 sf[8];
#pragma unroll
        for (int ks = 0; ks < 8; ++ks) sf[ks] = *(const GAS bf16x8*)(STu + (size_t)(32 * eb + r32) * 128 + ks * 16 + hi * 8);
        __builtin_amdgcn_sched_barrier(0);
#pragma unroll
        for (int ks = 0; ks < 8; ++ks) a = MFMA32(sf[ks], qf[ks], a);
        acc[eb] = a; __builtin_amdgcn_sched_barrier(0); }
    { const float cdec = exp2f((float)(iq + 1) * lg);
#pragma unroll
        for (int eb = 0; eb < 4; ++eb)
#pragma unroll
            for (int rg = 0; rg < 16; ++rg) acc[eb][rg] *= cdec; }
    const int gidx = lane >> 4, ql = (lane & 15) >> 2, pl = lane & 3;
    const int toff = (4 * hi + ql) * 64 + (16 * (gidx & 1) + 4 * pl) * 2;
#pragma unroll 1
    for (int kb = 0; kb <= wq; ++kb) {
        {
            f32x16 p = {};
            bf16x8 kfr[8];
#pragma unroll
            for (int ks = 0; ks < 8; ++ks) kfr[ks] = *(const GAS bf16x8*)(ZB + (row0 + 32 * kb + r32) * DIN + C_KR + h * 128 + ks * 16 + hi * 8);
            __builtin_amdgcn_sched_barrier(0);
#pragma unroll
            for (int ks = 0; ks < 8; ++ks) p = MFMA32(kfr[ks], qf[ks], p);
#pragma unroll
            for (int rg = 0; rg < 16; ++rg) { const int j = 32 * kb + crow(rg, hi); p[rg] = (j <= iq) ? p[rg] * __builtin_amdgcn_exp2f((float)(iq - j) * lg) : 0.f; }
#pragma unroll
            for (int s = 0; s < 2; ++s) { const bf16x8 pf = pack_step(p, s);
#pragma unroll
                for (int eb = 0; eb < 4; ++eb) { const LAS unsigned char* vb = Vl + eb * 8192 + (32 * kb + 16 * s) * 64 + toff; const bf16x8 vf = mk8(ds_tr(vb), ds_tr(vb + 8 * 64)); acc[eb] = MFMA32(vf, pf, acc[eb]); } }
        }
    }
    float s1 = 0.f;
#pragma unroll
    for (int eb = 0; eb < 4; ++eb)
#pragma unroll
        for (int rg = 0; rg < 16; ++rg) s1 += acc[eb][rg];
    s1 += __shfl_xor(s1, 32); const float mu = s1 * (1.f / 128.f);
    float s2 = 0.f;
#pragma unroll
    for (int eb = 0; eb < 4; ++eb)
#pragma unroll
        for (int rg = 0; rg < 16; ++rg) { const float dlt = acc[eb][rg] - mu; s2 += dlt * dlt; }
    s2 += __shfl_xor(s2, 32); const float rstd = 1.f / sqrtf(s2 * (1.f / 128.f) + EPS);
#pragma unroll
    for (int eb = 0; eb < 4; ++eb)
#pragma unroll
        for (int t = 0; t < 4; ++t) { const int e = 32 * eb + 8 * t + 4 * hi;
            const unsigned long long gg = *(const GAS unsigned long long*)(ZB + qrow * DIN + C_GR + h * 128 + e);
            const f32x4 gw = *(const GAS f32x4*)(gnw + h * 128 + e);
            float gv[4] = {__uint_as_float((unsigned)gg << 16), __uint_as_float((unsigned)gg & 0xffff0000u), __uint_as_float((unsigned)(gg >> 32) << 16), __uint_as_float((unsigned)(gg >> 32) & 0xffff0000u)};
            float y[4];
#pragma unroll
            for (int k = 0; k < 4; ++k) y[k] = silu_f(gv[k]) * ((acc[eb][4 * t + k] - mu) * rstd * gw[k]);
            *(GAS unsigned long long*)(CATB + qrow * DM + h * 128 + e) = (unsigned long long)cvtpk(y[0], y[1]) | ((unsigned long long)cvtpk(y[2], y[3]) << 32); }
    __syncthreads();
}
#define MFMA16(a, b, c) __builtin_amdgcn_mfma_f32_16x16x32_bf16((a), (b), (c), 0, 0, 0)
template <int KW, class Pre> __device__ __forceinline__ f32x4 smp_task_core(Frame& F, const bf16* A, const bf16* Bt, int K, int wrow, Pre&& pre) {
#if defined(DBG_NAIVE_CORE)
    { const int lane = F.lane, fr = lane & 15, fq = lane >> 4, row = 16 * F.wave + fr; f32x4 s;
      for (int i = 0; i < 4; ++i) { const int wr_i = __shfl(wrow, 4 * fq + i); float a = 0.f;
          for (int k = 0; k < K; ++k) a += __uint_as_float((unsigned)A[(size_t)row * K + k] << 16) * __uint_as_float((unsigned)Bt[(size_t)wr_i * K + k] << 16);
          s[i] = a; }
      __syncthreads(); return s; }
#endif
    const int lane = F.lane, w = F.wave, fr = lane & 15, fq = lane >> 4;
    const bf16* ap = A + (size_t)fr * K + w * KW + 8 * fq; const bf16* bp = Bt + (size_t)wrow * K + w * KW + 8 * fq;
    f32x4 acc[8];
#pragma unroll
    for (int mb = 0; mb < 8; ++mb) acc[mb] = (f32x4){0.f, 0.f, 0.f, 0.f};
    static_assert(KW % 32 == 0 && KW / 32 <= 4, "K slice");
    constexpr int NS = KW / 32;
    bf16x8 bf[NS], af[NS][8];
#pragma unroll
    for (int q = 0; q < NS; ++q) { bf[q] = *(const GAS bf16x8*)(bp + q * 32);
#pragma unroll
        for (int mb = 0; mb < 8; ++mb) af[q][mb] = *(const GAS bf16x8*)(ap + (size_t)(16 * mb) * K + q * 32); }
    __builtin_amdgcn_sched_barrier(0);
#pragma unroll
    for (int q = 0; q < NS; ++q)
#pragma unroll
        for (int mb = 0; mb < 8; ++mb) acc[mb] = MFMA16(bf[q], af[q][mb], acc[mb]);
    __builtin_amdgcn_sched_barrier(0);
    pre();
    __builtin_amdgcn_sched_barrier(0);
    LAS f32x4* red = (LAS f32x4*)F.lds;
#pragma unroll
    for (int mb = 0; mb < 8; ++mb) red[(w * 8 + mb) * 64 + lane] = acc[mb];
    __syncthreads();
    f32x4 s = red[(0 * 8 + w) * 64 + lane];
#pragma unroll
    for (int ww = 1; ww < 8; ++ww) s += red[(ww * 8 + w) * 64 + lane];
    return s;
}
struct SmpSS { f32x4 a, b, c, d; };
__device__ __forceinline__ SmpSS smp_rstd_issue(Frame& F) {
    const float* SSs = (const float*)(F.ws + WS_SMP + SM_SS); const int fr = F.lane & 15, fq = F.lane >> 4, row = 16 * F.wave + fr;
    const GAS f32x4* p = (const GAS f32x4*)(SSs + (size_t)row * 64 + 16 * fq); SmpSS r; r.a = p[0]; r.b = p[1]; r.c = p[2]; r.d = p[3]; return r;
}
__device__ __forceinline__ float smp_rstd_finish(const SmpSS& q) {
    const f32x4 a = q.a, b = q.b, c = q.c, d = q.d;
    float s = (((a[0] + a[1]) + (a[2] + a[3])) + ((b[0] + b[1]) + (b[2] + b[3]))) + (((c[0] + c[1]) + (c[2] + c[3])) + ((d[0] + d[1]) + (d[2] + d[3])));
    s += __shfl_xor(s, 16); s += __shfl_xor(s, 32); return 1.f / sqrtf(s * (1.f / DM) + EPS);
}
__device__ __forceinline__ float smp_rstd(Frame& F) { return smp_rstd_finish(smp_rstd_issue(F)); }

__device__ __forceinline__ void smp_load_a(Frame& F, const bf16* A, bf16x8 (&af)[4][8]) {
    const int fr = F.lane & 15, fq = F.lane >> 4; const bf16* ap = A + (size_t)fr * DM + F.wave * 128 + 8 * fq;
#pragma unroll
    for (int q = 0; q < 4; ++q)
#pragma unroll
        for (int mb = 0; mb < 8; ++mb) af[q][mb] = *(const GAS bf16x8*)(ap + (size_t)(16 * mb) * DM + q * 32);
}
__device__ __forceinline__ void smp_load_b(Frame& F, const bf16* Bt, int wrow, bf16x8 (&bf)[4]) {
    const int fq = F.lane >> 4; const bf16* bp = Bt + (size_t)wrow * DM + F.wave * 128 + 8 * fq;
#pragma unroll
    for (int q = 0; q < 4; ++q) bf[q] = *(const GAS bf16x8*)(bp + q * 32);
}
template <class Pre> __device__ __forceinline__ f32x4 smp_mma_reduce(Frame& F, const bf16x8 (&af)[4][8], const bf16x8 (&bf)[4], Pre&& pre) {
    const int lane = F.lane, w = F.wave;
    f32x4 acc[8];
#pragma unroll
    for (int mb = 0; mb < 8; ++mb) acc[mb] = (f32x4){0.f, 0.f, 0.f, 0.f};
#pragma unroll
    for (int q = 0; q < 4; ++q)
#pragma unroll
        for (int mb = 0; mb < 8; ++mb) acc[mb] = MFMA16(bf[q], af[q][mb], acc[mb]);
    __builtin_amdgcn_sched_barrier(0);
    pre();
    __builtin_amdgcn_sched_barrier(0);
    LAS f32x4* red = (LAS f32x4*)F.lds;
#pragma unroll
    for (int mb = 0; mb < 8; ++mb) red[(w * 8 + mb) * 64 + lane] = acc[mb];
    __syncthreads();
    f32x4 s = red[(0 * 8 + w) * 64 + lane];
#pragma unroll
    for (int ww = 1; ww < 8; ++ww) s += red[(ww * 8 + w) * 64 + lane];
    return s;
}

#if defined(DBG_RSTD_DIRECT)
#define smp_rstd smp_rstd_direct
__device__ __forceinline__ float smp_rstd_direct(Frame& F) {
    const float* XSf = (const float*)(F.ws + WS_SMP + SM_X); const int fr = F.lane & 15, fq = F.lane >> 4, row = 16 * F.wave + fr;
    const GAS f32x4* p = (const GAS f32x4*)(XSf + (size_t)row * DM + 256 * fq); float s = 0.f;
    for (int i = 0; i < 64; ++i) { const f32x4 a = p[i]; s += (a[0] * a[0] + a[1] * a[1]) + (a[2] * a[2] + a[3] * a[3]); }
    s += __shfl_xor(s, 16); s += __shfl_xor(s, 32); return 1.f / sqrtf(s * (1.f / DM) + EPS);
}
#endif
__device__ __forceinline__ int smp_pair_wrow(int task, int fr) { const int pn = task >> 4, j0 = (task & 15) * 8; return pn * 256 + (fr < 8 ? j0 + fr : 128 + j0 + (fr - 8)); }
__device__ __forceinline__ void sample_win_tasks(Frame& F, int task0, int tstep, const bf16* Wl, float* swk, float* swv) {
    if (task0 >= 224) return;
    const bf16* XSB = (const bf16*)(F.ws + WS_SMP + SM_HB); bf16* ZS = (bf16*)(F.ws + WS_SMP + SM_ZB);
    const float* T64 = (const float*)(F.ws + WS_T64); const float* T32 = (const float*)(F.ws + WS_T32);
    const int lane = F.lane, fr = lane & 15, fq = lane >> 4;
    bf16x8 af[4][8], bf[4];
    smp_load_a(F, XSB, af); smp_load_b(F, Wl, smp_pair_wrow(task0, fr), bf);
#pragma unroll 1
    for (int task = task0; task < 224; task += tstep) {
        const bool more = task + tstep < 224; bf16x8 bn[4];
        if (more) smp_load_b(F, Wl, smp_pair_wrow(task + tstep, fr), bn);
        const int pn = task >> 4, j0 = (task & 15) * 8;
        const int bj = fq >> 1, j = j0 + 4 * (fq & 1);
        const bool rot = (pn < 4) || (pn >= 8 && pn < 12);
        int feat; const float* T = T64; int tstride = 64, fidx = 0; float sc = 1.f;
        if (pn < 4) { feat = (pn >> 1) * 512 + (2 * (pn & 1) + (j >> 6)) * 128 + (j & 63) + 64 * bj; fidx = j & 63; sc = (pn >= 2) ? pg8::KR_SCALE : 1.f; }
        else if (pn >= 8 && pn < 12) { feat = 2048 + ((pn - 8) >> 1) * 512 + (4 * (pn & 1) + (j >> 5)) * 64 + (j & 31) + 32 * bj; fidx = j & 31; T = T32; tstride = 32; sc = (pn < 10) ? pg8::QA_SCALE : 1.f; }
        else feat = pn * 256 + 128 * bj + j;
        const int row = 16 * F.wave + fr;
        SmpSS ssq; f32x4 cs0, cs1;
        const float* tp = T + ((size_t)(SEQ + (row & 3)) * tstride + fidx) * 2;
        f32x4 v = smp_mma_reduce(F, af, bf, [&]() { ssq = smp_rstd_issue(F); cs0 = *(const GAS f32x4*)tp; cs1 = *(const GAS f32x4*)(tp + 4); });
        v *= smp_rstd_finish(ssq);
        f32x4 pr; pr[0] = __shfl_xor(v[0], 32); pr[1] = __shfl_xor(v[1], 32); pr[2] = __shfl_xor(v[2], 32); pr[3] = __shfl_xor(v[3], 32);
        if (rot) {
            const float c[4] = {cs0[0], cs0[2], cs1[0], cs1[2]}, s[4] = {cs0[1], cs0[3], cs1[1], cs1[3]};
#pragma unroll
            for (int i = 0; i < 4; ++i) v[i] = (bj == 0 ? (v[i] * c[i] - pr[i] * s[i]) : (v[i] * c[i] + pr[i] * s[i])) * sc; }
        *(GAS unsigned long long*)(ZS + (size_t)row * DIN + feat) = (unsigned long long)cvtpk(v[0], v[1]) | ((unsigned long long)cvtpk(v[2], v[3]) << 32);
        if (pn == 10 || pn == 11) *(GAS f32x4*)(swk + (size_t)row * 512 + (feat - C_KA)) = v;
        if (pn >= 12) *(GAS f32x4*)(swv + (size_t)row * 512 + (feat - C_VA)) = v;
        __syncthreads();
        if (more) {
#pragma unroll
            for (int q = 0; q < 4; ++q) bf[q] = bn[q]; }
    }
}
template <int KW> __device__ __forceinline__ void sample_resid_task(Frame& F, const bf16* A, const bf16* Bt, int K, int task) {
    float* XS = (float*)(F.ws + WS_SMP + SM_X); bf16* XSB = (bf16*)(F.ws + WS_SMP + SM_HB); float* SSs = (float*)(F.ws + WS_SMP + SM_SS);
    const int lane = F.lane, w = F.wave, fr = lane & 15, fq = lane >> 4, cg = task >> 2, rq = task & 3;
    constexpr int NS = KW / 32;
    const bf16* ap = A + (size_t)(32 * rq + fr) * K + w * KW + 8 * fq; const bf16* bp = Bt + (size_t)(16 * cg + fr) * K + w * KW + 8 * fq;
    bf16x8 bf[NS], a0[NS], a1[NS];
#pragma unroll
    for (int s = 0; s < NS; ++s) { bf[s] = *(const GAS bf16x8*)(bp + s * 32); a0[s] = *(const GAS bf16x8*)(ap + s * 32); a1[s] = *(const GAS bf16x8*)(ap + (size_t)16 * K + s * 32); }
    __builtin_amdgcn_sched_barrier(0);
    f32x4 acc0 = {0.f, 0.f, 0.f, 0.f}, acc1 = acc0;
#pragma unroll
    for (int s = 0; s < NS; ++s) { acc0 = MFMA16(bf[s], a0[s], acc0); acc1 = MFMA16(bf[s], a1[s], acc1); }
    LAS f32x4* red = (LAS f32x4*)F.lds;
    red[(w * 2 + 0) * 64 + lane] = acc0; red[(w * 2 + 1) * 64 + lane] = acc1;
    __syncthreads();
    if (w < 2) {
        f32x4 d = red[(0 * 2 + w) * 64 + lane];
#pragma unroll
        for (int ww = 1; ww < 8; ++ww) d += red[(ww * 2 + w) * 64 + lane];
        const int row = 32 * rq + 16 * w + fr;
        float* xp = XS + (size_t)row * DM + 16 * cg + 4 * fq;
        const f32x4 x = *(const GAS f32x4*)xp + d;
        *(GAS f32x4*)xp = x;
        *(GAS unsigned long long*)(XSB + (size_t)row * DM + 16 * cg + 4 * fq) = (unsigned long long)cvtpk(x[0], x[1]) | ((unsigned long long)cvtpk(x[2], x[3]) << 32);
        float s = (x[0] * x[0] + x[1] * x[1]) + (x[2] * x[2] + x[3] * x[3]); s += __shfl_xor(s, 16); s += __shfl_xor(s, 32);
        if (fq == 0) SSs[(size_t)row * 64 + cg] = s;
    }
    __syncthreads();
}

#if defined(DBG_NAIVE_RESID)
__device__ __forceinline__ void sample_resid_naive(Frame& F, const bf16* A, const bf16* Bt, int K) {
    float* XSf = (float*)(F.ws + WS_SMP + SM_X); bf16* XSB = (bf16*)(F.ws + WS_SMP + SM_HB);
    const int gt = (F.vcu * NWAVES + F.wave) * 64 + F.lane, NT = F.G * NWAVES * 64;
    for (int it = gt; it < MS * DM; it += NT) { const int row = it / DM, col = it % DM; float s = 0.f;
        for (int k = 0; k < K; ++k) s += __uint_as_float((unsigned)A[(size_t)row * K + k] << 16) * __uint_as_float((unsigned)Bt[(size_t)col * K + k] << 16);
        const float x = XSf[it] + s; XSf[it] = x; XSB[it] = (bf16)f2bf(x); }
}
#endif
__device__ __forceinline__ void sample_up_tasks(Frame& F, int task0, int tstep, const bf16* Wl, const float* sconv_in, const float* cw, const float* cb, float* sconv_out) {
    if (task0 >= 352) return;
    const bf16* XSB = (const bf16*)(F.ws + WS_SMP + SM_HB); bf16* AS = (bf16*)(F.ws + WS_SMP + SM_AB);
    const int lane = F.lane, fr = lane & 15, fq = lane >> 4;
    bf16x8 af[4][8], bf[4];
    smp_load_a(F, XSB, af); smp_load_b(F, Wl, smp_pair_wrow(task0, fr), bf);
#pragma unroll 1
    for (int task = task0; task < 352; task += tstep) {
        const bool more = task + tstep < 352; bf16x8 bn[4];
        if (more) smp_load_b(F, Wl, smp_pair_wrow(task + tstep, fr), bn);
        const int pn = task >> 4, j0 = (task & 15) * 8;
        const int row = 16 * F.wave + fr, b = row >> 2, t = row & 3;
        const int feat = (fq >> 1) * DFF + 128 * pn + j0 + 4 * (fq & 1);
        SmpSS ssq; f32x4 c0, c1, w0, w1, w2, bb;
        const f32x4 u_raw = smp_mma_reduce(F, af, bf, [&]() { ssq = smp_rstd_issue(F);
            c0 = *(const GAS f32x4*)(sconv_in + ((size_t)b * 2 + 0) * DUP + feat); c1 = *(const GAS f32x4*)(sconv_in + ((size_t)b * 2 + 1) * DUP + feat);
            w0 = *(const GAS f32x4*)(cw + feat); w1 = *(const GAS f32x4*)(cw + DUP + feat); w2 = *(const GAS f32x4*)(cw + 2 * DUP + feat); bb = *(const GAS f32x4*)(cb + feat); });
        const f32x4 u = u_raw * smp_rstd_finish(ssq);
        f32x4 r;
#pragma unroll
        for (int i = 0; i < 4; ++i) { const float s1 = __shfl_up(u[i], 1, 16), s2 = __shfl_up(u[i], 2, 16);
            const float p1 = (t >= 1) ? s1 : c1[i], p2 = (t >= 2) ? s2 : (t == 1 ? c1[i] : c0[i]);
            r[i] = bb[i] + w0[i] * p2 + w1[i] * p1 + w2[i] * u[i]; }
        f32x4 pr; pr[0] = __shfl_xor(r[0], 32); pr[1] = __shfl_xor(r[1], 32); pr[2] = __shfl_xor(r[2], 32); pr[3] = __shfl_xor(r[3], 32);
        if (fq < 2) { const int c = 128 * pn + j0 + 4 * fq;
            *(GAS unsigned long long*)(AS + (size_t)row * DFF + c) = (unsigned long long)cvtpk(silu_f(r[0]) * pr[0], silu_f(r[1]) * pr[1]) | ((unsigned long long)cvtpk(silu_f(r[2]) * pr[2], silu_f(r[3]) * pr[3]) << 32); }
        if (t >= 2) *(GAS f32x4*)(sconv_out + ((size_t)b * 2 + (t - 2)) * DUP + feat) = u;
        __syncthreads();
        if (more) {
#pragma unroll
            for (int q = 0; q < 4; ++q) bf[q] = bn[q]; }
    }
}

__device__ __forceinline__ void sample_attn_unit(Frame& F, int b, int h, const float* ck, const float* cv) {
    const bf16* ZS = (const bf16*)(F.ws + WS_SMP + SM_ZB); bf16* CATS = (bf16*)(F.ws + WS_SMP + SM_CATB);
    LAS float* sc = (LAS float*)F.lds; LAS float* part = sc + 4 * 388; LAS float* ml = part + 8 * 64;
    const int lane = F.lane, w = F.wave, t = w & 3, hf = w >> 2, sub = lane >> 4, l16 = lane & 15;
    float q[4];
    { const unsigned long long qq = *(const GAS unsigned long long*)(ZS + (size_t)(b * 4 + t) * DIN + C_QA + h * 64 + 4 * l16);
      q[0] = __uint_as_float((unsigned)qq << 16); q[1] = __uint_as_float((unsigned)qq & 0xffff0000u); q[2] = __uint_as_float((unsigned)(qq >> 32) << 16); q[3] = __uint_as_float((unsigned)(qq >> 32) & 0xffff0000u); }
    const float* ckb = ck + ((size_t)b * WCTX * 8 + h) * 64 + 4 * l16; const float* cvb = cv + ((size_t)b * WCTX * 8 + h) * 64 + 4 * l16;
#pragma unroll 1
    for (int c0 = 0; c0 < 50; c0 += 25) {
        f32x4 kvv[25];
#pragma unroll
        for (int u = 0; u < 25; ++u) { const int k = 4 * (hf + 2 * (c0 + u)) + sub; const int kk = k < 387 ? k : 386;
            const int g = kk / 129, j = kk - 129 * g; const int idx = WCTX + t - (j << (2 * g)); const int ic = idx >= WCTX ? WCTX - 1 : idx;
            kvv[u] = *(const GAS f32x4*)(ckb + (size_t)ic * 512); }
        __builtin_amdgcn_sched_barrier(0);
#pragma unroll
        for (int u = 0; u < 25; ++u) { const int k = 4 * (hf + 2 * (c0 + u)) + sub; const bool valid = k < 387; const int kk = valid ? k : 386;
            const int g = kk / 129, j = kk - 129 * g; const int idx = WCTX + t - (j << (2 * g)); const bool isnew = idx >= WCTX;
            const f32x4 kv = kvv[u];
            float s = q[0] * kv[0] + q[1] * kv[1] + q[2] * kv[2] + q[3] * kv[3];
            s += __shfl_xor(s, 1); s += __shfl_xor(s, 2); s += __shfl_xor(s, 4); s += __shfl_xor(s, 8);
            if (l16 == 0 && valid && !isnew) sc[t * 388 + k] = s; }
        __builtin_amdgcn_sched_barrier(0);
    }
#define SMP_NEWPAIR(pi, kvar, rvar) const bool pv_ = (pi) < t + 3; const int kvar = (pi) <= t ? (pi) : ((pi) == t + 1 ? 129 : 258); const int rvar = (pi) <= t ? t - (pi) : t;
    if (hf == 0) {
#pragma unroll
        for (int i = 0; i < 2; ++i) { SMP_NEWPAIR(4 * i + sub, kn, rn)
            const unsigned long long x = *(const GAS unsigned long long*)(ZS + (size_t)(b * 4 + rn) * DIN + C_KA + h * 64 + 4 * l16);
            float s = q[0] * __uint_as_float((unsigned)x << 16) + q[1] * __uint_as_float((unsigned)x & 0xffff0000u) + q[2] * __uint_as_float((unsigned)(x >> 32) << 16) + q[3] * __uint_as_float((unsigned)(x >> 32) & 0xffff0000u);
            s += __shfl_xor(s, 1); s += __shfl_xor(s, 2); s += __shfl_xor(s, 4); s += __shfl_xor(s, 8);
            if (l16 == 0 && pv_) sc[t * 388 + kn] = s; }
    }
    __syncthreads();
    if (w < 4) {
        float m = -INFINITY;
        for (int k = lane; k < 387; k += 64) m = fmaxf(m, sc[t * 388 + k]);
#pragma unroll
        for (int o = 1; o < 64; o <<= 1) m = fmaxf(m, __shfl_xor(m, o));
        float l = 0.f;
        for (int k = lane; k < 387; k += 64) { const float e = exp2f(sc[t * 388 + k] - m); sc[t * 388 + k] = e; l += e; }
        l = wave_sum(l);
        if (lane == 0) { ml[t] = l; sc[t * 388 + 387] = 0.f; }
    }
    __syncthreads();
    float a4[4] = {0.f, 0.f, 0.f, 0.f};
#pragma unroll 1
    for (int c0 = 0; c0 < 50; c0 += 25) {
        f32x4 vvv[25];
#pragma unroll
        for (int u = 0; u < 25; ++u) { const int k = 4 * (hf + 2 * (c0 + u)) + sub; const int kk = k < 387 ? k : 386;
            const int g = kk / 129, j = kk - 129 * g; const int idx = WCTX + t - (j << (2 * g)); const int ic = idx >= WCTX ? WCTX - 1 : idx;
            vvv[u] = *(const GAS f32x4*)(cvb + (size_t)ic * 512); }
        __builtin_amdgcn_sched_barrier(0);
#pragma unroll
        for (int u = 0; u < 25; ++u) { const int k = 4 * (hf + 2 * (c0 + u)) + sub; const bool valid = k < 387; const int kk = valid ? k : 386;
            const int g = kk / 129, j = kk - 129 * g; const int idx = WCTX + t - (j << (2 * g)); const bool isnew = idx >= WCTX;
            const f32x4 vv = vvv[u];
            const float p = (valid && !isnew) ? sc[t * 388 + kk] : 0.f;
#pragma unroll
            for (int i = 0; i < 4; ++i) a4[i] += p * vv[i]; }
        __builtin_amdgcn_sched_barrier(0);
    }
    if (hf == 0) {
#pragma unroll
        for (int i = 0; i < 2; ++i) { SMP_NEWPAIR(4 * i + sub, kn, rn)
            const unsigned long long x = *(const GAS unsigned long long*)(ZS + (size_t)(b * 4 + rn) * DIN + C_VA + h * 64 + 4 * l16);
            const float p = pv_ ? sc[t * 388 + kn] : 0.f;
            a4[0] += p * __uint_as_float((unsigned)x << 16); a4[1] += p * __uint_as_float((unsigned)x & 0xffff0000u); a4[2] += p * __uint_as_float((unsigned)(x >> 32) << 16); a4[3] += p * __uint_as_float((unsigned)(x >> 32) & 0xffff0000u); }
    }
#undef SMP_NEWPAIR
#pragma unroll
    for (int i = 0; i < 4; ++i) { a4[i] += __shfl_xor(a4[i], 16); a4[i] += __shfl_xor(a4[i], 32); }
    if (lane < 16) { part[w * 64 + 4 * l16 + 0] = a4[0]; part[w * 64 + 4 * l16 + 1] = a4[1]; part[w * 64 + 4 * l16 + 2] = a4[2]; part[w * 64 + 4 * l16 + 3] = a4[3]; }
    __syncthreads();
    if (w < 4) { const float o = (part[w * 64 + lane] + part[(w + 4) * 64 + lane]) / ml[w];
        CATS[(size_t)(b * 4 + w) * DM + 512 + h * 64 + lane] = (bf16)f2bf(o); }
    __syncthreads();
}
__device__ __forceinline__ void sample_ret_unit(Frame& F, int b, int h, const float* s0, float* s1, const float* gnw) {
    const bf16* ZS = (const bf16*)(F.ws + WS_SMP + SM_ZB); bf16* CATS = (bf16*)(F.ws + WS_SMP + SM_CATB);
    LAS float* qs = (LAS float*)F.lds; LAS float* ks = qs + 512; LAS float* vs = ks + 512; LAS float* part = vs + 512; LAS float* ob = part + 512;
    const int tid = F.tid, lane = F.lane, w = F.wave, e = tid & 127, dq = tid >> 7;
    { const int tt = tid >> 7, dd = tid & 127; const bf16* zr = ZS + (size_t)(b * 4 + tt) * DIN + h * 128 + dd;
      qs[tid] = __uint_as_float((unsigned)zr[C_QR] << 16); ks[tid] = __uint_as_float((unsigned)zr[C_KR] << 16); vs[tid] = __uint_as_float((unsigned)zr[C_VR] << 16); }
    const size_t sbase = ((size_t)b * 4 + h) * 16384;
    float S[32];
#pragma unroll
    for (int d = 0; d < 32; ++d) S[d] = s0[sbase + (size_t)(32 * dq + d) * 128 + e];
    const float gam = 1.f - exp2f(-5.f - (float)h);
    __syncthreads();
#pragma unroll 1
    for (int t = 0; t < 4; ++t) {
        const float v = vs[t * 128 + e]; float po = 0.f;
#pragma unroll
        for (int d = 0; d < 32; ++d) { S[d] = gam * S[d] + ks[t * 128 + 32 * dq + d] * v; po += qs[t * 128 + 32 * dq + d] * S[d]; }
        part[dq * 128 + e] = po;
        __syncthreads();
        if (dq == 0) ob[t * 128 + e] = (part[e] + part[128 + e]) + (part[256 + e] + part[384 + e]);
        __syncthreads();
    }
#pragma unroll
    for (int d = 0; d < 32; ++d) s1[sbase + (size_t)(32 * dq + d) * 128 + e] = S[d];
    if (w < 4) { const int t = w; const float a = ob[t * 128 + lane], c = ob[t * 128 + 64 + lane];
        const float mu = wave_sum(a + c) * (1.f / 128.f); const float var = wave_sum((a - mu) * (a - mu) + (c - mu) * (c - mu)) * (1.f / 128.f); const float rstd = 1.f / sqrtf(var + EPS);
        const bf16* zr = ZS + (size_t)(b * 4 + t) * DIN + C_GR + h * 128;
        const float g0 = __uint_as_float((unsigned)zr[lane] << 16), g1 = __uint_as_float((unsigned)zr[64 + lane] << 16);
        CATS[(size_t)(b * 4 + t) * DM + h * 128 + lane] = (bf16)f2bf(silu_f(g0) * ((a - mu) * rstd * gnw[h * 128 + lane]));
        CATS[(size_t)(b * 4 + t) * DM + h * 128 + 64 + lane] = (bf16)f2bf(silu_f(g1) * ((c - mu) * rstd * gnw[h * 128 + 64 + lane])); }
    __syncthreads();
}
#if defined(__HIP_DEVICE_COMPILE__)
#define MK_ASSUME_GLOBAL(p) do { __builtin_assume(!__builtin_amdgcn_is_shared((const void*)(p))); __builtin_assume(!__builtin_amdgcn_is_private((const void*)(p))); } while (0)
#else
#define MK_ASSUME_GLOBAL(p) do { } while (0)
#endif
#define MK_REFRESH() do { int t_; asm volatile("v_mbcnt_lo_u32_b32 %0, -1, 0\n\tv_mbcnt_hi_u32_b32 %0, -1, %0" : "=v"(t_)); t_ += wave_s * 64;     F.tid = t_; F.lane = t_ & 63; F.wave = __builtin_amdgcn_readfirstlane(t_ >> 6); \
    GAS unsigned char* w_ = (GAS unsigned char*)args.ws; asm volatile("" : "+s"(w_)); F.ws = (unsigned char*)w_;     F.ctl = (gu32*)(w_ + WS_CTL); { GAS float* o_ = (GAS float*)args.out; asm volatile("" : "+s"(o_)); outp = (float*)o_; } \
    bx = blockIdx.x; asm volatile("" : "+s"(bx)); F.G = gridDim.x; F.vcu = (F.G % 8 == 0) ? (bx % 8) * (F.G / 8) + bx / 8 : bx; } while (0)
#define MK_FRAME_SETUP() \
    extern __shared__ __attribute__((aligned(16))) unsigned char lds[]; \
    Frame F; F.lds = (LAS unsigned char*)lds; F.MISC = (volatile LAS unsigned*)(F.lds + MISC_OFF); \
    F.tid = threadIdx.x; F.lane = F.tid & 63; F.wave = __builtin_amdgcn_readfirstlane(F.tid >> 6); \
    F.G = gridDim.x; { const int bx = blockIdx.x; F.vcu = (F.G % 8 == 0) ? (bx % 8) * (F.G / 8) + bx / 8 : bx; } \
    F.ws = args.ws; F.ctl = (gu32*)(args.ws + WS_CTL);

enum { I_XP = 0, I_XS = 1, I_CK = 2, I_CV = 3, I_SRET = 4, I_SCONV = 5, I_N1W = 6, I_WIN = 7, I_GNW = 8, I_WOUT = 9, I_N2W = 10, I_WUP = 11, I_CW = 12, I_CB = 13, I_WDN = 14, I_FNW = 15 };
constexpr size_t O_YP = 0, O_YS = O_YP + (size_t)MP * DM, O_PWK = O_YS + (size_t)MS * DM, O_PWV = O_PWK + (size_t)DEPTH * NBATCH * 2048 * 512,
                 O_PRET = O_PWV + (size_t)DEPTH * NBATCH * 2048 * 512, O_PCONV = O_PRET + (size_t)DEPTH * NBATCH * 4 * 16384, O_SWK = O_PCONV + (size_t)DEPTH * NBATCH * 2 * DUP,
                 O_SWV = O_SWK + (size_t)DEPTH * MS * 512, O_SRET = O_SWV + (size_t)DEPTH * MS * 512, O_SCONV = O_SRET + (size_t)DEPTH * DBATCH * 4 * 16384, O_END = O_SCONV + (size_t)DEPTH * DBATCH * 2 * DUP;


__global__ void __launch_bounds__(NWAVES * 64, 2) mk_fwd(Args args) {
    MK_FRAME_SETUP();
#define INP(i) ((const float*)(const GAS float*)args.in[i])
    float* outp = args.out; int bx = blockIdx.x; const int wave_s = __builtin_amdgcn_readfirstlane((int)threadIdx.x >> 6);
    for (int u = F.tid; u < (LDS_BYTES - LDSCTL_OFF) / 4; u += NWAVES * 64) ((LAS unsigned*)(F.lds + LDSCTL_OFF))[u] = 0u;
    __syncthreads();
    XcdBarrier bar = xcd_barrier_post((unsigned*)(F.ctl + CW_BAR), F.MISC + 8);
#define XRES ((float*)(F.ws + WS_XRES))
#define XS ((float*)(F.ws + WS_SMP + SM_X))
    p0_prologue(F, INP(I_WIN), INP(I_WOUT), INP(I_WUP), INP(I_WDN), INP(I_N1W), INP(I_N2W), INP(I_XP));
    { const int gw = F.vcu * NWAVES + F.wave, NGW = F.G * NWAVES;
      for (int r = NGW - 1 - gw; r < MS; r += NGW) { const GAS f32x4* xr = (const GAS f32x4*)(INP(I_XS) + (size_t)r * DM) + F.lane; GAS f32x4* xo = (GAS f32x4*)(XS + (size_t)r * DM) + F.lane;
          GAS unsigned long long* o8 = (GAS unsigned long long*)((bf16*)(F.ws + WS_SMP + SM_HB) + (size_t)r * DM) + F.lane; float s = 0.f;
#pragma unroll
          for (int j = 0; j < 4; ++j) { const f32x4 v = xr[64 * j]; xo[64 * j] = v; s += (v.x * v.x + v.y * v.y) + (v.z * v.z + v.w * v.w); o8[64 * j] = (unsigned long long)pk2(v.x, v.y) | ((unsigned long long)pk2(v.z, v.w) << 32); }
          s = wave_sum(s); ((float*)(F.ws + WS_SMP + SM_SS))[(size_t)r * 64 + F.lane] = (F.lane == 0) ? s : 0.f; } }
    MK_REFRESH(); xcd_barrier(bar, F.tid); MK_REFRESH();
    for (int l = 0; l < DEPTH; ++l) {
        {
            pg8::Gemm g{(const pg8::bf16_t*)(F.ws + WS_HB), (const pg8::bf16_t*)(F.ws + WS_WIN) + (size_t)l * DIN * DM, MP, DIN, DM}; pg8::StaticOrder S; S.init(MP, DIN, F.G, bx); S.wperm = true;
            pg8::EpiIn E{(pg8::bf16_t*)(F.ws + WS_ZB), (const float*)(F.ws + WS_T64), (const float*)(F.ws + WS_T32), outp + O_PWK + (size_t)l * NBATCH * 2048 * 512, outp + O_PWV + (size_t)l * NBATCH * 2048 * 512, (const float*)(F.ws + WS_SS1)};
            if (bx >= F.G / 2) sample_win_tasks(F, bx - F.G / 2, F.G - F.G / 2, (const bf16*)(F.ws + WS_WIN) + (size_t)l * DIN * DM, outp + O_SWK + (size_t)l * MS * 512, outp + O_SWV + (size_t)l * MS * 512);
            pg8::gemm_phase<pg8::EpiIn, pg8::StaticOrder, true, true>(F.lds + RING_OFF, g, S, E, F.tid);
        }
        MK_REFRESH(); xcd_barrier(bar, F.tid); MK_REFRESH();
        {
#define MK_SAMPLE_UNITS() do { \
                for (int u = F.G - 1 - F.vcu; u < 256; u += F.G) sample_attn_unit(F, u >> 3, u & 7, INP(I_CK) + (size_t)l * DBATCH * WCTX * 512, INP(I_CV) + (size_t)l * DBATCH * WCTX * 512); \
                for (int u = F.vcu; u < 128; u += F.G) sample_ret_unit(F, u >> 2, u & 3, INP(I_SRET) + (size_t)l * DBATCH * 4 * 16384, outp + O_SRET + (size_t)l * DBATCH * 4 * 16384, INP(I_GNW) + (size_t)l * 512); } while (0)
            if (F.vcu & 1) MK_SAMPLE_UNITS();
            attn_prompt_units(F);
            for (int u = F.vcu; u < 512; u += F.G) ret_upd_unit(F, u >> 5, u & 31);
            if (!(F.vcu & 1)) MK_SAMPLE_UNITS();
#undef MK_SAMPLE_UNITS
        }
        MK_REFRESH(); xcd_barrier(bar, F.tid); MK_REFRESH();
        ret_scan(F, outp + O_PRET + (size_t)l * NBATCH * 4 * 16384);
#if defined(DBG_NAIVE_RESID)
        sample_resid_naive(F, (const bf16*)(F.ws + WS_SMP + SM_CATB), (const bf16*)(F.ws + WS_WOUT) + (size_t)l * DM * DM, DM);
#else
        for (int task = bx; task < 256; task += F.G) sample_resid_task<128>(F, (const bf16*)(F.ws + WS_SMP + SM_CATB), (const bf16*)(F.ws + WS_WOUT) + (size_t)l * DM * DM, DM, task);
#endif
        MK_REFRESH(); xcd_barrier(bar, F.tid); MK_REFRESH();
        { for (int u = F.vcu; u < 256; u += F.G) ret_out_pair(F, u, INP(I_GNW) + (size_t)l * 512); combine_prompt(F); }
        MK_REFRESH(); xcd_barrier(bar, F.tid); MK_REFRESH();
        {
            pg8::Gemm g{(const pg8::bf16_t*)(F.ws + WS_CATB), (const pg8::bf16_t*)(F.ws + WS_WOUT) + (size_t)l * DM * DM, MP, DM, DM}; pg8::StaticOrder S; S.init(MP, DM, F.G, bx);
            pg8::EpiResidNorm E{(pg8::bf16_t*)(F.ws + WS_HB), (float*)(F.ws + WS_SS2)};
            pg8::gemm_phase<pg8::EpiResidNorm, pg8::StaticOrder, true, true>(F.lds + RING_OFF, g, S, E, F.tid);
        }
        MK_REFRESH(); xcd_barrier(bar, F.tid); MK_REFRESH();
        {
            pg8::Gemm g{(const pg8::bf16_t*)(F.ws + WS_HB), (const pg8::bf16_t*)(F.ws + WS_WUP) + (size_t)l * DUP * DM, MP, DUP, DM}; pg8::StaticOrder S; S.init(MP, DUP, F.G, bx);
            pg8::EpiUpConv E{(pg8::bf16_t*)(F.ws + WS_AB), (float*)(F.ws + WS_UB), outp + O_PCONV + (size_t)l * NBATCH * 2 * DUP, INP(I_CW) + (size_t)l * 3 * DUP, INP(I_CB) + (size_t)l * DUP, (PG8_LAS float*)(F.lds + EXB_OFF), (const float*)(F.ws + WS_SS2)};
            if (bx >= F.G / 2) sample_up_tasks(F, bx - F.G / 2, F.G - F.G / 2, (const bf16*)(F.ws + WS_WUP) + (size_t)l * DUP * DM, INP(I_SCONV) + (size_t)l * DBATCH * 2 * DUP, INP(I_CW) + (size_t)l * 3 * DUP, INP(I_CB) + (size_t)l * DUP, outp + O_SCONV + (size_t)l * DBATCH * 2 * DUP);
            pg8::gemm_phase<pg8::EpiUpConv, pg8::StaticOrder, true, true>(F.lds + RING_OFF, g, S, E, F.tid);
        }
        MK_REFRESH(); xcd_barrier(bar, F.tid); MK_REFRESH();
        {
            conv_fixup_phase(F, INP(I_CW) + (size_t)l * 3 * DUP, INP(I_CB) + (size_t)l * DUP);
#if defined(DBG_NAIVE_RESID)
            sample_resid_naive(F, (const bf16*)(F.ws + WS_SMP + SM_AB), (const bf16*)(F.ws + WS_WDN) + (size_t)l * DM * DFF, DFF);
#else
            for (int task = bx; task < 256; task += F.G) sample_resid_task<352>(F, (const bf16*)(F.ws + WS_SMP + SM_AB), (const bf16*)(F.ws + WS_WDN) + (size_t)l * DM * DFF, DFF, task);
#endif
        }
        MK_REFRESH(); xcd_barrier(bar, F.tid); MK_REFRESH();
        {
            pg8::Gemm g{(const pg8::bf16_t*)(F.ws + WS_AB), (const pg8::bf16_t*)(F.ws + WS_WDN) + (size_t)l * DM * DFF, MP, DM, DFF}; pg8::StaticOrder S; S.init(MP, DM, F.G, bx);
            pg8::EpiResidNorm E{(pg8::bf16_t*)(F.ws + WS_HB), (float*)(F.ws + WS_SS1)};
            pg8::gemm_phase<pg8::EpiResidNorm, pg8::StaticOrder, true, true>(F.lds + RING_OFF, g, S, E, F.tid);
        }
        MK_REFRESH(); xcd_barrier(bar, F.tid); MK_REFRESH();
    }
    final_norm_phase(F, (const bf16*)(F.ws + WS_HB), XS, INP(I_FNW), outp + O_YP, outp + O_YS);
}

extern "C" void kernel_launch(void* const* d_in, const int* in_sizes, int n_in, void* d_out, int out_size, void* d_ws, size_t ws_size, hipStream_t stream) {
    static int grid = 0;
    if (grid == 0) {
        if (n_in != 16 || (size_t)out_size != O_END || ws_size < WS_OPT_END) { fprintf(stderr, "kernel_launch: unexpected sizes (n_in %d out %d ws %zu)\n", n_in, out_size, ws_size); grid = -1; return; }
        int dev = 0, cus = 0, per_cu = 0;
        if (hipGetDevice(&dev) != hipSuccess || hipDeviceGetAttribute(&cus, hipDeviceAttributeMultiprocessorCount, dev) != hipSuccess) { grid = -1; return; }
        if (hipFuncSetAttribute((const void*)mk_fwd, hipFuncAttributeMaxDynamicSharedMemorySize, LDS_BYTES) != hipSuccess) { fprintf(stderr, "kernel_launch: hipFuncSetAttribute failed\n"); grid = -1; return; }
        if (hipOccupancyMaxActiveBlocksPerMultiprocessor(&per_cu, (const void*)mk_fwd, NWAVES * 64, LDS_BYTES) != hipSuccess || per_cu < 1) { fprintf(stderr, "kernel_launch: occupancy query says %d blocks per CU\n", per_cu); }
        (void)hipGetLastError();
        grid = cus;
    }
    if (grid < 0) return;
    if (hipMemsetAsync((char*)d_ws + WS_CTL, 0, CTL_ZERO_BYTES, stream) != hipSuccess) return;
    Args a{}; for (int i = 0; i < 16; ++i) a.in[i] = (const float*)d_in[i];
    a.out = (float*)d_out; a.ws = (unsigned char*)d_ws; a.layer = 0; a.pad = 0;
    hipLaunchKernelGGL(mk_fwd, dim3(grid), dim3(NWAVES * 64), LDS_BYTES, stream, a);
}
```

```cpp
#include <hip/hip_runtime.h>
#include <cstdio>
#include <cstdint>
#include <cmath>
namespace pg8 {
#define PG8_LAS __attribute__((address_space(3)))
typedef unsigned short bf16_t;
typedef short bf16x8 __attribute__((ext_vector_type(8)));
typedef float f32x4 __attribute__((ext_vector_type(4)));
typedef unsigned u32x4 __attribute__((ext_vector_type(4)));
constexpr int BM = 256, BK = 64, HALF = 128, HTB = HALF * BK * 2  , STAGE_BYTES = 8 * HTB, NXCD = 8, WGM = 8;

__host__ __device__ __forceinline__ int lds_byte(int r, int c) { const int st = (r >> 4) * 2 + (c >> 5), rr = r & 15, cc = c & 31, ob = rr * 64 + cc * 2; return st * 1024 + (ob ^ (((ob >> 9) & 1) << 5)); }
__host__ __device__ __forceinline__ void stage_rc(int b, int& R, int& C) { const int st = b / 1024, sb = b % 1024, swz = sb ^ (((sb >> 9) & 1) << 5); R = (st >> 1) * 16 + swz / 64; C = (st & 1) * 32 + (swz % 64) / 2; }
__host__ __device__ __forceinline__ int perm32(int rho) { const int n = rho >> 4, i = rho & 15; return 8 * (i >> 2) + 4 * n + (i & 3); }

struct Unit { int pm, pn; };
struct Gemm { const bf16_t* A; const bf16_t* Bt; int M, N, K; };

struct StaticOrder {
    int nM, nN, nwg, G, c; bool wperm = false;
    __host__ __device__ void init(int M, int N, int G_, int c_) { nM = M / BM; nN = N / BM; nwg = nM * nN; G = G_; c = c_; }
    __host__ __device__ bool next(int i, Unit& u) const {
        const long L = (long)i * G + c; if (L >= nwg) return false;
        int wgid = (int)L; { const int q = nwg / NXCD, r = nwg % NXCD, xcd = wgid % NXCD, off = wgid / NXCD; wgid = (xcd < r ? xcd * (q + 1) : r * (q + 1) + (xcd - r) * q) + off; }
        const int nig = WGM * nN, gid = wgid / nig, fm = gid * WGM, gsz = (nM - fm) < WGM ? (nM - fm) : WGM;
        u.pm = fm + ((wgid % nig) % gsz); u.pn = (wgid % nig) / gsz; if (wperm) u.pn = (int)(((u.pn < 8 ? 0xDC32BA10u >> (4 * u.pn) : 0x987654u >> (4 * (u.pn - 8)))) & 15u); return true;
    }
    __device__ __forceinline__ void a_ready(const Unit&) const {}
    __device__ __forceinline__ void done(const Unit&) const {}
};

__device__ __forceinline__ unsigned cvt_pk_bf16(float lo, float hi) { unsigned r; asm volatile("v_cvt_pk_bf16_f32 %0, %1, %2" : "=v"(r) : "v"(lo), "v"(hi)); return r; }
typedef float f32x2 __attribute__((ext_vector_type(2)));
constexpr float KR_SCALE = 0.08838834764831845f;
constexpr float QA_SCALE = 0.125f * 1.4426950408889634f;
constexpr int ZLD = 3584;
__device__ __forceinline__ float row_rstd(const float* ssp, int row, int fq) {
    const f32x4 a = *(const f32x4*)(ssp + (size_t)row * 16 + 4 * fq); float s = (a[0] + a[1]) + (a[2] + a[3]); s += __shfl_xor(s, 16); s += __shfl_xor(s, 32); return 1.f / sqrtf(s * (1.f / 1024.f) + 1e-6f); }
__device__ __forceinline__ u32x4 pack8(const f32x4& a, const f32x4& b) { u32x4 w; w.x = cvt_pk_bf16(a[0], a[1]); w.y = cvt_pk_bf16(a[2], a[3]); w.z = cvt_pk_bf16(b[0], b[1]); w.w = cvt_pk_bf16(b[2], b[3]); return w; }
struct EpiIn {
    static constexpr bool PERM = true, AFTER_DRAIN = false, APERM = false;
    bf16_t* Z; const float* T64; const float* T32; float* pwk; float* pwv; const float* ss;
    __device__ __forceinline__ void operator()(const f32x4 (&acc)[2][2][4][2], const Unit& u, int wr, int wc, int fr, int fq) const {
        const int pn = u.pn; const int row0 = u.pm * BM + wr * 64 + fr;
        if ((pn >= 4 && pn < 8) || pn >= 12) {
            const int colb = pn * BM + wc * 32 + 8 * fq;
#pragma unroll
            for (int ai = 0; ai < 2; ++ai)
#pragma unroll
                for (int m = 0; m < 4; ++m) { const int row = row0 + ai * HALF + m * 16; bf16_t* rowp = Z + (size_t)row * ZLD + colb; const float rs = row_rstd(ss, row, fq);
#pragma unroll
                    for (int bj = 0; bj < 2; ++bj) { const f32x4 v0 = acc[ai][bj][m][0] * rs, v1 = acc[ai][bj][m][1] * rs;
                        *(u32x4*)(rowp + bj * HALF) = pack8(v0, v1);
                        if (pn >= 12) { const int t = row & 4095; if (t >= 2048) { float* o = pwv + ((size_t)((row >> 12) * 2048 + (t - 2048))) * 512 + (colb + bj * HALF - 3072); *(f32x4*)o = v0; *(f32x4*)(o + 4) = v1; } } } }
        } else {
            const bool hd128 = pn < 4;
            int featbase, d0, half, tstride; const float* T;
            if (hd128) { const int head = 2 * (pn & 1) + (wc >> 1); d0 = 32 * (wc & 1) + 8 * fq; featbase = (pn >> 1) * 512 + head * 128 + d0; half = 64; T = T64; tstride = 64; }
            else { const int head = 4 * (pn & 1) + wc; d0 = 8 * fq; featbase = 2048 + ((pn - 8) >> 1) * 512 + head * 64 + d0; half = 32; T = T32; tstride = 32; }
            const float sc0 = (pn < 2) ? 1.f : (pn < 4) ? KR_SCALE : (pn < 10) ? QA_SCALE : 1.f;
            const bool is_ka = (pn == 10 || pn == 11);
            f32x4 nc0, nc1, nc2, nc3, np;
            { const f32x4* tp = (const f32x4*)(T + ((size_t)(row0 & 4095) * tstride + d0) * 2); nc0 = tp[0]; nc1 = tp[1]; nc2 = tp[2]; nc3 = tp[3]; np = *(const f32x4*)(ss + (size_t)row0 * 16 + 4 * fq); }
#pragma unroll
            for (int ai = 0; ai < 2; ++ai)
#pragma unroll
                for (int m = 0; m < 4; ++m) { const int row = row0 + ai * HALF + m * 16; const int t = row & 4095;
                    const f32x4 cs0 = nc0, cs1 = nc1, cs2 = nc2, cs3 = nc3; const f32x4 pp = np;
                    if (ai * 4 + m < 7) { const int rown = row0 + ((ai * 4 + m + 1) >> 2) * HALF + ((ai * 4 + m + 1) & 3) * 16;
                        const f32x4* tp = (const f32x4*)(T + ((size_t)(rown & 4095) * tstride + d0) * 2); nc0 = tp[0]; nc1 = tp[1]; nc2 = tp[2]; nc3 = tp[3]; np = *(const f32x4*)(ss + (size_t)rown * 16 + 4 * fq); }
                    __builtin_amdgcn_sched_barrier(0);
                    float sq = (pp[0] + pp[1]) + (pp[2] + pp[3]); sq += __shfl_xor(sq, 16); sq += __shfl_xor(sq, 32); const float sc = sc0 / sqrtf(sq * (1.f / 1024.f) + 1e-6f);
                    const f32x4 xa0 = acc[ai][0][m][0], xa1 = acc[ai][0][m][1], xb0 = acc[ai][1][m][0], xb1 = acc[ai][1][m][1];
                    f32x4 o10, o11, o20, o21;
                    o10[0] = (xa0[0] * cs0[0] - xb0[0] * cs0[1]) * sc; o20[0] = (xb0[0] * cs0[0] + xa0[0] * cs0[1]) * sc;
                    o10[1] = (xa0[1] * cs0[2] - xb0[1] * cs0[3]) * sc; o20[1] = (xb0[1] * cs0[2] + xa0[1] * cs0[3]) * sc;
                    o10[2] = (xa0[2] * cs1[0] - xb0[2] * cs1[1]) * sc; o20[2] = (xb0[2] * cs1[0] + xa0[2] * cs1[1]) * sc;
                    o10[3] = (xa0[3] * cs1[2] - xb0[3] * cs1[3]) * sc; o20[3] = (xb0[3] * cs1[2] + xa0[3] * cs1[3]) * sc;
                    o11[0] = (xa1[0] * cs2[0] - xb1[0] * cs2[1]) * sc; o21[0] = (xb1[0] * cs2[0] + xa1[0] * cs2[1]) * sc;
                    o11[1] = (xa1[1] * cs2[2] - xb1[1] * cs2[3]) * sc; o21[1] = (xb1[1] * cs2[2] + xa1[1] * cs2[3]) * sc;
                    o11[2] = (xa1[2] * cs3[0] - xb1[2] * cs3[1]) * sc; o21[2] = (xb1[2] * cs3[0] + xa1[2] * cs3[1]) * sc;
                    o11[3] = (xa1[3] * cs3[2] - xb1[3] * cs3[3]) * sc; o21[3] = (xb1[3] * cs3[2] + xa1[3] * cs3[3]) * sc;
                    bf16_t* rowp = Z + (size_t)row * ZLD + featbase;
                    *(u32x4*)rowp = pack8(o10, o11); *(u32x4*)(rowp + half) = pack8(o20, o21);
                    if (is_ka && t >= 2048) { float* o = pwk + ((size_t)((row >> 12) * 2048 + (t - 2048))) * 512 + (featbase - 2560);
                        *(f32x4*)o = o10; *(f32x4*)(o + 4) = o11; *(f32x4*)(o + half) = o20; *(f32x4*)(o + half + 4) = o21; } }
        }
    }
};
struct EpiResid {
    static constexpr bool PERM = false, AFTER_DRAIN = false, APERM = false;
    const float* base; float* out;
    __device__ __forceinline__ void operator()(const f32x4 (&acc)[2][2][4][2], const Unit& u, int wr, int wc, int fr, int fq) const {
        const int col0 = u.pn * BM + wc * 32 + 4 * fq;
#pragma unroll
        for (int ai = 0; ai < 2; ++ai)
#pragma unroll
            for (int m = 0; m < 4; ++m) { const size_t off = (size_t)(u.pm * BM + ai * HALF + wr * 64 + m * 16 + fr) * 1024 + col0;
#pragma unroll
                for (int bj = 0; bj < 2; ++bj)
#pragma unroll
                    for (int n = 0; n < 2; ++n) { const f32x4 b = *(const f32x4*)(base + off + bj * HALF + n * 16); *(f32x4*)(out + off + bj * HALF + n * 16) = b + acc[ai][bj][m][n]; } }
    }
};
struct EpiResidNorm {
    static constexpr bool PERM = true, AFTER_DRAIN = false, APERM = false;
    bf16_t* xb; float* ss;
    __device__ __forceinline__ void operator()(const f32x4 (&acc)[2][2][4][2], const Unit& u, int wr, int wc, int fr, int fq) const {
        const int col0 = u.pn * BM + wc * 32 + 8 * fq;
#pragma unroll
        for (int ai = 0; ai < 2; ++ai) {
            u32x4 xin[2][4][2];
#pragma unroll
            for (int m = 0; m < 4; ++m)
#pragma unroll
                for (int bj = 0; bj < 2; ++bj) xin[ai][m][bj] = *(const u32x4*)(xb + (size_t)(u.pm * BM + ai * HALF + wr * 64 + m * 16 + fr) * 1024 + col0 + bj * HALF);
#pragma unroll
            for (int m = 0; m < 4; ++m) { const int row = u.pm * BM + ai * HALF + wr * 64 + m * 16 + fr; const size_t off = (size_t)row * 1024 + col0; float s = 0.f;
#pragma unroll
                for (int bj = 0; bj < 2; ++bj) { const u32x4 b = xin[ai][m][bj];
                    f32x4 x0, x1;
                    x0[0] = __uint_as_float(b.x << 16) + acc[ai][bj][m][0][0]; x0[1] = __uint_as_float(b.x & 0xffff0000u) + acc[ai][bj][m][0][1]; x0[2] = __uint_as_float(b.y << 16) + acc[ai][bj][m][0][2]; x0[3] = __uint_as_float(b.y & 0xffff0000u) + acc[ai][bj][m][0][3];
                    x1[0] = __uint_as_float(b.z << 16) + acc[ai][bj][m][1][0]; x1[1] = __uint_as_float(b.z & 0xffff0000u) + acc[ai][bj][m][1][1]; x1[2] = __uint_as_float(b.w << 16) + acc[ai][bj][m][1][2]; x1[3] = __uint_as_float(b.w & 0xffff0000u) + acc[ai][bj][m][1][3];
                    *(u32x4*)(xb + off + bj * HALF) = pack8(x0, x1);
                    s += (x0[0] * x0[0] + x0[1] * x0[1]) + (x0[2] * x0[2] + x0[3] * x0[3]) + (x1[0] * x1[0] + x1[1] * x1[1]) + (x1[2] * x1[2] + x1[3] * x1[3]); }
                s += __shfl_xor(s, 16); s += __shfl_xor(s, 32);
                if (fq == 0) ss[(size_t)row * 16 + u.pn * 4 + wc] = s; }
        }
    }
};
struct EpiUp {
    static constexpr bool PERM = true, AFTER_DRAIN = false, APERM = false;
    bf16_t* U; float* pconv;
    __device__ __forceinline__ void operator()(const f32x4 (&acc)[2][2][4][2], const Unit& u, int wr, int wc, int fr, int fq) const {
        const int row0 = u.pm * BM + wr * 64 + fr, col0 = u.pn * BM + wc * 32 + 8 * fq;
#pragma unroll
        for (int ai = 0; ai < 2; ++ai)
#pragma unroll
            for (int m = 0; m < 4; ++m) { const int row = row0 + ai * HALF + m * 16; bf16_t* rowp = U + (size_t)row * 5632 + col0; const int t = row & 4095;
#pragma unroll
                for (int bj = 0; bj < 2; ++bj) { const f32x4 v0 = acc[ai][bj][m][0], v1 = acc[ai][bj][m][1];
                    *(u32x4*)(rowp + bj * HALF) = pack8(v0, v1);
                    if (t >= 4094) { float* o = pconv + ((size_t)((row >> 12) * 2 + (t - 4094))) * 5632 + col0 + bj * HALF; *(f32x4*)o = v0; *(f32x4*)(o + 4) = v1; } } }
    }
};

#define PG8_DPP(oldv, src, ctrl) __builtin_bit_cast(float, __builtin_amdgcn_update_dpp(__builtin_bit_cast(int, (oldv)), __builtin_bit_cast(int, (src)), (ctrl), 0xf, 0xf, false))
__device__ __forceinline__ float silu_fast(float x) { return x * __builtin_amdgcn_rcpf(1.f + __expf(-x)); }
struct EpiUpConv {
    static constexpr bool PERM = true, AFTER_DRAIN = false, APERM = true;
    bf16_t* AB; float* ubnd; float* pconv; const float* cw; const float* cb; PG8_LAS float* exb; const float* ss;
    __device__ __forceinline__ void operator()(f32x4 (&acc)[2][2][4][2], const Unit& u, int wr, int wc, int fr, int fq) const {
        const int pn = u.pn, pm = u.pm, cloc = wc * 32 + 8 * fq, gcol = 128 * pn + cloc;
        PG8_LAS float* cwl = exb + 2048;
        { int fr_ = fr; asm volatile("" : "+v"(fr_));
          const int tid = ((wr * 4 + wc) * 4 + fq) * 16 + fr_;
#pragma unroll
          for (int k = 0; k < 2; ++k) { const int i = tid + 512 * k, which = i >> 8, col = i & 255; const int feat = col < 128 ? 128 * pn + col : 2816 + 128 * pn + (col - 128);
              cwl[i] = which < 3 ? cw[which * 5632 + feat] : cb[feat]; } }
#pragma unroll
        for (int ai = 0; ai < 2; ++ai)
#pragma unroll
            for (int m = 0; m < 4; ++m) { const float rs = row_rstd(ss, pm * BM + ai * HALF + wr * 64 + 4 * fr + m, fq);
#pragma unroll
                for (int bj = 0; bj < 2; ++bj)
#pragma unroll
                    for (int n = 0; n < 2; ++n) acc[ai][bj][m][n] *= rs; }
        if (fr == 15) {
#pragma unroll
            for (int ai = 0; ai < 2; ++ai)
#pragma unroll
                for (int bj = 0; bj < 2; ++bj)
#pragma unroll
                    for (int n = 0; n < 2; ++n) { PG8_LAS float* d = exb + ((2 * ai + wr) * 2) * 256 + bj * 128 + cloc + 4 * n; *(PG8_LAS f32x4*)d = acc[ai][bj][2][n]; *(PG8_LAS f32x4*)(d + 256) = acc[ai][bj][3][n]; }
            if (wr == 1) {
#pragma unroll
                for (int bj = 0; bj < 2; ++bj)
#pragma unroll
                    for (int n = 0; n < 2; ++n)
#pragma unroll
                        for (int k = 0; k < 2; ++k) { *(f32x4*)(ubnd + ((size_t)(pm * 4 + 2 + k) * 5632 + bj * 2816 + gcol + 4 * n)) = acc[1][bj][2 + k][n];
                            if ((pm & 15) == 15) *(f32x4*)(pconv + ((size_t)((pm >> 4) * 2 + k) * 5632 + bj * 2816 + gcol + 4 * n)) = acc[1][bj][2 + k][n]; }
            }
        }
        if (wr == 0 && fr == 0) {
#pragma unroll
            for (int bj = 0; bj < 2; ++bj)
#pragma unroll
                for (int n = 0; n < 2; ++n)
#pragma unroll
                    for (int k = 0; k < 2; ++k) *(f32x4*)(ubnd + ((size_t)(pm * 4 + k) * 5632 + bj * 2816 + gcol + 4 * n)) = acc[0][bj][k][n];
        }
        asm volatile("s_waitcnt vmcnt(0) lgkmcnt(0)" ::: "memory"); __builtin_amdgcn_s_barrier(); asm volatile("" ::: "memory");
#pragma unroll
        for (int ai = 0; ai < 2; ++ai) {
            const int s = 2 * ai + wr;
#pragma unroll
            for (int n = 0; n < 2; ++n) {
                const int cl = cloc + 4 * n;
                float o[1][4][4];
                f32x4 Bg0 = {0.f, 0.f, 0.f, 0.f}, Bg1 = Bg0, Bv0 = Bg0, Bv1 = Bg0;
                if (s > 0) { const PG8_LAS float* eb = exb + ((s - 1) * 2) * 256 + cl;
                    Bg0 = *(const PG8_LAS f32x4*)eb; Bg1 = *(const PG8_LAS f32x4*)(eb + 256); Bv0 = *(const PG8_LAS f32x4*)(eb + 128); Bv1 = *(const PG8_LAS f32x4*)(eb + 256 + 128); }
                {
                    const f32x4 wg0 = *(const PG8_LAS f32x4*)(cwl + cl), wg1 = *(const PG8_LAS f32x4*)(cwl + 256 + cl), wg2 = *(const PG8_LAS f32x4*)(cwl + 512 + cl), bg = *(const PG8_LAS f32x4*)(cwl + 768 + cl);
#pragma unroll
                    for (int i = 0; i < 4; ++i) {
                        const float g0 = acc[ai][0][0][n][i], g1 = acc[ai][0][1][n][i], g2 = acc[ai][0][2][n][i], g3 = acc[ai][0][3][n][i];
                        float og1 = Bg1[i], og0 = Bg0[i];
                        asm volatile("" : "+v"(og1), "+v"(og0));
                        const float pg3 = PG8_DPP(og1, g3, 0x111), pg2 = PG8_DPP(og0, g2, 0x111);
                        o[0][0][i] = silu_fast(bg[i] + wg2[i] * g0 + wg1[i] * pg3 + wg0[i] * pg2);
                        o[0][1][i] = silu_fast(bg[i] + wg2[i] * g1 + wg1[i] * g0 + wg0[i] * pg3);
                        o[0][2][i] = silu_fast(bg[i] + wg2[i] * g2 + wg1[i] * g1 + wg0[i] * g0);
                        o[0][3][i] = silu_fast(bg[i] + wg2[i] * g3 + wg1[i] * g2 + wg0[i] * g1);
                    }
                }
                {
                    const f32x4 wv0 = *(const PG8_LAS f32x4*)(cwl + 128 + cl), wv1 = *(const PG8_LAS f32x4*)(cwl + 256 + 128 + cl), wv2 = *(const PG8_LAS f32x4*)(cwl + 512 + 128 + cl), bv = *(const PG8_LAS f32x4*)(cwl + 768 + 128 + cl);
#pragma unroll
                    for (int i = 0; i < 4; ++i) {
                        const float v0 = acc[ai][1][0][n][i], v1 = acc[ai][1][1][n][i], v2 = acc[ai][1][2][n][i], v3 = acc[ai][1][3][n][i];
                        float ov1 = Bv1[i], ov0 = Bv0[i];
                        asm volatile("" : "+v"(ov1), "+v"(ov0));
                        const float pv3 = PG8_DPP(ov1, v3, 0x111), pv2 = PG8_DPP(ov0, v2, 0x111);
                        o[0][0][i] *= bv[i] + wv2[i] * v0 + wv1[i] * pv3 + wv0[i] * pv2;
                        o[0][1][i] *= bv[i] + wv2[i] * v1 + wv1[i] * v0 + wv0[i] * pv3;
                        o[0][2][i] *= bv[i] + wv2[i] * v2 + wv1[i] * v1 + wv0[i] * v0;
                        o[0][3][i] *= bv[i] + wv2[i] * v3 + wv1[i] * v2 + wv0[i] * v1;
                    }
                }
#pragma unroll
                for (int m = 0; m < 4; ++m) { const int row = pm * BM + ai * HALF + wr * 64 + 4 * fr + m;
                    typedef unsigned u32x2 __attribute__((ext_vector_type(2)));
                    u32x2 w; w.x = cvt_pk_bf16(o[0][m][0], o[0][m][1]); w.y = cvt_pk_bf16(o[0][m][2], o[0][m][3]);
                    *(u32x2*)(AB + (size_t)row * 2816 + gcol + 4 * n) = w; }
            }
        }
    }
};
template <class Epi, class Sched, bool ALIGN_EPI = false, bool SP2 = false>
__device__ __forceinline__ void gemm_phase(PG8_LAS unsigned char* lds, const Gemm g, const Sched& S, const Epi& E, int tid_in) {
    int tid_ = tid_in; asm volatile("" : "+v"(tid_));
    const int tid = tid_, wid = __builtin_amdgcn_readfirstlane(tid >> 6), lane = tid & 63, wr = wid >> 2, wc = wid & 3, fr = lane & 15, fq = lane >> 4;
    const int K = g.K, nt = K / BK;
    unsigned voffA[2], voffB[2];
#pragma unroll
    for (int i = 0; i < 2; ++i) { int R, C; stage_rc(tid * 16 + i * 8192, R, C); const int Rb = Epi::PERM ? ((R & ~31) + perm32(R & 31)) : R;
        const int Ra = Epi::APERM ? ((R & 64) | ((R & 15) << 2) | ((R >> 4) & 3)) : R;
        voffA[i] = (unsigned)(Ra * K + C) * 2u; voffB[i] = (unsigned)(Rb * K + C) * 2u; }
    const size_t kstep = (size_t)(BK * 2);
    const size_t hstep = (size_t)HALF * K * 2;
    const size_t tstep = 2 * hstep;
    const unsigned ldsw = (unsigned)wid * 1024u;
    const int aoff = lds_byte(wr * 64 + fr, fq * 8), boff = lds_byte(wc * 32 + fr, fq * 8);
#define PG8_SA(b, h) (((b) * 2 + (h)) * HTB)
#define PG8_SB(b, h) ((4 + (b) * 2 + (h)) * HTB)
#define PG8_STAGE(bufoff, gbase, voff) do { _Pragma("unroll") for (int _i = 0; _i < 2; ++_i) \
        __builtin_amdgcn_global_load_lds((const unsigned*)((const char*)(gbase) + (voff)[_i]), (PG8_LAS unsigned*)(lds + (bufoff) + ldsw + _i * 8192), 16, 0, 0); } while (0)
#define PG8_LDA(dst, b, h) do { _Pragma("unroll") for (int m = 0; m < 4; ++m) _Pragma("unroll") for (int k = 0; k < 2; ++k) dst[m][k] = *(const PG8_LAS bf16x8*)(lds + PG8_SA(b, h) + aoff + m * 2048 + k * 1024); } while (0)
#define PG8_LDB(dst, b, h) do { _Pragma("unroll") for (int n = 0; n < 2; ++n) _Pragma("unroll") for (int k = 0; k < 2; ++k) dst[n][k] = *(const PG8_LAS bf16x8*)(lds + PG8_SB(b, h) + boff + n * 2048 + k * 1024); } while (0)
#define PG8_MMA(ai, bj, At, Bt) do { __builtin_amdgcn_s_setprio(1); _Pragma("unroll") for (int m = 0; m < 4; ++m) _Pragma("unroll") for (int n = 0; n < 2; ++n) _Pragma("unroll") for (int k = 0; k < 2; ++k) \
        acc[ai][bj][m][n] = __builtin_amdgcn_mfma_f32_16x16x32_bf16(Bt[n][k], At[m][k], acc[ai][bj][m][n], 0, 0, 0); __builtin_amdgcn_s_setprio(0); } while (0)
#define PG8_WAIT_V(n) asm volatile("s_waitcnt vmcnt(" #n ")" ::: "memory")
#define PG8_WAIT_L(n) asm volatile("s_waitcnt lgkmcnt(" #n ")" ::: "memory")
#define PG8_BAR __builtin_amdgcn_s_barrier()
#define PG8_SCHED __builtin_amdgcn_sched_barrier(0)
    Unit cur, nxt; int ui = 0;
    if (!S.next(0, cur)) return;
    f32x4 acc[2][2][4][2];
#pragma unroll
    for (int a = 0; a < 2; ++a)
#pragma unroll
        for (int b = 0; b < 2; ++b)
#pragma unroll
            for (int m = 0; m < 4; ++m)
#pragma unroll
                for (int n = 0; n < 2; ++n) acc[a][b][m][n] = (f32x4){0.f, 0.f, 0.f, 0.f};
    bf16x8 At[4][2], B0[2][2], B1[2][2];
    const char* cA = (const char*)g.A + (size_t)cur.pm * tstep; const char* cB = (const char*)g.Bt + (size_t)cur.pn * tstep;
    S.a_ready(cur);
    if constexpr (SP2) {
        PG8_STAGE(PG8_SB(0, 0), cB, voffB); PG8_STAGE(PG8_SB(0, 1), cB + hstep, voffB); PG8_STAGE(PG8_SA(0, 0), cA, voffA); PG8_STAGE(PG8_SA(0, 1), cA + hstep, voffA);
        if (wr == 1) PG8_BAR;
        PG8_WAIT_V(2); PG8_BAR;
        PG8_STAGE(PG8_SB(1, 0), cB + kstep, voffB); PG8_STAGE(PG8_SA(1, 0), cA + kstep, voffA); PG8_STAGE(PG8_SB(1, 1), cB + hstep + kstep, voffB);
        PG8_WAIT_V(6); PG8_BAR;
    } else {
        PG8_STAGE(PG8_SB(0, 0), cB, voffB); PG8_STAGE(PG8_SA(0, 0), cA, voffA); PG8_STAGE(PG8_SB(0, 1), cB + hstep, voffB); PG8_STAGE(PG8_SA(0, 1), cA + hstep, voffA);
        if (wr == 1) PG8_BAR;
        PG8_WAIT_V(4); PG8_BAR;
        PG8_STAGE(PG8_SB(1, 0), cB + kstep, voffB); PG8_STAGE(PG8_SA(1, 0), cA + kstep, voffA); PG8_STAGE(PG8_SB(1, 1), cB + hstep + kstep, voffB);
        PG8_WAIT_V(6); PG8_BAR;
    }
    for (;;) {
        const bool has_next = S.next(ui + 1, nxt);
        const char* nA = has_next ? (const char*)g.A + (size_t)nxt.pm * tstep : cA; const char* nB = has_next ? (const char*)g.Bt + (size_t)nxt.pn * tstep : cB;
        for (int t = 0; t < nt; t += 2) {
            const bool last = (t == nt - 2);
            const char* a1 = cA + (size_t)(t + 1) * kstep;
            const char* a2 = last ? nA : cA + (size_t)(t + 2) * kstep; const char* b2 = last ? nB : cB + (size_t)(t + 2) * kstep;
            const char* a3 = a2 + kstep; const char* b3 = b2 + kstep;
            if (last && has_next) S.a_ready(nxt);
            if constexpr (SP2) {
            PG8_LDB(B0, 0, 0); PG8_LDB(B1, 0, 1); PG8_SCHED; PG8_LDA(At, 0, 0); PG8_STAGE(PG8_SA(1, 1), a1 + hstep, voffA);
            PG8_WAIT_V(8); PG8_WAIT_L(0); PG8_BAR; PG8_MMA(0, 0, At, B0); PG8_MMA(0, 1, At, B1); PG8_BAR; PG8_SCHED;
            PG8_LDA(At, 0, 1); PG8_STAGE(PG8_SB(0, 0), b2, voffB); PG8_STAGE(PG8_SB(0, 1), b2 + hstep, voffB); PG8_STAGE(PG8_SA(0, 0), a2, voffA);
            PG8_WAIT_V(8); PG8_WAIT_L(0); PG8_BAR; PG8_MMA(1, 0, At, B0); PG8_MMA(1, 1, At, B1); PG8_BAR; PG8_SCHED;
            PG8_LDB(B0, 1, 0); PG8_LDB(B1, 1, 1); PG8_SCHED; PG8_LDA(At, 1, 0); PG8_STAGE(PG8_SA(0, 1), a2 + hstep, voffA);
            PG8_WAIT_V(8); PG8_WAIT_L(0); PG8_BAR; PG8_MMA(0, 0, At, B0); PG8_MMA(0, 1, At, B1); PG8_BAR; PG8_SCHED;
            PG8_LDA(At, 1, 1); PG8_STAGE(PG8_SB(1, 0), b3, voffB); PG8_STAGE(PG8_SB(1, 1), b3 + hstep, voffB); PG8_STAGE(PG8_SA(1, 0), a3, voffA);
            PG8_WAIT_V(8); PG8_WAIT_L(0); PG8_BAR; PG8_MMA(1, 0, At, B0); PG8_MMA(1, 1, At, B1); PG8_BAR; PG8_SCHED;
            } else {
            PG8_LDB(B0, 0, 0); PG8_SCHED; PG8_LDA(At, 0, 0); PG8_STAGE(PG8_SA(1, 1), a1 + hstep, voffA);
            PG8_WAIT_L(8); PG8_BAR; PG8_WAIT_L(0); PG8_MMA(0, 0, At, B0); PG8_BAR; PG8_SCHED;
            PG8_LDB(B1, 0, 1); PG8_STAGE(PG8_SB(0, 0), b2, voffB);
            PG8_BAR; PG8_WAIT_L(0); PG8_MMA(0, 1, At, B1); PG8_BAR;
            PG8_LDA(At, 0, 1); PG8_STAGE(PG8_SA(0, 0), a2, voffA);
            PG8_BAR; PG8_WAIT_L(0); PG8_MMA(1, 0, At, B0); PG8_BAR; PG8_SCHED;
            PG8_STAGE(PG8_SB(0, 1), b2 + hstep, voffB);
            PG8_WAIT_V(6); PG8_BAR; PG8_MMA(1, 1, At, B1); PG8_BAR;
            PG8_LDB(B0, 1, 0); PG8_SCHED; PG8_LDA(At, 1, 0); PG8_STAGE(PG8_SA(0, 1), a2 + hstep, voffA);
            PG8_WAIT_L(8); PG8_BAR; PG8_WAIT_L(0); PG8_MMA(0, 0, At, B0); PG8_BAR; PG8_SCHED;
            PG8_LDB(B1, 1, 1); PG8_STAGE(PG8_SB(1, 0), b3, voffB);
            PG8_BAR; PG8_WAIT_L(0); PG8_MMA(0, 1, At, B1); PG8_BAR;
            PG8_LDA(At, 1, 1); PG8_STAGE(PG8_SA(1, 0), a3, voffA);
            PG8_BAR; PG8_WAIT_L(0); PG8_MMA(1, 0, At, B0); PG8_BAR; PG8_SCHED;
            PG8_STAGE(PG8_SB(1, 1), b3 + hstep, voffB);
            PG8_WAIT_V(6); PG8_BAR; PG8_MMA(1, 1, At, B1); PG8_BAR;
            }
        }
        if constexpr (ALIGN_EPI) { if (wr == 0) PG8_BAR; }
        if constexpr (!Epi::AFTER_DRAIN) { E(acc, cur, wr, wc, fr, fq); S.done(cur); }
        if (!has_next) break;
#pragma unroll
        for (int a = 0; a < 2; ++a)
#pragma unroll
            for (int b = 0; b < 2; ++b)
#pragma unroll
                for (int m = 0; m < 4; ++m)
#pragma unroll
                    for (int n = 0; n < 2; ++n) acc[a][b][m][n] = (f32x4){0.f, 0.f, 0.f, 0.f};
        cur = nxt; cA = nA; cB = nB; ++ui;
        if constexpr (ALIGN_EPI) { if (wr == 1) PG8_BAR; }
    }
    PG8_WAIT_V(0);
    if constexpr (!ALIGN_EPI) { if (wr == 0) PG8_BAR; }
    PG8_BAR;
    if constexpr (Epi::AFTER_DRAIN) { E.fused(acc, cur, wr, wc, fr, fq, lds, wid, lane); S.done(cur); }
#undef PG8_SA
#undef PG8_SB
#undef PG8_STAGE
#undef PG8_LDA
#undef PG8_LDB
#undef PG8_MMA
#undef PG8_WAIT_V
#undef PG8_WAIT_L
#undef PG8_BAR
#undef PG8_SCHED
}
}
#define GAS __attribute__((address_space(1)))
#define LAS __attribute__((address_space(3)))
typedef unsigned short bf16;
typedef unsigned v4u __attribute__((ext_vector_type(4)));
typedef float f32x4 __attribute__((ext_vector_type(4)));
typedef short bf16x8 __attribute__((ext_vector_type(8)));
typedef GAS unsigned gu32;
typedef GAS unsigned long long gu64;
#define RLX_AGENT __ATOMIC_RELAXED, __HIP_MEMORY_SCOPE_AGENT
#define LDS_WAIT() asm volatile("s_waitcnt lgkmcnt(0)" ::: "memory")
#define VM_WAIT() asm volatile("s_waitcnt vmcnt(0)" ::: "memory")
__device__ __forceinline__ unsigned long long rt() { return __builtin_amdgcn_s_memrealtime(); }
__device__ __forceinline__ unsigned f2bf(float f) { unsigned u = __builtin_bit_cast(unsigned, f); return (u + 0x7fffu + ((u >> 16) & 1u)) >> 16; }
__device__ __forceinline__ unsigned pk2(float lo, float hi) { return f2bf(lo) | (f2bf(hi) << 16); }
#define XB_TMO      128
#define XB_XCNT(j)  (256  + 64 * (j))
#define XB_XSUB(j)  (1280 + 64 * (j))
#define XB_XGEN(j)  (2304 + 64 * (j))
#define XB_TOP      3328
#define XB_TOPGEN   3392
#define XCD_BAR_WORDS 3456
#define XB_SPIN_CAP (1u << 18)

__device__ __forceinline__ unsigned xb_ld(unsigned* p)              { return __hip_atomic_load(p, __ATOMIC_RELAXED, __HIP_MEMORY_SCOPE_AGENT); }
__device__ __forceinline__ unsigned xb_add(unsigned* p, unsigned v) { return __hip_atomic_fetch_add(p, v, __ATOMIC_RELAXED, __HIP_MEMORY_SCOPE_AGENT); }
__device__ __forceinline__ unsigned xb_xcc_id() { return (unsigned)__builtin_amdgcn_s_getreg((3 << 11) | 20) & 0xFu; }
#define XB_SPIN(cond, bar) do { unsigned _sp = 0; while (cond) { __builtin_amdgcn_s_sleep(1); \
    if ((++_sp & 255u) == 0u) { if (xb_ld(&(bar)[XB_TMO])) break; if (_sp > XB_SPIN_CAP) { atomicAdd(&(bar)[XB_TMO], 1u); break; } } } } while (0)

struct XcdBarrier {
    unsigned* bar; unsigned x;
    volatile LAS unsigned* st;
};

__device__ __forceinline__ XcdBarrier xcd_barrier_post(unsigned* bar, volatile LAS unsigned* st) {
    XcdBarrier b; b.bar = bar; b.x = xb_xcc_id(); b.st = st;
    if (threadIdx.x == 0) (void)xb_add(&bar[XB_XCNT(b.x)], 1u);
    return b;
}
__device__ __forceinline__ void xcd_barrier_complete(unsigned* bar, unsigned x, unsigned& nloc, unsigned& nx) {
    const unsigned G = gridDim.x * gridDim.y * gridDim.z;
    unsigned sum, cnt, mine, sp = 0u;
    for (;;) {
        sum = 0u; cnt = 0u; mine = 0u;
#pragma unroll
        for (unsigned j = 0; j < 16; ++j) { const unsigned c = xb_ld(&bar[XB_XCNT(j)]); sum += c; cnt += (c > 0u) ? 1u : 0u; mine = (j == x) ? c : mine; }
        if (sum == G) break;
        __builtin_amdgcn_s_sleep(1);
        if ((++sp & 255u) == 0u) { if (xb_ld(&bar[XB_TMO])) break; if (sp > XB_SPIN_CAP) { atomicAdd(&bar[XB_TMO], 1u); break; } }
    }
    nloc = mine > 0u ? mine : 1u; nx = cnt > 0u ? cnt : 1u;
}

__device__ __forceinline__ void xcd_barrier(const XcdBarrier& b, int tid) {
    asm volatile("s_waitcnt vmcnt(0)" ::: "memory");
    __syncthreads();
    if (tid == 0) {
        unsigned* bar = b.bar; asm volatile("" : "+s"(bar));
        __builtin_amdgcn_s_waitcnt(0);
        unsigned bx_ = b.x; asm volatile("" : "+s"(bx_));
        unsigned nloc = b.st[0], nx = b.st[1];
        if (nloc == 0u) { xcd_barrier_complete(bar, bx_, nloc, nx); b.st[0] = nloc; b.st[1] = nx; }
        const unsigned old = xb_add(&bar[XB_XSUB(bx_)], 1u);
        const unsigned gen = old / nloc;
        if (old + 1u == (gen + 1u) * nloc) {
            __builtin_amdgcn_fence(__ATOMIC_RELEASE, "agent");
            asm volatile("s_waitcnt vmcnt(0)" ::: "memory");
            const unsigned og = xb_add(&bar[XB_TOP], 1u);
            const unsigned tg = og / nx;
            if (og + 1u == (tg + 1u) * nx) xb_add(&bar[XB_TOPGEN], 1u);
            else XB_SPIN(xb_ld(&bar[XB_TOPGEN]) == tg, bar);
            __builtin_amdgcn_fence(__ATOMIC_ACQUIRE, "agent");
            xb_add(&bar[XB_XGEN(bx_)], 1u);
            asm volatile("s_waitcnt vmcnt(0)" ::: "memory");
        } else {
            XB_SPIN(xb_ld(&bar[XB_XGEN(bx_)]) == gen, bar);
            __builtin_amdgcn_fence(__ATOMIC_ACQUIRE, "agent");
            asm volatile("s_waitcnt vmcnt(0)" ::: "memory");
        }
    }
    __syncthreads();
}
constexpr int NWAVES = 8;
constexpr int DM = 1024, NBATCH = 4, SEQ = 4096, DEPTH = 4, DBATCH = 32, DSEQ = 4, PAST = 8192;
constexpr int MP = NBATCH * SEQ, MS = DBATCH * DSEQ;
constexpr int DIN = 3584, DFF = 2816, DUP = 2 * DFF, WCTX = 2048;
constexpr int C_QR = 0, C_KR = 512, C_VR = 1024, C_GR = 1536, C_QA = 2048, C_KA = 2560, C_VA = 3072;
constexpr float EPS = 1e-6f;
constexpr int NPOS = SEQ + DSEQ;

__host__ __device__ __forceinline__ int in_feature(int nrow) {
    const int pn = nrow >> 8, tc = nrow & 255, bj = tc >> 7, j = tc & 127;
    if (pn < 4) return (pn >> 1) * 512 + (2 * (pn & 1) + (j >> 6)) * 128 + (j & 63) + 64 * bj;
    if (pn >= 8 && pn < 12) return 2048 + ((pn - 8) >> 1) * 512 + (4 * (pn & 1) + (j >> 5)) * 64 + (j & 31) + 32 * bj;
    return nrow;
}

__host__ __device__ __forceinline__ int up_feature(int nrow) { const int pn = nrow >> 8, tc = nrow & 255; return tc < 128 ? 128 * pn + tc : 2816 + 128 * pn + (tc - 128); }

constexpr size_t MiB = 1u << 20;
constexpr size_t WS_CTL = 0, CTL_ZERO_BYTES = 1 * MiB;
constexpr size_t WS_T64 = 1 * MiB;
constexpr size_t WS_T32 = 4 * MiB;
constexpr size_t WS_SS1 = 356 * MiB, WS_SS2 = 358 * MiB;
constexpr size_t WS_WIN = 6 * MiB;
constexpr size_t WS_WOUT = 34 * MiB;
constexpr size_t WS_WUP = 42 * MiB;
constexpr size_t WS_WDN = 86 * MiB;
constexpr size_t WS_XRES = 108 * MiB;
constexpr size_t WS_HB = 172 * MiB;
constexpr size_t WS_ZB = 204 * MiB;
constexpr size_t WS_CATB = 316 * MiB;
constexpr size_t WS_UB = 348 * MiB;
constexpr size_t WS_AB = 524 * MiB;
constexpr size_t WS_OG = 612 * MiB;
constexpr size_t WS_LSE = 660 * MiB;
constexpr size_t WS_UPD = 662 * MiB;
constexpr size_t WS_ST = 694 * MiB;
constexpr size_t WS_SMP = 710 * MiB;
constexpr size_t WS_OPT_END = 718 * MiB;
constexpr size_t WS_NAIVE = 720 * MiB;
constexpr size_t SM_X = 0;
constexpr size_t SM_HB = 512 * 1024;
constexpr size_t SM_ZB = 768 * 1024;
constexpr size_t SM_CATB = 1792 * 1024;
constexpr size_t SM_U = 2048 * 1024;
constexpr size_t SM_AB = 5120 * 1024;
constexpr size_t SM_SS = 6144 * 1024;
constexpr int CW_TMO = 0, CW_CODE = 1, CW_BAR = 4096;

constexpr int RING_OFF = 0, RING_BYTES = 131072;
constexpr int LDSCTL_OFF = RING_BYTES, MISC_OFF = LDSCTL_OFF + 320;
constexpr int EXB_OFF = 132096;
constexpr int LDS_BYTES = 147456;
static_assert(MISC_OFF + 128 <= EXB_OFF && EXB_OFF + 8192 + 4096 <= LDS_BYTES, "LDS map");
struct Frame {
    LAS unsigned char* lds;
    volatile LAS unsigned* MISC;
    gu32* ctl;
    int tid, lane, wave;
    int vcu, G;
    unsigned char* ws;
};
struct Args { const float* in[16]; float* out; unsigned char* ws; int layer, pad; };

__device__ __forceinline__ float wave_sum(float v) {
#pragma unroll
    for (int o = 1; o < 64; o <<= 1) v += __shfl_xor(v, o);
    return v;
}
__device__ __forceinline__ float silu_f(float x) { return x / (1.f + __expf(-x)); }

struct P0Item { const float* src; bf16* dst; const float* ksc; int K, N; };
__device__ __forceinline__ void p0_item_load(const P0Item& I, f32x4 (&v)[8], int lane) {
#pragma unroll
    for (int i = 0; i < 8; ++i) v[i] = *(const GAS f32x4*)(I.src + (size_t)((lane >> 3) + 8 * i) * I.N + 4 * (lane & 7));
}
__device__ __forceinline__ void p0_item_store(const P0Item& I, const f32x4 (&v)[8], LAS float* scr, int lane) {
#pragma unroll
    for (int i = 0; i < 8; ++i) { const int kk = (lane >> 3) + 8 * i; const float sc = I.ksc ? I.ksc[kk] : 1.f; LAS float* d = scr + kk * 33 + 4 * (lane & 7);
        d[0] = v[i][0] * sc; d[1] = v[i][1] * sc; d[2] = v[i][2] * sc; d[3] = v[i][3] * sc; }
    LDS_WAIT(); asm volatile("" ::: "memory");
    const int c = lane & 7;
#pragma unroll
    for (int j = 0; j < 4; ++j) { const int n = (lane >> 3) + 8 * j; const LAS float* s = scr + (8 * c) * 33 + n;
        v4u o; o.x = pk2(s[0 * 33], s[1 * 33]); o.y = pk2(s[2 * 33], s[3 * 33]); o.z = pk2(s[4 * 33], s[5 * 33]); o.w = pk2(s[6 * 33], s[7 * 33]);
        *(GAS v4u*)(I.dst + (size_t)n * I.K + 8 * c) = o; }
    LDS_WAIT(); asm volatile("" ::: "memory");
}
constexpr int P0_I_IN = (DM / 64) * (DIN / 32), P0_I_OUT = (DM / 64) * (DM / 32), P0_I_UP = (DM / 64) * (DUP / 32), P0_I_DN = (DFF / 64) * (DM / 32), P0_I_L = P0_I_IN + P0_I_OUT + P0_I_UP + P0_I_DN;
__device__ __forceinline__ void p0_convert(Frame& F, const float* w_in, const float* w_out, const float* w_up, const float* w_dn, const float* n1w, const float* n2w, int it0, int it1, int gw, int NGW) {
    LAS float* scr = (LAS float*)(F.lds + RING_OFF + F.wave * 16384);
    constexpr int I_IN = P0_I_IN, I_OUT = P0_I_OUT, I_UP = P0_I_UP, I_L = P0_I_L;
    bf16* WIN = (bf16*)(F.ws + WS_WIN); bf16* WOUT = (bf16*)(F.ws + WS_WOUT); bf16* WUP = (bf16*)(F.ws + WS_WUP); bf16* WDN = (bf16*)(F.ws + WS_WDN);
    auto resolve = [&](int it) -> P0Item {
        const int l = it / I_L; int r = it % I_L; P0Item I;
        if (r < I_IN) { const int nblk = DIN / 32, kb = r / nblk, nb = r % nblk; I.K = DM; I.N = DIN; I.src = w_in + (size_t)l * DM * DIN + (size_t)(64 * kb) * DIN + in_feature(32 * nb); I.dst = WIN + (size_t)l * DIN * DM + (size_t)(32 * nb) * DM + 64 * kb; I.ksc = n1w + (size_t)l * DM + 64 * kb; return I; } r -= I_IN;
        if (r < I_OUT) { const int nblk = DM / 32, kb = r / nblk, nb = r % nblk; I.K = DM; I.N = DM; I.src = w_out + (size_t)l * DM * DM + (size_t)(64 * kb) * DM + 32 * nb; I.dst = WOUT + (size_t)l * DM * DM + (size_t)(32 * nb) * DM + 64 * kb; I.ksc = nullptr; return I; } r -= I_OUT;
        if (r < I_UP) { const int nblk = DUP / 32, kb = r / nblk, nb = r % nblk; I.K = DM; I.N = DUP; I.src = w_up + (size_t)l * DM * DUP + (size_t)(64 * kb) * DUP + up_feature(32 * nb); I.dst = WUP + (size_t)l * DUP * DM + (size_t)(32 * nb) * DM + 64 * kb; I.ksc = n2w + (size_t)l * DM + 64 * kb; return I; } r -= I_UP;
        { const int nblk = DM / 32, kb = r / nblk, nb = r % nblk; I.K = DFF; I.N = DM; I.src = w_dn + (size_t)l * DFF * DM + (size_t)(64 * kb) * DM + 32 * nb; I.dst = WDN + (size_t)l * DM * DFF + (size_t)(32 * nb) * DFF + 64 * kb; I.ksc = nullptr; return I; }
    };
    if (it0 + gw < it1) {
        P0Item cur = resolve(it0 + gw); f32x4 v[8]; p0_item_load(cur, v, F.lane);
#pragma unroll 1
        for (int it = it0 + gw; it < it1; it += NGW) {
            const bool more = it + NGW < it1; P0Item nxt = cur; f32x4 vn[8];
            if (more) { nxt = resolve(it + NGW); p0_item_load(nxt, vn, F.lane); }
            p0_item_store(cur, v, scr, F.lane);
            if (more) { cur = nxt;
#pragma unroll
                for (int i = 0; i < 8; ++i) v[i] = vn[i]; }
        }
    }
}
__device__ __forceinline__ void p0_prologue(Frame& F, const float* w_in, const float* w_out, const float* w_up, const float* w_dn, const float* n1w, const float* n2w, const float* xp) {
    const int gw = F.vcu * NWAVES + F.wave, NGW = F.G * NWAVES;
    p0_convert(F, w_in, w_out, w_up, w_dn, n1w, n2w, 0, DEPTH * P0_I_L, gw, NGW);
    { bf16* XB = (bf16*)(F.ws + WS_HB); float* SS1 = (float*)(F.ws + WS_SS1);
      for (int m = gw; m < MP; m += NGW) { const GAS f32x4* xr = (const GAS f32x4*)(xp + (size_t)m * DM) + F.lane; GAS unsigned long long* o8 = (GAS unsigned long long*)(XB + (size_t)m * DM) + F.lane; float s = 0.f;
#pragma unroll
          for (int j = 0; j < 4; ++j) { const f32x4 v = xr[64 * j]; s += (v.x * v.x + v.y * v.y) + (v.z * v.z + v.w * v.w); o8[64 * j] = (unsigned long long)pk2(v.x, v.y) | ((unsigned long long)pk2(v.z, v.w) << 32); }
          s = wave_sum(s); if (F.lane < 16) SS1[(size_t)m * 16 + F.lane] = (F.lane == 0) ? s : 0.f; } }
    float* T64 = (float*)(F.ws + WS_T64); float* T32 = (float*)(F.ws + WS_T32);
    const int gt = (F.vcu * NWAVES + F.wave) * 64 + F.lane, NT = F.G * NWAVES * 64;
    for (int i = gt; i < NPOS * 96; i += NT) {
        const int p = i / 96, k = i % 96; const float pos = (float)(p < SEQ ? p : PAST + (p - SEQ));
        float inv; float* dst;
        if (k < 64) { inv = powf(10000.f, -(float)k / 64.f); dst = T64 + ((size_t)p * 64 + k) * 2; }
        else { inv = powf(10000.f, -(float)(k - 64) / 32.f); dst = T32 + ((size_t)p * 32 + (k - 64)) * 2; }
        float sn, cs; sincosf(pos * inv, &sn, &cs); dst[0] = cs; dst[1] = sn;
    }
}
__device__ __forceinline__ void rms_row_to_bf16(const float* xrow, const float* w, bf16* orow, int lane) {
    const GAS f32x4* xr = (const GAS f32x4*)xrow + lane; const GAS f32x4* wr = (const GAS f32x4*)w + lane;
    f32x4 v[4]; float s = 0.f;
#pragma unroll
    for (int j = 0; j < 4; ++j) { v[j] = xr[64 * j]; s += (v[j].x * v[j].x + v[j].y * v[j].y) + (v[j].z * v[j].z + v[j].w * v[j].w); }
    const float rstd = 1.f / sqrtf(wave_sum(s) * (1.f / DM) + EPS);
    GAS unsigned long long* o8 = (GAS unsigned long long*)orow + lane;
#pragma unroll
    for (int j = 0; j < 4; ++j) { const f32x4 ww = wr[64 * j];
        o8[64 * j] = (unsigned long long)pk2(v[j].x * rstd * ww.x, v[j].y * rstd * ww.y) | ((unsigned long long)pk2(v[j].z * rstd * ww.z, v[j].w * rstd * ww.w) << 32); }
}
__device__ __forceinline__ void rms_row_to_f32(const float* xrow, const float* w, float* orow, int lane) {
    const GAS f32x4* xr = (const GAS f32x4*)xrow + lane; const GAS f32x4* wr = (const GAS f32x4*)w + lane;
    f32x4 v[4]; float s = 0.f;
#pragma unroll
    for (int j = 0; j < 4; ++j) { v[j] = xr[64 * j]; s += (v[j].x * v[j].x + v[j].y * v[j].y) + (v[j].z * v[j].z + v[j].w * v[j].w); }
    const float rstd = 1.f / sqrtf(wave_sum(s) * (1.f / DM) + EPS);
    GAS f32x4* o = (GAS f32x4*)orow + lane;
#pragma unroll
    for (int j = 0; j < 4; ++j) { const f32x4 ww = wr[64 * j]; o[64 * j] = (v[j] * rstd) * ww; }
}
__device__ __forceinline__ void norm_phase(Frame& F, const float* xp, const float* xs, const float* w) {
    const int gw = F.vcu * NWAVES + F.wave, NGW = F.G * NWAVES;
    bf16* HB = (bf16*)(F.ws + WS_HB); bf16* HS = (bf16*)(F.ws + WS_SMP + SM_HB);
    for (int m = gw; m < MP; m += NGW) rms_row_to_bf16(xp + (size_t)m * DM, w, HB + (size_t)m * DM, F.lane);
    for (int m = NGW - 1 - gw; m < MS; m += NGW) rms_row_to_bf16(xs + (size_t)m * DM, w, HS + (size_t)m * DM, F.lane);
}
__device__ __forceinline__ void rms_rowb_to_f32(const bf16* xrow, const float* w, float* orow, int lane) {
    const GAS unsigned long long* xr = (const GAS unsigned long long*)xrow + lane; const GAS f32x4* wr = (const GAS f32x4*)w + lane;
    f32x4 v[4]; float s = 0.f;
#pragma unroll
    for (int j = 0; j < 4; ++j) { const unsigned long long q = xr[64 * j]; v[j].x = __uint_as_float((unsigned)q << 16); v[j].y = __uint_as_float((unsigned)q & 0xffff0000u); v[j].z = __uint_as_float((unsigned)(q >> 32) << 16); v[j].w = __uint_as_float((unsigned)(q >> 32) & 0xffff0000u);
        s += (v[j].x * v[j].x + v[j].y * v[j].y) + (v[j].z * v[j].z + v[j].w * v[j].w); }
    const float rstd = 1.f / sqrtf(wave_sum(s) * (1.f / DM) + EPS);
    GAS f32x4* o = (GAS f32x4*)orow + lane;
#pragma unroll
    for (int j = 0; j < 4; ++j) { const f32x4 ww = wr[64 * j]; o[64 * j] = (v[j] * rstd) * ww; }
}
__device__ __forceinline__ void final_norm_phase(Frame& F, const bf16* xpb, const float* xs, const float* w, float* yp, float* ys) {
    const int gw = F.vcu * NWAVES + F.wave, NGW = F.G * NWAVES;
    for (int m = gw; m < MP; m += NGW) rms_rowb_to_f32(xpb + (size_t)m * DM, w, yp + (size_t)m * DM, F.lane);
    for (int m = NGW - 1 - gw; m < MS; m += NGW) rms_row_to_f32(xs + (size_t)m * DM, w, ys + (size_t)m * DM, F.lane);
}
__device__ __forceinline__ void conv_phase_prompt(Frame& F, const float* cw, const float* cb) {
    const bf16* UB = (const bf16*)(F.ws + WS_UB); bf16* AB = (bf16*)(F.ws + WS_AB);
    const int gt = (F.vcu * NWAVES + F.wave) * 64 + F.lane, NT = F.G * NWAVES * 64;
    constexpr int NCH = DFF / 8, NITEM = (MP / 16) * NCH;
    for (int it = gt; it < NITEM; it += NT) {
        const int rb = it / NCH, c8 = it % NCH, r0 = rb * 16, c0 = c8 * 8;
        float wg[3][8], wv[3][8], bg[8], bv[8];
#pragma unroll
        for (int j = 0; j < 3; ++j)
#pragma unroll
            for (int q = 0; q < 2; ++q) { const f32x4 a = *(const GAS f32x4*)(cw + (size_t)j * DUP + c0 + 4 * q), b = *(const GAS f32x4*)(cw + (size_t)j * DUP + DFF + c0 + 4 * q);
#pragma unroll
                for (int e = 0; e < 4; ++e) { wg[j][4 * q + e] = a[e]; wv[j][4 * q + e] = b[e]; } }
#pragma unroll
        for (int q = 0; q < 2; ++q) { const f32x4 a = *(const GAS f32x4*)(cb + c0 + 4 * q), b = *(const GAS f32x4*)(cb + DFF + c0 + 4 * q);
#pragma unroll
            for (int e = 0; e < 4; ++e) { bg[4 * q + e] = a[e]; bv[4 * q + e] = b[e]; } }
        float g2[8], g1[8], v2[8], v1[8];
        const bool has_prev = (r0 & 4095) != 0;
        {
            v4u a2 = {0u, 0u, 0u, 0u}, a1 = a2, b2 = a2, b1 = a2;
            if (has_prev) { a2 = *(const GAS v4u*)(UB + (size_t)(r0 - 2) * DUP + c0); a1 = *(const GAS v4u*)(UB + (size_t)(r0 - 1) * DUP + c0);
                            b2 = *(const GAS v4u*)(UB + (size_t)(r0 - 2) * DUP + DFF + c0); b1 = *(const GAS v4u*)(UB + (size_t)(r0 - 1) * DUP + DFF + c0); }
#pragma unroll
            for (int e = 0; e < 4; ++e) { g2[2 * e] = __uint_as_float(a2[e] << 16); g2[2 * e + 1] = __uint_as_float(a2[e] & 0xffff0000u); g1[2 * e] = __uint_as_float(a1[e] << 16); g1[2 * e + 1] = __uint_as_float(a1[e] & 0xffff0000u);
                                          v2[2 * e] = __uint_as_float(b2[e] << 16); v2[2 * e + 1] = __uint_as_float(b2[e] & 0xffff0000u); v1[2 * e] = __uint_as_float(b1[e] << 16); v1[2 * e + 1] = __uint_as_float(b1[e] & 0xffff0000u); }
        }
#pragma unroll 4
        for (int i = 0; i < 16; ++i) {
            const v4u a0 = *(const GAS v4u*)(UB + (size_t)(r0 + i) * DUP + c0), b0 = *(const GAS v4u*)(UB + (size_t)(r0 + i) * DUP + DFF + c0);
            float g0[8], v0[8], o[8];
#pragma unroll
            for (int e = 0; e < 4; ++e) { g0[2 * e] = __uint_as_float(a0[e] << 16); g0[2 * e + 1] = __uint_as_float(a0[e] & 0xffff0000u); v0[2 * e] = __uint_as_float(b0[e] << 16); v0[2 * e + 1] = __uint_as_float(b0[e] & 0xffff0000u); }
#pragma unroll
            for (int e = 0; e < 8; ++e) { const float gg = bg[e] + wg[0][e] * g2[e] + wg[1][e] * g1[e] + wg[2][e] * g0[e]; const float vv = bv[e] + wv[0][e] * v2[e] + wv[1][e] * v1[e] + wv[2][e] * v0[e];
                o[e] = silu_f(gg) * vv; g2[e] = g1[e]; g1[e] = g0[e]; v2[e] = v1[e]; v1[e] = v0[e]; }
            v4u w; w.x = pk2(o[0], o[1]); w.y = pk2(o[2], o[3]); w.z = pk2(o[4], o[5]); w.w = pk2(o[6], o[7]);
            *(GAS v4u*)(AB + (size_t)(r0 + i) * DFF + c0) = w;
        }
    }
}

__device__ __forceinline__ void conv_fixup_phase(Frame& F, const float* cw, const float* cb) {
    const float* UB = (const float*)(F.ws + WS_UB); bf16* AB = (bf16*)(F.ws + WS_AB);
    const int gt = (F.vcu * NWAVES + F.wave) * 64 + F.lane, NT = F.G * NWAVES * 64;
    for (int it = gt; it < 64 * 2 * DFF; it += NT) { const int c = it % DFF, tr = it / DFF, pm = tr >> 1, r = tr & 1;
        if ((pm & 15) == 0) continue;
        float o[2];
#pragma unroll
        for (int hh = 0; hh < 2; ++hh) { const int cc = c + hh * DFF;
            const float um2 = UB[((size_t)(pm - 1) * 4 + 2) * DUP + cc], um1 = UB[((size_t)(pm - 1) * 4 + 3) * DUP + cc], u0 = UB[((size_t)pm * 4 + 0) * DUP + cc], u1 = UB[((size_t)pm * 4 + 1) * DUP + cc];
            const float a = r ? um1 : um2, b = r ? u0 : um1, d = r ? u1 : u0;
            o[hh] = cb[cc] + cw[cc] * a + cw[DUP + cc] * b + cw[2 * DUP + cc] * d; }
        AB[(size_t)(pm * 256 + r) * DFF + c] = (bf16)f2bf(silu_f(o[0]) * o[1]); }
}

__device__ __forceinline__ void zero_rows_f32(Frame& F, float* p) { const int gt = (F.vcu * NWAVES + F.wave) * 64 + F.lane; if (gt < MP) p[gt] = 0.f; }
typedef float f32x16 __attribute__((ext_vector_type(16)));
typedef short s16x4 __attribute__((ext_vector_type(4)));
typedef float f32x2_t __attribute__((ext_vector_type(2))); typedef __bf16 bf16x2_t __attribute__((ext_vector_type(2)));
__device__ __forceinline__ unsigned cvtpk(float lo, float hi) { f32x2_t v = {lo, hi}; bf16x2_t b = __builtin_convertvector(v, bf16x2_t); return __builtin_bit_cast(unsigned, b); }
__device__ __forceinline__ int crow(int r, int hi) { return (r & 3) + 8 * (r >> 2) + 4 * hi; }
__device__ __forceinline__ s16x4 ds_tr(const LAS unsigned char* p) { return __builtin_bit_cast(s16x4, __builtin_amdgcn_ds_read_tr16_b64_v4i16((LAS s16x4*)p)); }
__device__ __forceinline__ bf16x8 mk8(s16x4 lo, s16x4 hi) { return (bf16x8){lo[0], lo[1], lo[2], lo[3], hi[0], hi[1], hi[2], hi[3]}; }
__device__ __forceinline__ bf16x8 pack_step(const f32x16& x, int s) {
    v4u p; p.x = cvtpk(x[8 * s], x[8 * s + 1]); p.y = cvtpk(x[8 * s + 2], x[8 * s + 3]); p.z = cvtpk(x[8 * s + 4], x[8 * s + 5]); p.w = cvtpk(x[8 * s + 6], x[8 * s + 7]);
    return __builtin_bit_cast(bf16x8, p);
}
#define MFMA32(a, b, c) __builtin_amdgcn_mfma_f32_32x32x16_bf16((a), (b), (c), 0, 0, 0)
__device__ __forceinline__ float log2_gamma(int h) { return log2f(1.f - exp2f(-5.f - (float)h)); }

constexpr int AT_V0 = 49152, AT_V1 = 49152 + 24576 + 128, AT_OSC = 100352;
static_assert(AT_V1 + 24576 <= AT_OSC && AT_OSC + 7 * 4352 <= RING_BYTES && EXB_OFF + 4352 <= LDS_BYTES, "attention LDS map");
struct AttnIds { int g, b, h, r, np; };
__device__ __forceinline__ AttnIds attn_ids(int uid) { AttnIds a; a.g = uid >> 9; const int rem = uid & 511, bh = rem >> 4, rn = rem & 15, npc = 16 >> (2 * a.g); a.b = bh >> 3; a.h = bh & 7; a.r = rn / npc; a.np = rn % npc; return a; }
__device__ __forceinline__ void attn_fetch(Frame& F, const AttnIds& a, v4u (&kreg)[6], v4u (&vreg)[6]) {
    const bf16* ZB = (const bf16*)(F.ws + WS_ZB); const int dsh = 2 * a.g; const size_t brow = (size_t)a.b * SEQ;
#pragma unroll
    for (int i = 0; i < 6; ++i) { const int c = F.tid + 512 * i, key = c >> 3, ch = c & 7; int uk = 256 * a.np - 128 + key; uk = uk < 0 ? 0 : uk;
        const bf16* src = ZB + (brow + a.r + ((size_t)uk << dsh)) * DIN + a.h * 64 + ch * 8;
        kreg[i] = *(const GAS v4u*)(src + C_KA); vreg[i] = *(const GAS v4u*)(src + C_VA); }
}
__device__ __forceinline__ void attn_stage(Frame& F, const v4u (&kreg)[6], const v4u (&vreg)[6]) {
#pragma unroll
    for (int i = 0; i < 6; ++i) { const int c = F.tid + 512 * i, key = c >> 3, ch = c & 7;
        *(LAS v4u*)(F.lds + key * 128 + ((ch ^ ((key >> 1) & 7)) << 4)) = kreg[i];
        *(LAS v4u*)(F.lds + ((ch >> 2) ? AT_V1 : AT_V0) + key * 64 + ((ch & 3) << 4)) = vreg[i]; }
}
__device__ __forceinline__ void attn_compute(Frame& F, const AttnIds& a, const bf16x8 (&qf)[4]) {
    const int g = a.g, b = a.b, h = a.h, r = a.r, np = a.np;
    const int dsh = 2 * g;
    bf16* OG = (bf16*)(F.ws + WS_OG) + (size_t)g * MP * 512; float* LSE = (float*)(F.ws + WS_LSE) + (size_t)g * MP * 8;
    const int lane = F.lane, w = F.wave, r32 = lane & 31, hi = lane >> 5;
    LAS unsigned char* Kl = F.lds;
    const size_t brow = (size_t)b * SEQ;
    const size_t qrow = brow + r + ((size_t)(256 * np + 32 * w + r32) << dsh);
    f32x16 p[5];
#pragma unroll
    for (int kb = 0; kb < 5; ++kb) {
        f32x16 a = {};
        const int key = 32 * w + 32 * kb + r32;
#pragma unroll
        for (int d0 = 0; d0 < 4; ++d0) { const bf16x8 kf = *(const LAS bf16x8*)(Kl + key * 128 + (((2 * d0 + hi) ^ ((key >> 1) & 7)) << 4)); a = MFMA32(kf, qf[d0], a); }
        p[kb] = a;
    }
    float mx = -INFINITY;
#pragma unroll
    for (int kb = 0; kb < 5; ++kb) { const bool blk_dead = (np == 0) && (kb < 4 - w);
#pragma unroll
        for (int rg = 0; rg < 16; ++rg) { const int c = crow(rg, hi); bool ok = !blk_dead; if (kb == 0) ok = ok && (c >= r32); if (kb == 4) ok = ok && (c <= r32);
            const float v = ok ? p[kb][rg] : -INFINITY; p[kb][rg] = v; mx = fmaxf(mx, v); } }
    mx = fmaxf(mx, __shfl_xor(mx, 32));
    float l = 0.f;
#pragma unroll
    for (int kb = 0; kb < 5; ++kb)
#pragma unroll
        for (int rg = 0; rg < 16; ++rg) { const float e = __builtin_amdgcn_exp2f(p[kb][rg] - mx); p[kb][rg] = e; l += e; }
    l += __shfl_xor(l, 32);
    f32x16 o[2]; o[0] = (f32x16){}; o[1] = (f32x16){};
    const int gidx = lane >> 4, ql = (lane & 15) >> 2, pl = lane & 3;
    const int voff = (4 * hi + ql) * 64 + (16 * (gidx & 1) + 4 * pl) * 2;
#pragma unroll
    for (int kb = 0; kb < 5; ++kb)
#pragma unroll
        for (int s = 0; s < 2; ++s) { const bf16x8 pf = pack_step(p[kb], s);
#pragma unroll
            for (int dh = 0; dh < 2; ++dh) { const LAS unsigned char* vb = F.lds + (dh ? AT_V1 : AT_V0) + (32 * w + 32 * kb + 16 * s) * 64 + voff;
                const bf16x8 vf = mk8(ds_tr(vb), ds_tr(vb + 8 * 64)); o[dh] = MFMA32(vf, pf, o[dh]); } }
    const float inv = 1.f / l;
    LAS unsigned char* osc = F.lds + (w < 7 ? AT_OSC + w * 4352 : EXB_OFF);
#pragma unroll
    for (int dh = 0; dh < 2; ++dh)
#pragma unroll
        for (int t = 0; t < 4; ++t) { const int d = 32 * dh + 8 * t + 4 * hi;
            const unsigned lo = cvtpk(o[dh][4 * t] * inv, o[dh][4 * t + 1] * inv), hi2 = cvtpk(o[dh][4 * t + 2] * inv, o[dh][4 * t + 3] * inv);
            *(LAS unsigned long long*)(osc + r32 * 136 + d * 2) = (unsigned long long)lo | ((unsigned long long)hi2 << 32); }
    if (hi == 0) LSE[qrow * 8 + h] = mx + log2f(l);
    asm volatile("s_waitcnt lgkmcnt(0)" ::: "memory");
#pragma unroll
    for (int j = 0; j < 4; ++j) { const int rr = (lane >> 3) + 8 * j, ch = lane & 7;
        const LAS unsigned long long* s8 = (const LAS unsigned long long*)(osc + rr * 136 + ch * 16);
        v4u val; { const unsigned long long x0 = s8[0], x1 = s8[1]; val.x = (unsigned)x0; val.y = (unsigned)(x0 >> 32); val.z = (unsigned)x1; val.w = (unsigned)(x1 >> 32); }
        const size_t qr = brow + r + ((size_t)(256 * np + 32 * w + rr) << dsh);
        *(GAS v4u*)(OG + qr * 512 + h * 64 + ch * 8) = val; }
}
__device__ __forceinline__ void attn_qfetch(Frame& F, const AttnIds& a, bf16x8 (&qf)[4]) {
    const bf16* ZB = (const bf16*)(F.ws + WS_ZB); const int r32 = F.lane & 31, hi = F.lane >> 5;
    const size_t qrow = (size_t)a.b * SEQ + a.r + ((size_t)(256 * a.np + 32 * F.wave + r32) << (2 * a.g));
#pragma unroll
    for (int d0 = 0; d0 < 4; ++d0) qf[d0] = *(const GAS bf16x8*)(ZB + qrow * DIN + C_QA + a.h * 64 + d0 * 16 + hi * 8);
}
__device__ __forceinline__ void attn_prompt_units(Frame& F) {
    const int per = (1536 + F.G - 1) / F.G, u0 = F.vcu * per, u1 = (u0 + per < 1536) ? u0 + per : 1536;
    if (u0 >= u1) return;
    v4u kreg[6], vreg[6]; bf16x8 qn[4];
    attn_fetch(F, attn_ids(u0), kreg, vreg); attn_qfetch(F, attn_ids(u0), qn);
#pragma unroll 1
    for (int uid = u0; uid < u1; ++uid) {
        const AttnIds a = attn_ids(uid);
        bf16x8 qf[4];
#pragma unroll
        for (int d0 = 0; d0 < 4; ++d0) qf[d0] = qn[d0];
        attn_stage(F, kreg, vreg);
        __syncthreads();
        if (uid + 1 < u1) { attn_fetch(F, attn_ids(uid + 1), kreg, vreg); attn_qfetch(F, attn_ids(uid + 1), qn); }
        attn_compute(F, a, qf);
        __syncthreads();
    }
}
__device__ __forceinline__ void combine_prompt(Frame& F) {
    const bf16* OG = (const bf16*)(F.ws + WS_OG); const float* LSE = (const float*)(F.ws + WS_LSE); bf16* CATB = (bf16*)(F.ws + WS_CATB);
    const int gt = (F.vcu * NWAVES + F.wave) * 64 + F.lane, NT = F.G * NWAVES * 64;
    for (int it0 = gt; it0 < MP * 64; it0 += 4 * NT) {
        float l0[4], l1[4], l2[4]; v4u a[4], b[4], c[4];
#pragma unroll
        for (int q = 0; q < 4; ++q) { const int it = it0 + q * NT; const int row = (it < MP * 64 ? it : gt) >> 6, hc = it & 63, h = hc >> 3;
            l0[q] = *(const GAS float*)(LSE + (size_t)row * 8 + h); l1[q] = *(const GAS float*)(LSE + ((size_t)MP + row) * 8 + h); l2[q] = *(const GAS float*)(LSE + ((size_t)2 * MP + row) * 8 + h);
            a[q] = *(const GAS v4u*)(OG + (size_t)row * 512 + hc * 8); b[q] = *(const GAS v4u*)(OG + ((size_t)MP + row) * 512 + hc * 8); c[q] = *(const GAS v4u*)(OG + ((size_t)2 * MP + row) * 512 + hc * 8); }
        __builtin_amdgcn_sched_barrier(0);
#pragma unroll
        for (int q = 0; q < 4; ++q) { const int it = it0 + q * NT; if (it >= MP * 64) break; const int row = it >> 6, hc = it & 63;
            const float m = fmaxf(l0[q], fmaxf(l1[q], l2[q])); float w0 = __builtin_amdgcn_exp2f(l0[q] - m), w1 = __builtin_amdgcn_exp2f(l1[q] - m), w2 = __builtin_amdgcn_exp2f(l2[q] - m); const float inv = 1.f / (w0 + w1 + w2); w0 *= inv; w1 *= inv; w2 *= inv;
            v4u o;
#pragma unroll
            for (int e = 0; e < 4; ++e) { const float x0 = w0 * __uint_as_float(a[q][e] << 16) + w1 * __uint_as_float(b[q][e] << 16) + w2 * __uint_as_float(c[q][e] << 16);
                const float x1 = w0 * __uint_as_float(a[q][e] & 0xffff0000u) + w1 * __uint_as_float(b[q][e] & 0xffff0000u) + w2 * __uint_as_float(c[q][e] & 0xffff0000u); o[e] = cvtpk(x0, x1); }
            *(GAS v4u*)(CATB + (size_t)row * DM + 512 + hc * 8) = o; }
    }
}
__device__ __forceinline__ void ret_upd_unit(Frame& F, int bh, int n) {
    const bf16* ZB = (const bf16*)(F.ws + WS_ZB); float* UPD = (float*)(F.ws + WS_UPD) + ((size_t)bh * 32 + n) * 16384;
    const int tid = F.tid, lane = F.lane, w = F.wave, r32 = lane & 31, hi = lane >> 5;
    const int b = bh >> 2, h = bh & 3; const size_t row0 = (size_t)b * SEQ + 128 * n; const float lg = log2_gamma(h);
    {
        v4u kreg[4], vreg[4];
#pragma unroll
        for (int i = 0; i < 4; ++i) { const int c = tid + 512 * i, tok = c >> 4, ch = c & 15; const bf16* src = ZB + (row0 + tok) * DIN + h * 128 + ch * 8;
            kreg[i] = *(const GAS v4u*)(src + C_KR); vreg[i] = *(const GAS v4u*)(src + C_VR); }
#pragma unroll
        for (int i = 0; i < 4; ++i) { const int c = tid + 512 * i, tok = c >> 4, ch = c & 15; const float dec = exp2f((float)(127 - tok) * lg);
            v4u kk;
#pragma unroll
            for (int e = 0; e < 4; ++e) kk[e] = cvtpk(__uint_as_float(kreg[i][e] << 16) * dec, __uint_as_float(kreg[i][e] & 0xffff0000u) * dec);
            const int dst = (ch >> 2) * 8192 + tok * 64 + ((ch & 3) << 4);
            *(LAS v4u*)(F.lds + dst) = kk; *(LAS v4u*)(F.lds + 32768 + dst) = vreg[i]; }
    }
    __syncthreads();
    const int eb = w >> 1, db0 = 2 * (w & 1);
    const int gidx = lane >> 4, ql = (lane & 15) >> 2, pl = lane & 3;
    const int toff = (4 * hi + ql) * 64 + (16 * (gidx & 1) + 4 * pl) * 2;
    f32x16 acc[2]; acc[0] = (f32x16){}; acc[1] = (f32x16){};
#pragma unroll
    for (int s = 0; s < 8; ++s) { const LAS unsigned char* vb = F.lds + 32768 + eb * 8192 + (16 * s) * 64 + toff; const bf16x8 vf = mk8(ds_tr(vb), ds_tr(vb + 8 * 64));
#pragma unroll
        for (int q = 0; q < 2; ++q) { const LAS unsigned char* kb = F.lds + (db0 + q) * 8192 + (16 * s) * 64 + toff; const bf16x8 kf = mk8(ds_tr(kb), ds_tr(kb + 8 * 64)); acc[q] = MFMA32(vf, kf, acc[q]); } }
#pragma unroll
    for (int q = 0; q < 2; ++q)
#pragma unroll
        for (int rg = 0; rg < 16; ++rg) UPD[(size_t)(32 * eb + crow(rg, hi)) * 128 + 32 * (db0 + q) + r32] = acc[q][rg];
    __syncthreads();
}
__device__ __forceinline__ void ret_scan(Frame& F, float* pret) {
    const float* UPD = (const float*)(F.ws + WS_UPD); bf16* ST = (bf16*)(F.ws + WS_ST);
    const int gt = (F.vcu * NWAVES + F.wave) * 64 + F.lane, NT = F.G * NWAVES * 64;
    for (int it = gt; it < 16 * 16384; it += NT) { const int bh = it >> 14, ed = it & 16383, e = ed >> 7, d = ed & 127;
        const float cd = exp2f(128.f * log2_gamma(bh & 3));
        float u[32];
#pragma unroll
        for (int n = 0; n < 32; ++n) u[n] = UPD[((size_t)bh * 32 + n) * 16384 + ed];
        float S = 0.f;
#pragma unroll
        for (int n = 0; n < 32; ++n) { ST[((size_t)bh * 32 + n) * 16384 + ed] = (bf16)f2bf(S); S = cd * S + u[n]; }
        pret[(size_t)bh * 16384 + d * 128 + e] = S; }
}
__device__ __forceinline__ void ret_out_pair(Frame& F, int upair, const float* gnw) {
    const bf16* ZB = (const bf16*)(F.ws + WS_ZB); bf16* CATB = (bf16*)(F.ws + WS_CATB);
    const int tid = F.tid, lane = F.lane, w = F.wave, r32 = lane & 31, hi = lane >> 5, qd = w >> 2, wq = w & 3, tq = tid & 255;
    const int unit = 2 * upair + qd, bh = unit >> 5, n = unit & 31, b = bh >> 2, h = bh & 3;
    const size_t row0 = (size_t)b * SEQ + 128 * n; const float lg = log2_gamma(h);
    const bf16* STu = (const bf16*)(F.ws + WS_ST) + ((size_t)bh * 32 + n) * 16384;
    LAS unsigned char* Vl = F.lds + qd * 32768;
    {
        v4u vreg[8];
#pragma unroll
        for (int i = 0; i < 8; ++i) { const int c = tq + 256 * i, tok = c >> 4, ch = c & 15; vreg[i] = *(const GAS v4u*)(ZB + (row0 + tok) * DIN + C_VR + h * 128 + ch * 8); }
#pragma unroll
        for (int i = 0; i < 8; ++i) { const int c = tq + 256 * i, tok = c >> 4, ch = c & 15; *(LAS v4u*)(Vl + (ch >> 2) * 8192 + tok * 64 + ((ch & 3) << 4)) = vreg[i]; }
    }
    const int iq = 32 * wq + r32; const size_t qrow = row0 + iq;
    bf16x8 qf[8];
#pragma unroll
    for (int ks = 0; ks < 8; ++ks) qf[ks] = *(const GAS bf16x8*)(ZB + qrow * DIN + C_QR + h * 128 + ks * 16 + hi * 8);
    __syncthreads();
    f32x16 acc[4];
#pragma unroll
    for (int eb = 0; eb < 4; ++eb) { f32x16 a = {};
        bf16x8 sf[8];
#pragma unroll
        for (int ks = 0; ks < 8; ++ks) sf[ks] = *(const GAS bf16x8*)(STu + (size_t)(32 * eb + r32) * 128 + ks * 16 + hi * 8);
        __builtin_amdgcn_sched_barrier(0);
#pragma unroll
        for (int ks = 0; ks < 8; ++ks) a = MFMA32(sf[ks], qf[ks], a);
        acc[eb] = a; __builtin_amdgcn_sched_barrier(0); }
    { const float cdec = exp2f((float)(iq + 1) * lg);
#pragma unroll
        for (int eb = 0; eb < 4; ++eb)
#pragma unroll
            for (int rg = 0; rg < 16; ++rg) acc[eb][rg] *= cdec; }
    const int gidx = lane >> 4, ql = (lane & 15) >> 2, pl = lane & 3;
    const int toff = (4 * hi + ql) * 64 + (16 * (gidx & 1) + 4 * pl) * 2;
#pragma unroll 1
    for (int kb = 0; kb <= wq; ++kb) {
        {
            f32x16 p = {};
            bf16x8 kfr[8];
#pragma unroll
            for (int ks = 0; ks < 8; ++ks) kfr[ks] = *(const GAS bf16x8*)(ZB + (row0 + 32 * kb + r32) * DIN + C_KR + h * 128 + ks * 16 + hi * 8);
            __builtin_amdgcn_sched_barrier(0);
#pragma unroll
            for (int ks = 0; ks < 8; ++ks) p = MFMA32(kfr[ks], qf[ks], p);
#pragma unroll
            for (int rg = 0; rg < 16; ++rg) { const int j = 32 * kb + crow(rg, hi); p[rg] = (j <= iq) ? p[rg] * __builtin_amdgcn_exp2f((float)(iq - j) * lg) : 0.f; }
#pragma unroll
            for (int s = 0; s < 2; ++s) { const bf16x8 pf = pack_step(p, s);
#pragma unroll
                for (int eb = 0; eb < 4; ++eb) { const LAS unsigned char* vb = Vl + eb * 8192 + (32 * kb + 16 * s) * 64 + toff; const bf16x8 vf = mk8(ds_tr(vb), ds_tr(vb + 8 * 64)); acc[eb] = MFMA32(vf, pf, acc[eb]); } }
        }
    }
    float s1 = 0.f;
#pragma unroll
    for (int eb = 0; eb < 4; ++eb)
#pragma unroll
        for (int rg = 0; rg < 16; ++rg) s1 += acc[eb][rg];
    s1 += __shfl_xor(s1, 32); const float mu = s1 * (1.f / 128.f);
    float s2 = 0.f;
#pragma unroll
    for (int eb = 0; eb < 4; ++eb)
#pragma unroll
        for (int rg = 0; rg < 16; ++rg) { const float dlt = acc[eb][rg] - mu; s2 += dlt * dlt; }
    s2 += __shfl_xor(s2, 32); const float rstd = 1.f / sqrtf(s2 * (1.f / 128.f) + EPS);
#pragma unroll
    for (int eb = 0; eb < 4; ++eb)
#pragma unroll
        for (int t = 0; t < 4; ++t) { const int e = 32 * eb + 8 * t + 4 * hi;
            const unsigned long long gg = *(const GAS unsigned long long*)(ZB + qrow * DIN + C_GR + h * 128 + e);
            const f32x4 gw = *(const GAS f32x4*)(gnw + h * 128 + e);
            float gv[4] = {__uint_as_float((unsigned)gg << 16), __uint_as_float((unsigned)gg & 0xffff0000u), __uint_as_float((unsigned)(gg >> 32) << 16), __uint_as_float((unsigned)(gg >> 32) & 0xffff0000u)};
            float y[4];
#pragma unroll
            for (int k = 0; k < 4; ++k) y[k] = silu_f(gv[k]) * ((acc[eb][4 * t + k] - mu) * rstd * gw[k]);
            *(GAS unsigned long long*)(CATB + qrow * DM + h * 128 + e) = (unsigned long long)cvtpk(y[0], y[1]) | ((unsigned long long)cvtpk(y[2], y[3]) << 32); }
    __syncthreads();
}
#define MFMA16(a, b, c) __builtin_amdgcn_mfma_f32_16x16x32_bf16((a), (b), (c), 0, 0, 0)
template <int KW, class Pre> __device__ __forceinline__ f32x4 smp_task_core(Frame& F, const bf16* A, const bf16* Bt, int K, int wrow, Pre&& pre) {
#if defined(DBG_NAIVE_CORE)
    { const int lane = F.lane, fr = lane & 15, fq = lane >> 4, row = 16 * F.wave + fr; f32x4 s;
      for (int i = 0; i < 4; ++i) { const int wr_i = __shfl(wrow, 4 * fq + i); float a = 0.f;
          for (int k = 0; k < K; ++k) a += __uint_as_float((unsigned)A[(size_t)row * K + k] << 16) * __uint_as_float((unsigned)Bt[(size_t)wr_i * K + k] << 16);
          s[i] = a; }
      __syncthreads(); return s; }
#endif
    const int lane = F.lane, w = F.wave, fr = lane & 15, fq = lane >> 4;
    const bf16* ap = A + (size_t)fr * K + w * KW + 8 * fq; const bf16* bp = Bt + (size_t)wrow * K + w * KW + 8 * fq;
    f32x4 acc[8];
#pragma unroll
    for (int mb = 0; mb < 8; ++mb) acc[mb] = (f32x4){0.f, 0.f, 0.f, 0.f};
    static_assert(KW % 32 == 0 && KW / 32 <= 4, "K slice");
    constexpr int NS = KW / 32;
    bf16x8 bf[NS], af[NS][8];
#pragma unroll
    for (int q = 0; q < NS; ++q) { bf[q] = *(const GAS bf16x8*)(bp + q * 32);
#pragma unroll
        for (int mb = 0; mb < 8; ++mb) af[q][mb] = *(const GAS bf16x8*)(ap + (size_t)(16 * mb) * K + q * 32); }
    __builtin_amdgcn_sched_barrier(0);
#pragma unroll
    for (int q = 0; q < NS; ++q)
#pragma unroll
        for (int mb = 0; mb < 8; ++mb) acc[mb] = MFMA16(bf[q], af[q][mb], acc[mb]);
    __builtin_amdgcn_sched_barrier(0);
    pre();
    __builtin_amdgcn_sched_barrier(0);
    LAS f32x4* red = (LAS f32x4*)F.lds;
#pragma unroll
    for (int mb = 0; mb < 8; ++mb) red[(w * 8 + mb) * 64 + lane] = acc[mb];
    __syncthreads();
    f32x4 s = red[(0 * 8 + w) * 64 + lane];
#pragma unroll
    for (int ww = 1; ww < 8; ++ww) s += red[(ww * 8 + w) * 64 + lane];
    return s;
}
struct SmpSS { f32x4 a, b, c, d; };
__device__ __forceinline__ SmpSS smp_rstd_issue(Frame& F) {
    const float* SSs = (const float*)(F.ws + WS_SMP + SM_SS); const int fr = F.lane & 15, fq = F.lane >> 4, row = 16 * F.wave + fr;
    const GAS f32x4* p = (const GAS f32x4*)(SSs + (size_t)row * 64 + 16 * fq); SmpSS r; r.a = p[0]; r.b = p[1]; r.c = p[2]; r.d = p[3]; return r;
}
__device__ __forceinline__ float smp_rstd_finish(const SmpSS& q) {
    const f32x4 a = q.a, b = q.b, c = q.c, d = q.d;
    float s = (((a[0] + a[1]) + (a[2] + a[3])) + ((b[0] + b[1]) + (b[2] + b[3]))) + (((c[0] + c[1]) + (c[2] + c[3])) + ((d[0] + d[1]) + (d[2] + d[3])));
    s += __shfl_xor(s, 16); s += __shfl_xor(s, 32); return 1.f / sqrtf(s * (1.f / DM) + EPS);
}
__device__ __forceinline__ float smp_rstd(Frame& F) { return smp_rstd_finish(smp_rstd_issue(F)); }

__device__ __forceinline__ void smp_load_a(Frame& F, const bf16* A, bf16x8 (&af)[4][8]) {
    const int fr = F.lane & 15, fq = F.lane >> 4; const bf16* ap = A + (size_t)fr * DM + F.wave * 128 + 8 * fq;
#pragma unroll
    for (int q = 0; q < 4; ++q)
#pragma unroll
        for (int mb = 0; mb < 8; ++mb) af[q][mb] = *(const GAS bf16x8*)(ap + (size_t)(16 * mb) * DM + q * 32);
}
__device__ __forceinline__ void smp_load_b(Frame& F, const bf16* Bt, int wrow, bf16x8 (&bf)[4]) {
    const int fq = F.lane >> 4; const bf16* bp = Bt + (size_t)wrow * DM + F.wave * 128 + 8 * fq;
#pragma unroll
    for (int q = 0; q < 4; ++q) bf[q] = *(const GAS bf16x8*)(bp + q * 32);
}
template <class Pre> __device__ __forceinline__ f32x4 smp_mma_reduce(Frame& F, const bf16x8 (&af)[4][8], const bf16x8 (&bf)[4], Pre&& pre) {
    const int lane = F.lane, w = F.wave;
    f32x4 acc[8];
#pragma unroll
    for (int mb = 0; mb < 8; ++mb) acc[mb] = (f32x4){0.f, 0.f, 0.f, 0.f};
#pragma unroll
    for (int q = 0; q < 4; ++q)
#pragma unroll
        for (int mb = 0; mb < 8; ++mb) acc[mb] = MFMA16(bf[q], af[q][mb], acc[mb]);
    __builtin_amdgcn_sched_barrier(0);
    pre();
    __builtin_amdgcn_sched_barrier(0);
    LAS f32x4* red = (LAS f32x4*)F.lds;
#pragma unroll
    for (int mb = 0; mb < 8; ++mb) red[(w * 8 + mb) * 64 + lane] = acc[mb];
    __syncthreads();
    f32x4 s = red[(0 * 8 + w) * 64 + lane];
#pragma unroll
    for (int ww = 1; ww < 8; ++ww) s += red[(ww * 8 + w) * 64 + lane];
    return s;
}

#if defined(DBG_RSTD_DIRECT)
#define smp_rstd smp_rstd_direct
__device__ __forceinline__ float smp_rstd_direct(Frame& F) {
    const float* XSf = (const float*)(F.ws + WS_SMP + SM_X); const int fr = F.lane & 15, fq = F.lane >> 4, row = 16 * F.wave + fr;
    const GAS f32x4* p = (const GAS f32x4*)(XSf + (size_t)row * DM + 256 * fq); float s = 0.f;
    for (int i = 0; i < 64; ++i) { const f32x4 a = p[i]; s += (a[0] * a[0] + a[1] * a[1]) + (a[2] * a[2] + a[3] * a[3]); }
    s += __shfl_xor(s, 16); s += __shfl_xor(s, 32); return 1.f / sqrtf(s * (1.f / DM) + EPS);
}
#endif
__device__ __forceinline__ int smp_pair_wrow(int task, int fr) { const int pn = task >> 4, j0 = (task & 15) * 8; return pn * 256 + (fr < 8 ? j0 + fr : 128 + j0 + (fr - 8)); }
__device__ __forceinline__ void sample_win_tasks(Frame& F, int task0, int tstep, const bf16* Wl, float* swk, float* swv) {
    if (task0 >= 224) return;
    const bf16* XSB = (const bf16*)(F.ws + WS_SMP + SM_HB); bf16* ZS = (bf16*)(F.ws + WS_SMP + SM_ZB);
    const float* T64 = (const float*)(F.ws + WS_T64); const float* T32 = (const float*)(F.ws + WS_T32);
    const int lane = F.lane, fr = lane & 15, fq = lane >> 4;
    bf16x8 af[4][8], bf[4];
    smp_load_a(F, XSB, af); smp_load_b(F, Wl, smp_pair_wrow(task0, fr), bf);
#pragma unroll 1
    for (int task = task0; task < 224; task += tstep) {
        const bool more = task + tstep < 224; bf16x8 bn[4];
        if (more) smp_load_b(F, Wl, smp_pair_wrow(task + tstep, fr), bn);
        const int pn = task >> 4, j0 = (task & 15) * 8;
        const int bj = fq >> 1, j = j0 + 4 * (fq & 1);
        const bool rot = (pn < 4) || (pn >= 8 && pn < 12);
        int feat; const float* T = T64; int tstride = 64, fidx = 0; float sc = 1.f;
        if (pn < 4) { feat = (pn >> 1) * 512 + (2 * (pn & 1) + (j >> 6)) * 128 + (j & 63) + 64 * bj; fidx = j & 63; sc = (pn >= 2) ? pg8::KR_SCALE : 1.f; }
        else if (pn >= 8 && pn < 12) { feat = 2048 + ((pn - 8) >> 1) * 512 + (4 * (pn & 1) + (j >> 5)) * 64 + (j & 31) + 32 * bj; fidx = j & 31; T = T32; tstride = 32; sc = (pn < 10) ? pg8::QA_SCALE : 1.f; }
        else feat = pn * 256 + 128 * bj + j;
        const int row = 16 * F.wave + fr;
        SmpSS ssq; f32x4 cs0, cs1;
        const float* tp = T + ((size_t)(SEQ + (row & 3)) * tstride + fidx) * 2;
        f32x4 v = smp_mma_reduce(F, af, bf, [&]() { ssq = smp_rstd_issue(F); cs0 = *(const GAS f32x4*)tp; cs1 = *(const GAS f32x4*)(tp + 4); });
        v *= smp_rstd_finish(ssq);
        f32x4 pr; pr[0] = __shfl_xor(v[0], 32); pr[1] = __shfl_xor(v[1], 32); pr[2] = __shfl_xor(v[2], 32); pr[3] = __shfl_xor(v[3], 32);
        if (rot) {
            const float c[4] = {cs0[0], cs0[2], cs1[0], cs1[2]}, s[4] = {cs0[1], cs0[3], cs1[1], cs1[3]};
#pragma unroll
            for (int i = 0; i < 4; ++i) v[i] = (bj == 0 ? (v[i] * c[i] - pr[i] * s[i]) : (v[i] * c[i] + pr[i] * s[i])) * sc; }
        *(GAS unsigned long long*)(ZS + (size_t)row * DIN + feat) = (unsigned long long)cvtpk(v[0], v[1]) | ((unsigned long long)cvtpk(v[2], v[3]) << 32);
        if (pn == 10 || pn == 11) *(GAS f32x4*)(swk + (size_t)row * 512 + (feat - C_KA)) = v;
        if (pn >= 12) *(GAS f32x4*)(swv + (size_t)row * 512 + (feat - C_VA)) = v;
        __syncthreads();
        if (more) {
#pragma unroll
            for (int q = 0; q < 4; ++q) bf[q] = bn[q]; }
    }
}
template <int KW> __device__ __forceinline__ void sample_resid_task(Frame& F, const bf16* A, const bf16* Bt, int K, int task) {
    float* XS = (float*)(F.ws + WS_SMP + SM_X); bf16* XSB = (bf16*)(F.ws + WS_SMP + SM_HB); float* SSs = (float*)(F.ws + WS_SMP + SM_SS);
    const int lane = F.lane, w = F.wave, fr = lane & 15, fq = lane >> 4, cg = task >> 2, rq = task & 3;
    constexpr int NS = KW / 32;
    const bf16* ap = A + (size_t)(32 * rq + fr) * K + w * KW + 8 * fq; const bf16* bp = Bt + (size_t)(16 * cg + fr) * K + w * KW + 8 * fq;
    bf16x8 bf[NS], a0[NS], a1[NS];
#pragma unroll
    for (int s = 0; s < NS; ++s) { bf[s] = *(const GAS bf16x8*)(bp + s * 32); a0[s] = *(const GAS bf16x8*)(ap + s * 32); a1[s] = *(const GAS bf16x8*)(ap + (size_t)16 * K + s * 32); }
    __builtin_amdgcn_sched_barrier(0);
    f32x4 acc0 = {0.f, 0.f, 0.f, 0.f}, acc1 = acc0;
#pragma unroll
    for (int s = 0; s < NS; ++s) { acc0 = MFMA16(bf[s], a0[s], acc0); acc1 = MFMA16(bf[s], a1[s], acc1); }
    LAS f32x4* red = (LAS f32x4*)F.lds;
    red[(w * 2 + 0) * 64 + lane] = acc0; red[(w * 2 + 1) * 64 + lane] = acc1;
    __syncthreads();
    if (w < 2) {
        f32x4 d = red[(0 * 2 + w) * 64 + lane];
#pragma unroll
        for (int ww = 1; ww < 8; ++ww) d += red[(ww * 2 + w) * 64 + lane];
        const int row = 32 * rq + 16 * w + fr;
        float* xp = XS + (size_t)row * DM + 16 * cg + 4 * fq;
        const f32x4 x = *(const GAS f32x4*)xp + d;
        *(GAS f32x4*)xp = x;
        *(GAS unsigned long long*)(XSB + (size_t)row * DM + 16 * cg + 4 * fq) = (unsigned long long)cvtpk(x[0], x[1]) | ((unsigned long long)cvtpk(x[2], x[3]) << 32);
        float s = (x[0] * x[0] + x[1] * x[1]) + (x[2] * x[2] + x[3] * x[3]); s += __shfl_xor(s, 16); s += __shfl_xor(s, 32);
        if (fq == 0) SSs[(size_t)row * 64 + cg] = s;
    }
    __syncthreads();
}

#if defined(DBG_NAIVE_RESID)
__device__ __forceinline__ void sample_resid_naive(Frame& F, const bf16* A, const bf16* Bt, int K) {
    float* XSf = (float*)(F.ws + WS_SMP + SM_X); bf16* XSB = (bf16*)(F.ws + WS_SMP + SM_HB);
    const int gt = (F.vcu * NWAVES + F.wave) * 64 + F.lane, NT = F.G * NWAVES * 64;
    for (int it = gt; it < MS * DM; it += NT) { const int row = it / DM, col = it % DM; float s = 0.f;
        for (int k = 0; k < K; ++k) s += __uint_as_float((unsigned)A[(size_t)row * K + k] << 16) * __uint_as_float((unsigned)Bt[(size_t)col * K + k] << 16);
        const float x = XSf[it] + s; XSf[it] = x; XSB[it] = (bf16)f2bf(x); }
}
#endif
__device__ __forceinline__ void sample_up_tasks(Frame& F, int task0, int tstep, const bf16* Wl, const float* sconv_in, const float* cw, const float* cb, float* sconv_out) {
    if (task0 >= 352) return;
    const bf16* XSB = (const bf16*)(F.ws + WS_SMP + SM_HB); bf16* AS = (bf16*)(F.ws + WS_SMP + SM_AB);
    const int lane = F.lane, fr = lane & 15, fq = lane >> 4;
    bf16x8 af[4][8], bf[4];
    smp_load_a(F, XSB, af); smp_load_b(F, Wl, smp_pair_wrow(task0, fr), bf);
#pragma unroll 1
    for (int task = task0; task < 352; task += tstep) {
        const bool more = task + tstep < 352; bf16x8 bn[4];
        if (more) smp_load_b(F, Wl, smp_pair_wrow(task + tstep, fr), bn);
        const int pn = task >> 4, j0 = (task & 15) * 8;
        const int row = 16 * F.wave + fr, b = row >> 2, t = row & 3;
        const int feat = (fq >> 1) * DFF + 128 * pn + j0 + 4 * (fq & 1);
        SmpSS ssq; f32x4 c0, c1, w0, w1, w2, bb;
        const f32x4 u_raw = smp_mma_reduce(F, af, bf, [&]() { ssq = smp_rstd_issue(F);
            c0 = *(const GAS f32x4*)(sconv_in + ((size_t)b * 2 + 0) * DUP + feat); c1 = *(const GAS f32x4*)(sconv_in + ((size_t)b * 2 + 1) * DUP + feat);
            w0 = *(const GAS f32x4*)(cw + feat); w1 = *(const GAS f32x4*)(cw + DUP + feat); w2 = *(const GAS f32x4*)(cw + 2 * DUP + feat); bb = *(const GAS f32x4*)(cb + feat); });
        const f32x4 u = u_raw * smp_rstd_finish(ssq);
        f32x4 r;
#pragma unroll
        for (int i = 0; i < 4; ++i) { const float s1 = __shfl_up(u[i], 1, 16), s2 = __shfl_up(u[i], 2, 16);
            const float p1 = (t >= 1) ? s1 : c1[i], p2 = (t >= 2) ? s2 : (t == 1 ? c1[i] : c0[i]);
            r[i] = bb[i] + w0[i] * p2 + w1[i] * p1 + w2[i] * u[i]; }
        f32x4 pr; pr[0] = __shfl_xor(r[0], 32); pr[1] = __shfl_xor(r[1], 32); pr[2] = __shfl_xor(r[2], 32); pr[3] = __shfl_xor(r[3], 32);
        if (fq < 2) { const int c = 128 * pn + j0 + 4 * fq;
            *(GAS unsigned long long*)(AS + (size_t)row * DFF + c) = (unsigned long long)cvtpk(silu_f(r[0]) * pr[0], silu_f(r[1]) * pr[1]) | ((unsigned long long)cvtpk(silu_f(r[2]) * pr[2], silu_f(r[3]) * pr[3]) << 32); }
        if (t >= 2) *(GAS f32x4*)(sconv_out + ((size_t)b * 2 + (t - 2)) * DUP + feat) = u;
        __syncthreads();
        if (more) {
#pragma unroll
            for (int q = 0; q < 4; ++q) bf[q] = bn[q]; }
    }
}

__device__ __forceinline__ void sample_attn_unit(Frame& F, int b, int h, const float* ck, const float* cv) {
    const bf16* ZS = (const bf16*)(F.ws + WS_SMP + SM_ZB); bf16* CATS = (bf16*)(F.ws + WS_SMP + SM_CATB);
    LAS float* sc = (LAS float*)F.lds; LAS float* part = sc + 4 * 388; LAS float* ml = part + 8 * 64;
    const int lane = F.lane, w = F.wave, t = w & 3, hf = w >> 2, sub = lane >> 4, l16 = lane & 15;
    float q[4];
    { const unsigned long long qq = *(const GAS unsigned long long*)(ZS + (size_t)(b * 4 + t) * DIN + C_QA + h * 64 + 4 * l16);
      q[0] = __uint_as_float((unsigned)qq << 16); q[1] = __uint_as_float((unsigned)qq & 0xffff0000u); q[2] = __uint_as_float((unsigned)(qq >> 32) << 16); q[3] = __uint_as_float((unsigned)(qq >> 32) & 0xffff0000u); }
    const float* ckb = ck + ((size_t)b * WCTX * 8 + h) * 64 + 4 * l16; const float* cvb = cv + ((size_t)b * WCTX * 8 + h) * 64 + 4 * l16;
#pragma unroll 1
    for (int c0 = 0; c0 < 50; c0 += 25) {
        f32x4 kvv[25];
#pragma unroll
        for (int u = 0; u < 25; ++u) { const int k = 4 * (hf + 2 * (c0 + u)) + sub; const int kk = k < 387 ? k : 386;
            const int g = kk / 129, j = kk - 129 * g; const int idx = WCTX + t - (j << (2 * g)); const int ic = idx >= WCTX ? WCTX - 1 : idx;
            kvv[u] = *(const GAS f32x4*)(ckb + (size_t)ic * 512); }
        __builtin_amdgcn_sched_barrier(0);
#pragma unroll
        for (int u = 0; u < 25; ++u) { const int k = 4 * (hf + 2 * (c0 + u)) + sub; const bool valid = k < 387; const int kk = valid ? k : 386;
            const int g = kk / 129, j = kk - 129 * g; const int idx = WCTX + t - (j << (2 * g)); const bool isnew = idx >= WCTX;
            const f32x4 kv = kvv[u];
            float s = q[0] * kv[0] + q[1] * kv[1] + q[2] * kv[2] + q[3] * kv[3];
            s += __shfl_xor(s, 1); s += __shfl_xor(s, 2); s += __shfl_xor(s, 4); s += __shfl_xor(s, 8);
            if (l16 == 0 && valid && !isnew) sc[t * 388 + k] = s; }
        __builtin_amdgcn_sched_barrier(0);
    }
#define SMP_NEWPAIR(pi, kvar, rvar) const bool pv_ = (pi) < t + 3; const int kvar = (pi) <= t ? (pi) : ((pi) == t + 1 ? 129 : 258); const int rvar = (pi) <= t ? t - (pi) : t;
    if (hf == 0) {
#pragma unroll
        for (int i = 0; i < 2; ++i) { SMP_NEWPAIR(4 * i + sub, kn, rn)
            const unsigned long long x = *(const GAS unsigned long long*)(ZS + (size_t)(b * 4 + rn) * DIN + C_KA + h * 64 + 4 * l16);
            float s = q[0] * __uint_as_float((unsigned)x << 16) + q[1] * __uint_as_float((unsigned)x & 0xffff0000u) + q[2] * __uint_as_float((unsigned)(x >> 32) << 16) + q[3] * __uint_as_float((unsigned)(x >> 32) & 0xffff0000u);
            s += __shfl_xor(s, 1); s += __shfl_xor(s, 2); s += __shfl_xor(s, 4); s += __shfl_xor(s, 8);
            if (l16 == 0 && pv_) sc[t * 388 + kn] = s; }
    }
    __syncthreads();
    if (w < 4) {
        float m = -INFINITY;
        for (int k = lane; k < 387; k += 64) m = fmaxf(m, sc[t * 388 + k]);
#pragma unroll
        for (int o = 1; o < 64; o <<= 1) m = fmaxf(m, __shfl_xor(m, o));
        float l = 0.f;
        for (int k = lane; k < 387; k += 64) { const float e = exp2f(sc[t * 388 + k] - m); sc[t * 388 + k] = e; l += e; }
        l = wave_sum(l);
        if (lane == 0) { ml[t] = l; sc[t * 388 + 387] = 0.f; }
    }
    __syncthreads();
    float a4[4] = {0.f, 0.f, 0.f, 0.f};
#pragma unroll 1
    for (int c0 = 0; c0 < 50; c0 += 25) {
        f32x4 vvv[25];
#pragma unroll
        for (int u = 0; u < 25; ++u) { const int k = 4 * (hf + 2 * (c0 + u)) + sub; const int kk = k < 387 ? k : 386;
            const int g = kk / 129, j = kk - 129 * g; const int idx = WCTX + t - (j << (2 * g)); const int ic = idx >= WCTX ? WCTX - 1 : idx;
            vvv[u] = *(const GAS f32x4*)(cvb + (size_t)ic * 512); }
        __builtin_amdgcn_sched_barrier(0);
#pragma unroll
        for (int u = 0; u < 25; ++u) { const int k = 4 * (hf + 2 * (c0 + u)) + sub; const bool valid = k < 387; const int kk = valid ? k : 386;
            const int g = kk / 129, j = kk - 129 * g; const int idx = WCTX + t - (j << (2 * g)); const bool isnew = idx >= WCTX;
            const f32x4 vv = vvv[u];
            const float p = (valid && !isnew) ? sc[t * 388 + kk] : 0.f;
#pragma unroll
            for (int i = 0; i < 4; ++i) a4[i] += p * vv[i]; }
        __builtin_amdgcn_sched_barrier(0);
    }
    if (hf == 0) {
#pragma unroll
        for (int i = 0; i < 2; ++i) { SMP_NEWPAIR(4 * i + sub, kn, rn)
            const unsigned long long x = *(const GAS unsigned long long*)(ZS + (size_t)(b * 4 + rn) * DIN + C_VA + h * 64 + 4 * l16);
            const float p = pv_ ? sc[t * 388 + kn] : 0.f;
            a4[0] += p * __uint_as_float((unsigned)x << 16); a4[1] += p * __uint_as_float((unsigned)x & 0xffff0000u); a4[2] += p * __uint_as_float((unsigned)(x >> 32) << 16); a4[3] += p * __uint_as_float((unsigned)(x >> 32) & 0xffff0000u); }
    }
#undef SMP_NEWPAIR
#pragma unroll
    for (int i = 0; i < 4; ++i) { a4[i] += __shfl_xor(a4[i], 16); a4[i] += __shfl_xor(a4[i], 32); }
    if (lane < 16) { part[w * 64 + 4 * l16 + 0] = a4[0]; part[w * 64 + 4 * l16 + 1] = a4[1]; part[w * 64 + 4 * l16 + 2] = a4[2]; part[w * 64 + 4 * l16 + 3] = a4[3]; }
    __syncthreads();
    if (w < 4) { const float o = (part[w * 64 + lane] + part[(w + 4) * 64 + lane]) / ml[w];
        CATS[(size_t)(b * 4 + w) * DM + 512 + h * 64 + lane] = (bf16)f2bf(o); }
    __syncthreads();
}
__device__ __forceinline__ void sample_ret_unit(Frame& F, int b, int h, const float* s0, float* s1, const float* gnw) {
    const bf16* ZS = (const bf16*)(F.ws + WS_SMP + SM_ZB); bf16* CATS = (bf16*)(F.ws + WS_SMP + SM_CATB);
    LAS float* qs = (LAS float*)F.lds; LAS float* ks = qs + 512; LAS float* vs = ks + 512; LAS float* part = vs + 512; LAS float* ob = part + 512;
    const int tid = F.tid, lane = F.lane, w = F.wave, e = tid & 127, dq = tid >> 7;
    { const int tt = tid >> 7, dd = tid & 127; const bf16* zr = ZS + (size_t)(b * 4 + tt) * DIN + h * 128 + dd;
      qs[tid] = __uint_as_float((unsigned)zr[C_QR] << 16); ks[tid] = __uint_as_float((unsigned)zr[C_KR] << 16); vs[tid] = __uint_as_float((unsigned)zr[C_VR] << 16); }
    const size_t sbase = ((size_t)b * 4 + h) * 16384;
    float S[32];
#pragma unroll
    for (int d = 0; d < 32; ++d) S[d] = s0[sbase + (size_t)(32 * dq + d) * 128 + e];
    const float gam = 1.f - exp2f(-5.f - (float)h);
    __syncthreads();
#pragma unroll 1
    for (int t = 0; t < 4; ++t) {
        const float v = vs[t * 128 + e]; float po = 0.f;
#pragma unroll
        for (int d = 0; d < 32; ++d) { S[d] = gam * S[d] + ks[t * 128 + 32 * dq + d] * v; po += qs[t * 128 + 32 * dq + d] * S[d]; }
        part[dq * 128 + e] = po;
        __syncthreads();
        if (dq == 0) ob[t * 128 + e] = (part[e] + part[128 + e]) + (part[256 + e] + part[384 + e]);
        __syncthreads();
    }
#pragma unroll
    for (int d = 0; d < 32; ++d) s1[sbase + (size_t)(32 * dq + d) * 128 + e] = S[d];
    if (w < 4) { const int t = w; const float a = ob[t * 128 + lane], c = ob[t * 128 + 64 + lane];
        const float mu = wave_sum(a + c) * (1.f / 128.f); const float var = wave_sum((a - mu) * (a - mu) + (c - mu) * (c - mu)) * (1.f / 128.f); const float rstd = 1.f / sqrtf(var + EPS);
        const bf16* zr = ZS + (size_t)(b * 4 + t) * DIN + C_GR + h * 128;
        const float g0 = __uint_as_float((unsigned)zr[lane] << 16), g1 = __uint_as_float((unsigned)zr[64 + lane] << 16);
        CATS[(size_t)(b * 4 + t) * DM + h * 128 + lane] = (bf16)f2bf(silu_f(g0) * ((a - mu) * rstd * gnw[h * 128 + lane]));
        CATS[(size_t)(b * 4 + t) * DM + h * 128 + 64 + lane] = (bf16)f2bf(silu_f(g1) * ((c - mu) * rstd * gnw[h * 128 + 64 + lane])); }
    __syncthreads();
}
#if defined(__HIP_DEVICE_COMPILE__)
#define MK_ASSUME_GLOBAL(p) do { __builtin_assume(!__builtin_amdgcn_is_shared((const void*)(p))); __builtin_assume(!__builtin_amdgcn_is_private((const void*)(p))); } while (0)
#else
#define MK_ASSUME_GLOBAL(p) do { } while (0)
#endif
#define MK_REFRESH() do { int t_; asm volatile("v_mbcnt_lo_u32_b32 %0, -1, 0\n\tv_mbcnt_hi_u32_b32 %0, -1, %0" : "=v"(t_)); t_ += wave_s * 64;     F.tid = t_; F.lane = t_ & 63; F.wave = __builtin_amdgcn_readfirstlane(t_ >> 6); \
    GAS unsigned char* w_ = (GAS unsigned char*)args.ws; asm volatile("" : "+s"(w_)); F.ws = (unsigned char*)w_;     F.ctl = (gu32*)(w_ + WS_CTL); { GAS float* o_ = (GAS float*)args.out; asm volatile("" : "+s"(o_)); outp = (float*)o_; } \
    bx = blockIdx.x; asm volatile("" : "+s"(bx)); F.G = gridDim.x; F.vcu = (F.G % 8 == 0) ? (bx % 8) * (F.G / 8) + bx / 8 : bx; } while (0)
#define MK_FRAME_SETUP() \
    extern __shared__ __attribute__((aligned(16))) unsigned char lds[]; \
    Frame F; F.lds = (LAS unsigned char*)lds; F.MISC = (volatile LAS unsigned*)(F.lds + MISC_OFF); \
    F.tid = threadIdx.x; F.lane = F.tid & 63; F.wave = __builtin_amdgcn_readfirstlane(F.tid >> 6); \
    F.G = gridDim.x; { const int bx = blockIdx.x; F.vcu = (F.G % 8 == 0) ? (bx % 8) * (F.G / 8) + bx / 8 : bx; } \
    F.ws = args.ws; F.ctl = (gu32*)(args.ws + WS_CTL);

enum { I_XP = 0, I_XS = 1, I_CK = 2, I_CV = 3, I_SRET = 4, I_SCONV = 5, I_N1W = 6, I_WIN = 7, I_GNW = 8, I_WOUT = 9, I_N2W = 10, I_WUP = 11, I_CW = 12, I_CB = 13, I_WDN = 14, I_FNW = 15 };
constexpr size_t O_YP = 0, O_YS = O_YP + (size_t)MP * DM, O_PWK = O_YS + (size_t)MS * DM, O_PWV = O_PWK + (size_t)DEPTH * NBATCH * 2048 * 512,
                 O_PRET = O_PWV + (size_t)DEPTH * NBATCH * 2048 * 512, O_PCONV = O_PRET + (size_t)DEPTH * NBATCH * 4 * 16384, O_SWK = O_PCONV + (size_t)DEPTH * NBATCH * 2 * DUP,
                 O_SWV = O_SWK + (size_t)DEPTH * MS * 512, O_SRET = O_SWV + (size_t)DEPTH * MS * 512, O_SCONV = O_SRET + (size_t)DEPTH * DBATCH * 4 * 16384, O_END = O_SCONV + (size_t)DEPTH * DBATCH * 2 * DUP;


__global__ void __launch_bounds__(NWAVES * 64, 2) mk_fwd(Args args) {
    MK_FRAME_SETUP();
#define INP(i) ((const float*)(const GAS float*)args.in[i])
    float* outp = args.out; int bx = blockIdx.x; const int wave_s = __builtin_amdgcn_readfirstlane((int)threadIdx.x >> 6);
    for (int u = F.tid; u < (LDS_BYTES - LDSCTL_OFF) / 4; u += NWAVES * 64) ((LAS unsigned*)(F.lds + LDSCTL_OFF))[u] = 0u;
    __syncthreads();
    XcdBarrier bar = xcd_barrier_post((unsigned*)(F.ctl + CW_BAR), F.MISC + 8);
#define XRES ((float*)(F.ws + WS_XRES))
#define XS ((float*)(F.ws + WS_SMP + SM_X))
    p0_prologue(F, INP(I_WIN), INP(I_WOUT), INP(I_WUP), INP(I_WDN), INP(I_N1W), INP(I_N2W), INP(I_XP));
    { const int gw = F.vcu * NWAVES + F.wave, NGW = F.G * NWAVES;
      for (int r = NGW - 1 - gw; r < MS; r += NGW) { const GAS f32x4* xr = (const GAS f32x4*)(INP(I_XS) + (size_t)r * DM) + F.lane; GAS f32x4* xo = (GAS f32x4*)(XS + (size_t)r * DM) + F.lane;
          GAS unsigned long long* o8 = (GAS unsigned long long*)((bf16*)(F.ws + WS_SMP + SM_HB) + (size_t)r * DM) + F.lane; float s = 0.f;
#pragma unroll
          for (int j = 0; j < 4; ++j) { const f32x4 v = xr[64 * j]; xo[64 * j] = v; s += (v.x * v.x + v.y * v.y) + (v.z * v.z + v.w * v.w); o8[64 * j] = (unsigned long long)pk2(v.x, v.y) | ((unsigned long long)pk2(v.z, v.w) << 32); }
          s = wave_sum(s); ((float*)(F.ws + WS_SMP + SM_SS))[(size_t)r * 64 + F.lane] = (F.lane == 0) ? s : 0.f; } }
    MK_REFRESH(); xcd_barrier(bar, F.tid); MK_REFRESH();
    for (int l = 0; l < DEPTH; ++l) {
        {
            pg8::Gemm g{(const pg8::bf16_t*)(F.ws + WS_HB), (const pg8::bf16_t*)(F.ws + WS_WIN) + (size_t)l * DIN * DM, MP, DIN, DM}; pg8::StaticOrder S; S.init(MP, DIN, F.G, bx); S.wperm = true;
            pg8::EpiIn E{(pg8::bf16_t*)(F.ws + WS_ZB), (const float*)(F.ws + WS_T64), (const float*)(F.ws + WS_T32), outp + O_PWK + (size_t)l * NBATCH * 2048 * 512, outp + O_PWV + (size_t)l * NBATCH * 2048 * 512, (const float*)(F.ws + WS_SS1)};
            if (bx >= F.G / 2) sample_win_tasks(F, bx - F.G / 2, F.G - F.G / 2, (const bf16*)(F.ws + WS_WIN) + (size_t)l * DIN * DM, outp + O_SWK + (size_t)l * MS * 512, outp + O_SWV + (size_t)l * MS * 512);
            pg8::gemm_phase<pg8::EpiIn, pg8::StaticOrder, true, true>(F.lds + RING_OFF, g, S, E, F.tid);
        }
        MK_REFRESH(); xcd_barrier(bar, F.tid); MK_REFRESH();
        {
#define MK_SAMPLE_UNITS() do { \
                for (int u = F.G - 1 - F.vcu; u < 256; u += F.G) sample_attn_unit(F, u >> 3, u & 7, INP(I_CK) + (size_t)l * DBATCH * WCTX * 512, INP(I_CV) + (size_t)l * DBATCH * WCTX * 512); \
                for (int u = F.vcu; u < 128; u += F.G) sample_ret_unit(F, u >> 2, u & 3, INP(I_SRET) + (size_t)l * DBATCH * 4 * 16384, outp + O_SRET + (size_t)l * DBATCH * 4 * 16384, INP(I_GNW) + (size_t)l * 512); } while (0)
            if (F.vcu & 1) MK_SAMPLE_UNITS();
            attn_prompt_units(F);
            for (int u = F.vcu; u < 512; u += F.G) ret_upd_unit(F, u >> 5, u & 31);
            if (!(F.vcu & 1)) MK_SAMPLE_UNITS();
#undef MK_SAMPLE_UNITS
        }
        MK_REFRESH(); xcd_barrier(bar, F.tid); MK_REFRESH();
        ret_scan(F, outp + O_PRET + (size_t)l * NBATCH * 4 * 16384);
#if defined(DBG_NAIVE_RESID)
        sample_resid_naive(F, (const bf16*)(F.ws + WS_SMP + SM_CATB), (const bf16*)(F.ws + WS_WOUT) + (size_t)l * DM * DM, DM);
#else
        for (int task = bx; task < 256; task += F.G) sample_resid_task<128>(F, (const bf16*)(F.ws + WS_SMP + SM_CATB), (const bf16*)(F.ws + WS_WOUT) + (size_t)l * DM * DM, DM, task);
#endif
        MK_REFRESH(); xcd_barrier(bar, F.tid); MK_REFRESH();
        { for (int u = F.vcu; u < 256; u += F.G) ret_out_pair(F, u, INP(I_GNW) + (size_t)l * 512); combine_prompt(F); }
        MK_REFRESH(); xcd_barrier(bar, F.tid); MK_REFRESH();
        {
            pg8::Gemm g{(const pg8::bf16_t*)(F.ws + WS_CATB), (const pg8::bf16_t*)(F.ws + WS_WOUT) + (size_t)l * DM * DM, MP, DM, DM}; pg8::StaticOrder S; S.init(MP, DM, F.G, bx);
            pg8::EpiResidNorm E{(pg8::bf16_t*)(F.ws + WS_HB), (float*)(F.ws + WS_SS2)};
            pg8::gemm_phase<pg8::EpiResidNorm, pg8::StaticOrder, true, true>(F.lds + RING_OFF, g, S, E, F.tid);
        }
        MK_REFRESH(); xcd_barrier(bar, F.tid); MK_REFRESH();
        {
            pg8::Gemm g{(const pg8::bf16_t*)(F.ws + WS_HB), (const pg8::bf16_t*)(F.ws + WS_WUP) + (size_t)l * DUP * DM, MP, DUP, DM}; pg8::StaticOrder S; S.init(MP, DUP, F.G, bx);
            pg8::EpiUpConv E{(pg8::bf16_t*)(F.ws + WS_AB), (float*)(F.ws + WS_UB), outp + O_PCONV + (size_t)l * NBATCH * 2 * DUP, INP(I_CW) + (size_t)l * 3 * DUP, INP(I_CB) + (size_t)l * DUP, (PG8_LAS float*)(F.lds + EXB_OFF), (const float*)(F.ws + WS_SS2)};
            if (bx >= F.G / 2) sample_up_tasks(F, bx - F.G / 2, F.G - F.G / 2, (const bf16*)(F.ws + WS_WUP) + (size_t)l * DUP * DM, INP(I_SCONV) + (size_t)l * DBATCH * 2 * DUP, INP(I_CW) + (size_t)l * 3 * DUP, INP(I_CB) + (size_t)l * DUP, outp + O_SCONV + (size_t)l * DBATCH * 2 * DUP);
            pg8::gemm_phase<pg8::EpiUpConv, pg8::StaticOrder, true, true>(F.lds + RING_OFF, g, S, E, F.tid);
        }
        MK_REFRESH(); xcd_barrier(bar, F.tid); MK_REFRESH();
        {
            conv_fixup_phase(F, INP(I_CW) + (size_t)l * 3 * DUP, INP(I_CB) + (size_t)l * DUP);
#if defined(DBG_NAIVE_RESID)
            sample_resid_naive(F, (const bf16*)(F.ws + WS_SMP + SM_AB), (const bf16*)(F.ws + WS_WDN) + (size_t)l * DM * DFF, DFF);
#else
            for (int task = bx; task < 256; task += F.G) sample_resid_task<352>(F, (const bf16*)(F.ws + WS_SMP + SM_AB), (const bf16*)(F.ws + WS_WDN) + (size_t)l * DM * DFF, DFF, task);
#endif
        }
        MK_REFRESH(); xcd_barrier(bar, F.tid); MK_REFRESH();
        {
            pg8::Gemm g{(const pg8::bf16_t*)(F.ws + WS_AB), (const pg8::bf16_t*)(F.ws + WS_WDN) + (size_t)l * DM * DFF, MP, DM, DFF}; pg8::StaticOrder S; S.init(MP, DM, F.G, bx);
            pg8::EpiResidNorm E{(pg8::bf16_t*)(F.ws + WS_HB), (float*)(F.ws + WS_SS1)};
            pg8::gemm_phase<pg8::EpiResidNorm, pg8::StaticOrder, true, true>(F.lds + RING_OFF, g, S, E, F.tid);
        }
        MK_REFRESH(); xcd_barrier(bar, F.tid); MK_REFRESH();
    }
    final_norm_phase(F, (const bf16*)(F.ws + WS_HB), XS, INP(I_FNW), outp + O_YP, outp + O_YS);
}

extern "C" void kernel_launch(void* const* d_in, const int* in_sizes, int n_in, void* d_out, int out_size, void* d_ws, size_t ws_size, hipStream_t stream) {
    static int grid = 0;
    if (grid == 0) {
        if (n_in != 16 || (size_t)out_size != O_END || ws_size < WS_OPT_END) { fprintf(stderr, "kernel_launch: unexpected sizes (n_in %d out %d ws %zu)\n", n_in, out_size, ws_size); grid = -1; return; }
        int dev = 0, cus = 0, per_cu = 0;
        if (hipGetDevice(&dev) != hipSuccess || hipDeviceGetAttribute(&cus, hipDeviceAttributeMultiprocessorCount, dev) != hipSuccess) { grid = -1; return; }
        if (hipFuncSetAttribute((const void*)mk_fwd, hipFuncAttributeMaxDynamicSharedMemorySize, LDS_BYTES) != hipSuccess) { fprintf(stderr, "kernel_launch: hipFuncSetAttribute failed\n"); grid = -1; return; }
        if (hipOccupancyMaxActiveBlocksPerMultiprocessor(&per_cu, (const void*)mk_fwd, NWAVES * 64, LDS_BYTES) != hipSuccess || per_cu < 1) { fprintf(stderr, "kernel_launch: occupancy query says %d blocks per CU\n", per_cu); }
        (void)hipGetLastError();
        grid = cus;
    }
    if (grid < 0) return;
    if (hipMemsetAsync((char*)d_ws + WS_CTL, 0, CTL_ZERO_BYTES, stream) != hipSuccess) return;
    Args a{}; for (int i = 0; i < 16; ++i) a.in[i] = (const float*)d_in[i];
    a.out = (float*)d_out; a.ws = (unsigned char*)d_ws; a.layer = 0; a.pad = 0;
    hipLaunchKernelGGL(mk_fwd, dim3(grid), dim3(NWAVES * 64), LDS_BYTES, stream, a);
}
```

```cpp
#include <hip/hip_runtime.h>
#include <cstdio>
#include <cstdint>
#include <cmath>
namespace pg8 {
#define PG8_LAS __attribute__((address_space(3)))
typedef unsigned short bf16_t;
typedef short bf16x8 __attribute__((ext_vector_type(8)));
typedef float f32x4 __attribute__((ext_vector_type(4)));
typedef unsigned u32x4 __attribute__((ext_vector_type(4)));
constexpr int BM = 256, BK = 64, HALF = 128, HTB = HALF * BK * 2  , STAGE_BYTES = 8 * HTB, NXCD = 8, WGM = 8;

__host__ __device__ __forceinline__ int lds_byte(int r, int c) { const int st = (r >> 4) * 2 + (c >> 5), rr = r & 15, cc = c & 31, ob = rr * 64 + cc * 2; return st * 1024 + (ob ^ (((ob >> 9) & 1) << 5)); }
__host__ __device__ __forceinline__ void stage_rc(int b, int& R, int& C) { const int st = b / 1024, sb = b % 1024, swz = sb ^ (((sb >> 9) & 1) << 5); R = (st >> 1) * 16 + swz / 64; C = (st & 1) * 32 + (swz % 64) / 2; }
__host__ __device__ __forceinline__ int perm32(int rho) { const int n = rho >> 4, i = rho & 15; return 8 * (i >> 2) + 4 * n + (i & 3); }

struct Unit { int pm, pn; };
struct Gemm { const bf16_t* A; const bf16_t* Bt; int M, N, K; };

struct StaticOrder {
    int nM, nN, nwg, G, c; bool wperm = false;
    __host__ __device__ void init(int M, int N, int G_, int c_) { nM = M / BM; nN = N / BM; nwg = nM * nN; G = G_; c = c_; }
    __host__ __device__ bool next(int i, Unit& u) const {
        const long L = (long)i * G + c; if (L >= nwg) return false;
        int wgid = (int)L; { const int q = nwg / NXCD, r = nwg % NXCD, xcd = wgid % NXCD, off = wgid / NXCD; wgid = (xcd < r ? xcd * (q + 1) : r * (q + 1) + (xcd - r) * q) + off; }
        const int nig = WGM * nN, gid = wgid / nig, fm = gid * WGM, gsz = (nM - fm) < WGM ? (nM - fm) : WGM;
        u.pm = fm + ((wgid % nig) % gsz); u.pn = (wgid % nig) / gsz; if (wperm) u.pn = (int)(((u.pn < 8 ? 0xDC32BA10u >> (4 * u.pn) : 0x987654u >> (4 * (u.pn - 8)))) & 15u); return true;
    }
    __device__ __forceinline__ void a_ready(const Unit&) const {}
    __device__ __forceinline__ void done(const Unit&) const {}
};

__device__ __forceinline__ unsigned cvt_pk_bf16(float lo, float hi) { unsigned r; asm volatile("v_cvt_pk_bf16_f32 %0, %1, %2" : "=v"(r) : "v"(lo), "v"(hi)); return r; }
typedef float f32x2 __attribute__((ext_vector_type(2)));
constexpr float KR_SCALE = 0.08838834764831845f;
constexpr float QA_SCALE = 0.125f * 1.4426950408889634f;
constexpr int ZLD = 3584;
__device__ __forceinline__ float row_rstd(const float* ssp, int row, int fq) {
    const f32x4 a = *(const f32x4*)(ssp + (size_t)row * 16 + 4 * fq); float s = (a[0] + a[1]) + (a[2] + a[3]); s += __shfl_xor(s, 16); s += __shfl_xor(s, 32); return 1.f / sqrtf(s * (1.f / 1024.f) + 1e-6f); }
__device__ __forceinline__ u32x4 pack8(const f32x4& a, const f32x4& b) { u32x4 w; w.x = cvt_pk_bf16(a[0], a[1]); w.y = cvt_pk_bf16(a[2], a[3]); w.z = cvt_pk_bf16(b[0], b[1]); w.w = cvt_pk_bf16(b[2], b[3]); return w; }
struct EpiIn {
    static constexpr bool PERM = true, AFTER_DRAIN = false, APERM = false;
    bf16_t* Z; const float* T64; const float* T32; float* pwk; float* pwv; const float* ss;
    __device__ __forceinline__ void operator()(const f32x4 (&acc)[2][2][4][2], const Unit& u, int wr, int wc, int fr, int fq) const {
        const int pn = u.pn; const int row0 = u.pm * BM + wr * 64 + fr;
        if ((pn >= 4 && pn < 8) || pn >= 12) {
            const int colb = pn * BM + wc * 32 + 8 * fq;
            f32x4 np = *(const f32x4*)(ss + (size_t)row0 * 16 + 4 * fq);
#pragma unroll
            for (int ai = 0; ai < 2; ++ai)
#pragma unroll
                for (int m = 0; m < 4; ++m) { const int row = row0 + ai * HALF + m * 16; bf16_t* rowp = Z + (size_t)row * ZLD + colb;
                    const f32x4 pp = np;
                    if (ai * 4 + m < 7) { const int rown = row0 + ((ai * 4 + m + 1) >> 2) * HALF + ((ai * 4 + m + 1) & 3) * 16; np = *(const f32x4*)(ss + (size_t)rown * 16 + 4 * fq); }
                    __builtin_amdgcn_sched_barrier(0);
                    float sq = (pp[0] + pp[1]) + (pp[2] + pp[3]); sq += __shfl_xor(sq, 16); sq += __shfl_xor(sq, 32); const float rs = 1.f / sqrtf(sq * (1.f / 1024.f) + 1e-6f);
#pragma unroll
                    for (int bj = 0; bj < 2; ++bj) { const f32x4 v0 = acc[ai][bj][m][0] * rs, v1 = acc[ai][bj][m][1] * rs;
                        *(u32x4*)(rowp + bj * HALF) = pack8(v0, v1);
                        if (pn >= 12) { const int t = row & 4095; if (t >= 2048) { float* o = pwv + ((size_t)((row >> 12) * 2048 + (t - 2048))) * 512 + (colb + bj * HALF - 3072); *(f32x4*)o = v0; *(f32x4*)(o + 4) = v1; } } } }
        } else {
            const bool hd128 = pn < 4;
            int featbase, d0, half, tstride; const float* T;
            if (hd128) { const int head = 2 * (pn & 1) + (wc >> 1); d0 = 32 * (wc & 1) + 8 * fq; featbase = (pn >> 1) * 512 + head * 128 + d0; half = 64; T = T64; tstride = 64; }
            else { const int head = 4 * (pn & 1) + wc; d0 = 8 * fq; featbase = 2048 + ((pn - 8) >> 1) * 512 + head * 64 + d0; half = 32; T = T32; tstride = 32; }
            const float sc0 = (pn < 2) ? 1.f : (pn < 4) ? KR_SCALE : (pn < 10) ? QA_SCALE : 1.f;
            const bool is_ka = (pn == 10 || pn == 11);
            f32x4 nc0, nc1, nc2, nc3, np;
            { const f32x4* tp = (const f32x4*)(T + ((size_t)(row0 & 4095) * tstride + d0) * 2); nc0 = tp[0]; nc1 = tp[1]; nc2 = tp[2]; nc3 = tp[3]; np = *(const f32x4*)(ss + (size_t)row0 * 16 + 4 * fq); }
#pragma unroll
            for (int ai = 0; ai < 2; ++ai)
#pragma unroll
                for (int m = 0; m < 4; ++m) { const int row = row0 + ai * HALF + m * 16; const int t = row & 4095;
                    const f32x4 cs0 = nc0, cs1 = nc1, cs2 = nc2, cs3 = nc3; const f32x4 pp = np;
                    if (ai * 4 + m < 7) { const int rown = row0 + ((ai * 4 + m + 1) >> 2) * HALF + ((ai * 4 + m + 1) & 3) * 16;
                        const f32x4* tp = (const f32x4*)(T + ((size_t)(rown & 4095) * tstride + d0) * 2); nc0 = tp[0]; nc1 = tp[1]; nc2 = tp[2]; nc3 = tp[3]; np = *(const f32x4*)(ss + (size_t)rown * 16 + 4 * fq); }
                    __builtin_amdgcn_sched_barrier(0);
                    float sq = (pp[0] + pp[1]) + (pp[2] + pp[3]); sq += __shfl_xor(sq, 16); sq += __shfl_xor(sq, 32); const float sc = sc0 / sqrtf(sq * (1.f / 1024.f) + 1e-6f);
                    const f32x4 xa0 = acc[ai][0][m][0], xa1 = acc[ai][0][m][1], xb0 = acc[ai][1][m][0], xb1 = acc[ai][1][m][1];
                    f32x4 o10, o11, o20, o21;
                    o10[0] = (xa0[0] * cs0[0] - xb0[0] * cs0[1]) * sc; o20[0] = (xb0[0] * cs0[0] + xa0[0] * cs0[1]) * sc;
                    o10[1] = (xa0[1] * cs0[2] - xb0[1] * cs0[3]) * sc; o20[1] = (xb0[1] * cs0[2] + xa0[1] * cs0[3]) * sc;
                    o10[2] = (xa0[2] * cs1[0] - xb0[2] * cs1[1]) * sc; o20[2] = (xb0[2] * cs1[0] + xa0[2] * cs1[1]) * sc;
                    o10[3] = (xa0[3] * cs1[2] - xb0[3] * cs1[3]) * sc; o20[3] = (xb0[3] * cs1[2] + xa0[3] * cs1[3]) * sc;
                    o11[0] = (xa1[0] * cs2[0] - xb1[0] * cs2[1]) * sc; o21[0] = (xb1[0] * cs2[0] + xa1[0] * cs2[1]) * sc;
                    o11[1] = (xa1[1] * cs2[2] - xb1[1] * cs2[3]) * sc; o21[1] = (xb1[1] * cs2[2] + xa1[1] * cs2[3]) * sc;
                    o11[2] = (xa1[2] * cs3[0] - xb1[2] * cs3[1]) * sc; o21[2] = (xb1[2] * cs3[0] + xa1[2] * cs3[1]) * sc;
                    o11[3] = (xa1[3] * cs3[2] - xb1[3] * cs3[3]) * sc; o21[3] = (xb1[3] * cs3[2] + xa1[3] * cs3[3]) * sc;
                    bf16_t* rowp = Z + (size_t)row * ZLD + featbase;
                    *(u32x4*)rowp = pack8(o10, o11); *(u32x4*)(rowp + half) = pack8(o20, o21);
                    if (is_ka && t >= 2048) { float* o = pwk + ((size_t)((row >> 12) * 2048 + (t - 2048))) * 512 + (featbase - 2560);
                        *(f32x4*)o = o10; *(f32x4*)(o + 4) = o11; *(f32x4*)(o + half) = o20; *(f32x4*)(o + half + 4) = o21; } }
        }
    }
};
struct EpiResid {
    static constexpr bool PERM = false, AFTER_DRAIN = false, APERM = false;
    const float* base; float* out;
    __device__ __forceinline__ void operator()(const f32x4 (&acc)[2][2][4][2], const Unit& u, int wr, int wc, int fr, int fq) const {
        const int col0 = u.pn * BM + wc * 32 + 4 * fq;
#pragma unroll
        for (int ai = 0; ai < 2; ++ai)
#pragma unroll
            for (int m = 0; m < 4; ++m) { const size_t off = (size_t)(u.pm * BM + ai * HALF + wr * 64 + m * 16 + fr) * 1024 + col0;
#pragma unroll
                for (int bj = 0; bj < 2; ++bj)
#pragma unroll
                    for (int n = 0; n < 2; ++n) { const f32x4 b = *(const f32x4*)(base + off + bj * HALF + n * 16); *(f32x4*)(out + off + bj * HALF + n * 16) = b + acc[ai][bj][m][n]; } }
    }
};
struct EpiResidNorm {
    static constexpr bool PERM = true, AFTER_DRAIN = false, APERM = false;
    bf16_t* xb; float* ss;
    __device__ __forceinline__ void operator()(const f32x4 (&acc)[2][2][4][2], const Unit& u, int wr, int wc, int fr, int fq) const {
        const int col0 = u.pn * BM + wc * 32 + 8 * fq;
#pragma unroll
        for (int ai = 0; ai < 2; ++ai) {
            u32x4 xin[2][4][2];
#pragma unroll
            for (int m = 0; m < 4; ++m)
#pragma unroll
                for (int bj = 0; bj < 2; ++bj) xin[ai][m][bj] = *(const u32x4*)(xb + (size_t)(u.pm * BM + ai * HALF + wr * 64 + m * 16 + fr) * 1024 + col0 + bj * HALF);
#pragma unroll
            for (int m = 0; m < 4; ++m) { const int row = u.pm * BM + ai * HALF + wr * 64 + m * 16 + fr; const size_t off = (size_t)row * 1024 + col0; float s = 0.f;
#pragma unroll
                for (int bj = 0; bj < 2; ++bj) { const u32x4 b = xin[ai][m][bj];
                    f32x4 x0, x1;
                    x0[0] = __uint_as_float(b.x << 16) + acc[ai][bj][m][0][0]; x0[1] = __uint_as_float(b.x & 0xffff0000u) + acc[ai][bj][m][0][1]; x0[2] = __uint_as_float(b.y << 16) + acc[ai][bj][m][0][2]; x0[3] = __uint_as_float(b.y & 0xffff0000u) + acc[ai][bj][m][0][3];
                    x1[0] = __uint_as_float(b.z << 16) + acc[ai][bj][m][1][0]; x1[1] = __uint_as_float(b.z & 0xffff0000u) + acc[ai][bj][m][1][1]; x1[2] = __uint_as_float(b.w << 16) + acc[ai][bj][m][1][2]; x1[3] = __uint_as_float(b.w & 0xffff0000u) + acc[ai][bj][m][1][3];
                    *(u32x4*)(xb + off + bj * HALF) = pack8(x0, x1);
                    s += (x0[0] * x0[0] + x0[1] * x0[1]) + (x0[2] * x0[2] + x0[3] * x0[3]) + (x1[0] * x1[0] + x1[1] * x1[1]) + (x1[2] * x1[2] + x1[3] * x1[3]); }
                s += __shfl_xor(s, 16); s += __shfl_xor(s, 32);
                if (fq == 0) ss[(size_t)row * 16 + u.pn * 4 + wc] = s; }
        }
    }
};
struct EpiUp {
    static constexpr bool PERM = true, AFTER_DRAIN = false, APERM = false;
    bf16_t* U; float* pconv;
    __device__ __forceinline__ void operator()(const f32x4 (&acc)[2][2][4][2], const Unit& u, int wr, int wc, int fr, int fq) const {
        const int row0 = u.pm * BM + wr * 64 + fr, col0 = u.pn * BM + wc * 32 + 8 * fq;
#pragma unroll
        for (int ai = 0; ai < 2; ++ai)
#pragma unroll
            for (int m = 0; m < 4; ++m) { const int row = row0 + ai * HALF + m * 16; bf16_t* rowp = U + (size_t)row * 5632 + col0; const int t = row & 4095;
#pragma unroll
                for (int bj = 0; bj < 2; ++bj) { const f32x4 v0 = acc[ai][bj][m][0], v1 = acc[ai][bj][m][1];
                    *(u32x4*)(rowp + bj * HALF) = pack8(v0, v1);
                    if (t >= 4094) { float* o = pconv + ((size_t)((row >> 12) * 2 + (t - 4094))) * 5632 + col0 + bj * HALF; *(f32x4*)o = v0; *(f32x4*)(o + 4) = v1; } } }
    }
};

#define PG8_DPP(oldv, src, ctrl) __builtin_bit_cast(float, __builtin_amdgcn_update_dpp(__builtin_bit_cast(int, (oldv)), __builtin_bit_cast(int, (src)), (ctrl), 0xf, 0xf, false))
__device__ __forceinline__ float silu_fast(float x) { return x * __builtin_amdgcn_rcpf(1.f + __expf(-x)); }
struct EpiUpConv {
    static constexpr bool PERM = true, AFTER_DRAIN = false, APERM = true;
    bf16_t* AB; float* ubnd; float* pconv; const float* cw; const float* cb; PG8_LAS float* exb; const float* ss;
    __device__ __forceinline__ void operator()(f32x4 (&acc)[2][2][4][2], const Unit& u, int wr, int wc, int fr, int fq) const {
        const int pn = u.pn, pm = u.pm, cloc = wc * 32 + 8 * fq, gcol = 128 * pn + cloc;
        PG8_LAS float* cwl = exb + 2048;
        { int fr_ = fr; asm volatile("" : "+v"(fr_));
          const int tid = ((wr * 4 + wc) * 4 + fq) * 16 + fr_;
#pragma unroll
          for (int k = 0; k < 2; ++k) { const int i = tid + 512 * k, which = i >> 8, col = i & 255; const int feat = col < 128 ? 128 * pn + col : 2816 + 128 * pn + (col - 128);
              cwl[i] = which < 3 ? cw[which * 5632 + feat] : cb[feat]; } }
#pragma unroll
        for (int ai = 0; ai < 2; ++ai)
#pragma unroll
            for (int m = 0; m < 4; ++m) { const float rs = row_rstd(ss, pm * BM + ai * HALF + wr * 64 + 4 * fr + m, fq);
#pragma unroll
                for (int bj = 0; bj < 2; ++bj)
#pragma unroll
                    for (int n = 0; n < 2; ++n) acc[ai][bj][m][n] *= rs; }
        if (fr == 15) {
#pragma unroll
            for (int ai = 0; ai < 2; ++ai)
#pragma unroll
                for (int bj = 0; bj < 2; ++bj)
#pragma unroll
                    for (int n = 0; n < 2; ++n) { PG8_LAS float* d = exb + ((2 * ai + wr) * 2) * 256 + bj * 128 + cloc + 4 * n; *(PG8_LAS f32x4*)d = acc[ai][bj][2][n]; *(PG8_LAS f32x4*)(d + 256) = acc[ai][bj][3][n]; }
        }
        asm volatile("s_waitcnt vmcnt(0) lgkmcnt(0)" ::: "memory"); __builtin_amdgcn_s_barrier(); asm volatile("" ::: "memory");
        if (fr == 15 && wr == 1) {
#pragma unroll
            for (int bj = 0; bj < 2; ++bj)
#pragma unroll
                for (int n = 0; n < 2; ++n)
#pragma unroll
                    for (int k = 0; k < 2; ++k) { *(f32x4*)(ubnd + ((size_t)(pm * 4 + 2 + k) * 5632 + bj * 2816 + gcol + 4 * n)) = acc[1][bj][2 + k][n];
                        if ((pm & 15) == 15) *(f32x4*)(pconv + ((size_t)((pm >> 4) * 2 + k) * 5632 + bj * 2816 + gcol + 4 * n)) = acc[1][bj][2 + k][n]; }
        }
        if (wr == 0 && fr == 0) {
#pragma unroll
            for (int bj = 0; bj < 2; ++bj)
#pragma unroll
                for (int n = 0; n < 2; ++n)
#pragma unroll
                    for (int k = 0; k < 2; ++k) *(f32x4*)(ubnd + ((size_t)(pm * 4 + k) * 5632 + bj * 2816 + gcol + 4 * n)) = acc[0][bj][k][n];
        }
#pragma unroll
        for (int ai = 0; ai < 2; ++ai) {
            const int s = 2 * ai + wr;
            unsigned pk[2][4][2];
#pragma unroll
            for (int n = 0; n < 2; ++n) {
                const int cl = cloc + 4 * n;
                float o[1][4][4];
                f32x4 Bg0 = {0.f, 0.f, 0.f, 0.f}, Bg1 = Bg0, Bv0 = Bg0, Bv1 = Bg0;
                if (s > 0) { const PG8_LAS float* eb = exb + ((s - 1) * 2) * 256 + cl;
                    Bg0 = *(const PG8_LAS f32x4*)eb; Bg1 = *(const PG8_LAS f32x4*)(eb + 256); Bv0 = *(const PG8_LAS f32x4*)(eb + 128); Bv1 = *(const PG8_LAS f32x4*)(eb + 256 + 128); }
                {
                    const f32x4 wg0 = *(const PG8_LAS f32x4*)(cwl + cl), wg1 = *(const PG8_LAS f32x4*)(cwl + 256 + cl), wg2 = *(const PG8_LAS f32x4*)(cwl + 512 + cl), bg = *(const PG8_LAS f32x4*)(cwl + 768 + cl);
#pragma unroll
                    for (int i = 0; i < 4; ++i) {
                        const float g0 = acc[ai][0][0][n][i], g1 = acc[ai][0][1][n][i], g2 = acc[ai][0][2][n][i], g3 = acc[ai][0][3][n][i];
                        float og1 = Bg1[i], og0 = Bg0[i];
                        asm volatile("" : "+v"(og1), "+v"(og0));
                        const float pg3 = PG8_DPP(og1, g3, 0x111), pg2 = PG8_DPP(og0, g2, 0x111);
                        o[0][0][i] = silu_fast(bg[i] + wg2[i] * g0 + wg1[i] * pg3 + wg0[i] * pg2);
                        o[0][1][i] = silu_fast(bg[i] + wg2[i] * g1 + wg1[i] * g0 + wg0[i] * pg3);
                        o[0][2][i] = silu_fast(bg[i] + wg2[i] * g2 + wg1[i] * g1 + wg0[i] * g0);
                        o[0][3][i] = silu_fast(bg[i] + wg2[i] * g3 + wg1[i] * g2 + wg0[i] * g1);
                    }
                }
                {
                    const f32x4 wv0 = *(const PG8_LAS f32x4*)(cwl + 128 + cl), wv1 = *(const PG8_LAS f32x4*)(cwl + 256 + 128 + cl), wv2 = *(const PG8_LAS f32x4*)(cwl + 512 + 128 + cl), bv = *(const PG8_LAS f32x4*)(cwl + 768 + 128 + cl);
#pragma unroll
                    for (int i = 0; i < 4; ++i) {
                        const float v0 = acc[ai][1][0][n][i], v1 = acc[ai][1][1][n][i], v2 = acc[ai][1][2][n][i], v3 = acc[ai][1][3][n][i];
                        float ov1 = Bv1[i], ov0 = Bv0[i];
                        asm volatile("" : "+v"(ov1), "+v"(ov0));
                        const float pv3 = PG8_DPP(ov1, v3, 0x111), pv2 = PG8_DPP(ov0, v2, 0x111);
                        o[0][0][i] *= bv[i] + wv2[i] * v0 + wv1[i] * pv3 + wv0[i] * pv2;
                        o[0][1][i] *= bv[i] + wv2[i] * v1 + wv1[i] * v0 + wv0[i] * pv3;
                        o[0][2][i] *= bv[i] + wv2[i] * v2 + wv1[i] * v1 + wv0[i] * v0;
                        o[0][3][i] *= bv[i] + wv2[i] * v3 + wv1[i] * v2 + wv0[i] * v1;
                    }
                }
#pragma unroll
                for (int m = 0; m < 4; ++m) { pk[n][m][0] = cvt_pk_bf16(o[0][m][0], o[0][m][1]); pk[n][m][1] = cvt_pk_bf16(o[0][m][2], o[0][m][3]); }
            }
#pragma unroll
            for (int m = 0; m < 4; ++m) { const int row = pm * BM + ai * HALF + wr * 64 + 4 * fr + m;
                u32x4 w; w.x = pk[0][m][0]; w.y = pk[0][m][1]; w.z = pk[1][m][0]; w.w = pk[1][m][1];
                *(u32x4*)(AB + (size_t)row * 2816 + gcol) = w; }
        }
    }
};
template <class Epi, class Sched, bool ALIGN_EPI = false, bool SP2 = false>
__device__ __forceinline__ void gemm_phase(PG8_LAS unsigned char* lds, const Gemm g, const Sched& S, const Epi& E, int tid_in) {
    int tid_ = tid_in; asm volatile("" : "+v"(tid_));
    const int tid = tid_, wid = __builtin_amdgcn_readfirstlane(tid >> 6), lane = tid & 63, wr = wid >> 2, wc = wid & 3, fr = lane & 15, fq = lane >> 4;
    const int K = g.K, nt = K / BK;
    unsigned voffA[2], voffB[2];
#pragma unroll
    for (int i = 0; i < 2; ++i) { int R, C; stage_rc(tid * 16 + i * 8192, R, C); const int Rb = Epi::PERM ? ((R & ~31) + perm32(R & 31)) : R;
        const int Ra = Epi::APERM ? ((R & 64) | ((R & 15) << 2) | ((R >> 4) & 3)) : R;
        voffA[i] = (unsigned)(Ra * K + C) * 2u; voffB[i] = (unsigned)(Rb * K + C) * 2u; }
    const size_t kstep = (size_t)(BK * 2);
    const size_t hstep = (size_t)HALF * K * 2;
    const size_t tstep = 2 * hstep;
    const unsigned ldsw = (unsigned)wid * 1024u;
    const int aoff = lds_byte(wr * 64 + fr, fq * 8), boff = lds_byte(wc * 32 + fr, fq * 8);
#define PG8_SA(b, h) (((b) * 2 + (h)) * HTB)
#define PG8_SB(b, h) ((4 + (b) * 2 + (h)) * HTB)
#define PG8_STAGE(bufoff, gbase, voff) do { _Pragma("unroll") for (int _i = 0; _i < 2; ++_i) \
        __builtin_amdgcn_global_load_lds((const unsigned*)((const char*)(gbase) + (voff)[_i]), (PG8_LAS unsigned*)(lds + (bufoff) + ldsw + _i * 8192), 16, 0, 0); } while (0)
#define PG8_LDA(dst, b, h) do { _Pragma("unroll") for (int m = 0; m < 4; ++m) _Pragma("unroll") for (int k = 0; k < 2; ++k) dst[m][k] = *(const PG8_LAS bf16x8*)(lds + PG8_SA(b, h) + aoff + m * 2048 + k * 1024); } while (0)
#define PG8_LDB(dst, b, h) do { _Pragma("unroll") for (int n = 0; n < 2; ++n) _Pragma("unroll") for (int k = 0; k < 2; ++k) dst[n][k] = *(const PG8_LAS bf16x8*)(lds + PG8_SB(b, h) + boff + n * 2048 + k * 1024); } while (0)
#define PG8_MMA(ai, bj, At, Bt) do { __builtin_amdgcn_s_setprio(1); _Pragma("unroll") for (int m = 0; m < 4; ++m) _Pragma("unroll") for (int n = 0; n < 2; ++n) _Pragma("unroll") for (int k = 0; k < 2; ++k) \
        acc[ai][bj][m][n] = __builtin_amdgcn_mfma_f32_16x16x32_bf16(Bt[n][k], At[m][k], acc[ai][bj][m][n], 0, 0, 0); __builtin_amdgcn_s_setprio(0); } while (0)
#define PG8_WAIT_V(n) asm volatile("s_waitcnt vmcnt(" #n ")" ::: "memory")
#define PG8_WAIT_L(n) asm volatile("s_waitcnt lgkmcnt(" #n ")" ::: "memory")
#define PG8_BAR __builtin_amdgcn_s_barrier()
#define PG8_SCHED __builtin_amdgcn_sched_barrier(0)
    Unit cur, nxt; int ui = 0;
    if (!S.next(0, cur)) return;
    f32x4 acc[2][2][4][2];
#pragma unroll
    for (int a = 0; a < 2; ++a)
#pragma unroll
        for (int b = 0; b < 2; ++b)
#pragma unroll
            for (int m = 0; m < 4; ++m)
#pragma unroll
                for (int n = 0; n < 2; ++n) acc[a][b][m][n] = (f32x4){0.f, 0.f, 0.f, 0.f};
    bf16x8 At[4][2], B0[2][2], B1[2][2];
    const char* cA = (const char*)g.A + (size_t)cur.pm * tstep; const char* cB = (const char*)g.Bt + (size_t)cur.pn * tstep;
    S.a_ready(cur);
    if constexpr (SP2) {
        PG8_STAGE(PG8_SB(0, 0), cB, voffB); PG8_STAGE(PG8_SB(0, 1), cB + hstep, voffB); PG8_STAGE(PG8_SA(0, 0), cA, voffA); PG8_STAGE(PG8_SA(0, 1), cA + hstep, voffA);
        if (wr == 1) PG8_BAR;
        PG8_WAIT_V(2); PG8_BAR;
        PG8_STAGE(PG8_SB(1, 0), cB + kstep, voffB); PG8_STAGE(PG8_SA(1, 0), cA + kstep, voffA); PG8_STAGE(PG8_SB(1, 1), cB + hstep + kstep, voffB);
        PG8_WAIT_V(6); PG8_BAR;
    } else {
        PG8_STAGE(PG8_SB(0, 0), cB, voffB); PG8_STAGE(PG8_SA(0, 0), cA, voffA); PG8_STAGE(PG8_SB(0, 1), cB + hstep, voffB); PG8_STAGE(PG8_SA(0, 1), cA + hstep, voffA);
        if (wr == 1) PG8_BAR;
        PG8_WAIT_V(4); PG8_BAR;
        PG8_STAGE(PG8_SB(1, 0), cB + kstep, voffB); PG8_STAGE(PG8_SA(1, 0), cA + kstep, voffA); PG8_STAGE(PG8_SB(1, 1), cB + hstep + kstep, voffB);
        PG8_WAIT_V(6); PG8_BAR;
    }
    for (;;) {
        const bool has_next = S.next(ui + 1, nxt);
        const char* nA = has_next ? (const char*)g.A + (size_t)nxt.pm * tstep : cA; const char* nB = has_next ? (const char*)g.Bt + (size_t)nxt.pn * tstep : cB;
        for (int t = 0; t < nt; t += 2) {
            const bool last = (t == nt - 2);
            const char* a1 = cA + (size_t)(t + 1) * kstep;
            const char* a2 = last ? nA : cA + (size_t)(t + 2) * kstep; const char* b2 = last ? nB : cB + (size_t)(t + 2) * kstep;
            const char* a3 = a2 + kstep; const char* b3 = b2 + kstep;
            if (last && has_next) S.a_ready(nxt);
            if constexpr (SP2) {
            PG8_LDB(B0, 0, 0); PG8_LDB(B1, 0, 1); PG8_SCHED; PG8_LDA(At, 0, 0); PG8_STAGE(PG8_SA(1, 1), a1 + hstep, voffA);
            PG8_WAIT_V(8); PG8_WAIT_L(0); PG8_BAR; PG8_MMA(0, 0, At, B0); PG8_MMA(0, 1, At, B1); PG8_BAR; PG8_SCHED;
            PG8_LDA(At, 0, 1); PG8_STAGE(PG8_SB(0, 0), b2, voffB); PG8_STAGE(PG8_SB(0, 1), b2 + hstep, voffB); PG8_STAGE(PG8_SA(0, 0), a2, voffA);
            PG8_WAIT_V(8); PG8_WAIT_L(0); PG8_BAR; PG8_MMA(1, 0, At, B0); PG8_MMA(1, 1, At, B1); PG8_BAR; PG8_SCHED;
            PG8_LDB(B0, 1, 0); PG8_LDB(B1, 1, 1); PG8_SCHED; PG8_LDA(At, 1, 0); PG8_STAGE(PG8_SA(0, 1), a2 + hstep, voffA);
            PG8_WAIT_V(8); PG8_WAIT_L(0); PG8_BAR; PG8_MMA(0, 0, At, B0); PG8_MMA(0, 1, At, B1); PG8_BAR; PG8_SCHED;
            PG8_LDA(At, 1, 1); PG8_STAGE(PG8_SB(1, 0), b3, voffB); PG8_STAGE(PG8_SB(1, 1), b3 + hstep, voffB); PG8_STAGE(PG8_SA(1, 0), a3, voffA);
            PG8_WAIT_V(8); PG8_WAIT_L(0); PG8_BAR; PG8_MMA(1, 0, At, B0); PG8_MMA(1, 1, At, B1); PG8_BAR; PG8_SCHED;
            } else {
            PG8_LDB(B0, 0, 0); PG8_SCHED; PG8_LDA(At, 0, 0); PG8_STAGE(PG8_SA(1, 1), a1 + hstep, voffA);
            PG8_WAIT_L(8); PG8_BAR; PG8_WAIT_L(0); PG8_MMA(0, 0, At, B0); PG8_BAR; PG8_SCHED;
            PG8_LDB(B1, 0, 1); PG8_STAGE(PG8_SB(0, 0), b2, voffB);
            PG8_BAR; PG8_WAIT_L(0); PG8_MMA(0, 1, At, B1); PG8_BAR;
            PG8_LDA(At, 0, 1); PG8_STAGE(PG8_SA(0, 0), a2, voffA);
            PG8_BAR; PG8_WAIT_L(0); PG8_MMA(1, 0, At, B0); PG8_BAR; PG8_SCHED;
            PG8_STAGE(PG8_SB(0, 1), b2 + hstep, voffB);
            PG8_WAIT_V(6); PG8_BAR; PG8_MMA(1, 1, At, B1); PG8_BAR;
            PG8_LDB(B0, 1, 0); PG8_SCHED; PG8_LDA(At, 1, 0); PG8_STAGE(PG8_SA(0, 1), a2 + hstep, voffA);
            PG8_WAIT_L(8); PG8_BAR; PG8_WAIT_L(0); PG8_MMA(0, 0, At, B0); PG8_BAR; PG8_SCHED;
            PG8_LDB(B1, 1, 1); PG8_STAGE(PG8_SB(1, 0), b3, voffB);
            PG8_BAR; PG8_WAIT_L(0); PG8_MMA(0, 1, At, B1); PG8_BAR;
            PG8_LDA(At, 1, 1); PG8_STAGE(PG8_SA(1, 0), a3, voffA);
            PG8_BAR; PG8_WAIT_L(0); PG8_MMA(1, 0, At, B0); PG8_BAR; PG8_SCHED;
            PG8_STAGE(PG8_SB(1, 1), b3 + hstep, voffB);
            PG8_WAIT_V(6); PG8_BAR; PG8_MMA(1, 1, At, B1); PG8_BAR;
            }
        }
        if constexpr (ALIGN_EPI) { if (wr == 0) PG8_BAR; }
        if constexpr (!Epi::AFTER_DRAIN) { E(acc, cur, wr, wc, fr, fq); S.done(cur); }
        if (!has_next) break;
#pragma unroll
        for (int a = 0; a < 2; ++a)
#pragma unroll
            for (int b = 0; b < 2; ++b)
#pragma unroll
                for (int m = 0; m < 4; ++m)
#pragma unroll
                    for (int n = 0; n < 2; ++n) acc[a][b][m][n] = (f32x4){0.f, 0.f, 0.f, 0.f};
        cur = nxt; cA = nA; cB = nB; ++ui;
        if constexpr (ALIGN_EPI) { if (wr == 1) PG8_BAR; }
    }
    PG8_WAIT_V(0);
    if constexpr (!ALIGN_EPI) { if (wr == 0) PG8_BAR; }
    PG8_BAR;
    if constexpr (Epi::AFTER_DRAIN) { E.fused(acc, cur, wr, wc, fr, fq, lds, wid, lane); S.done(cur); }
#undef PG8_SA
#undef PG8_SB
#undef PG8_STAGE
#undef PG8_LDA
#undef PG8_LDB
#undef PG8_MMA
#undef PG8_WAIT_V
#undef PG8_WAIT_L
#undef PG8_BAR
#undef PG8_SCHED
}
}
#define GAS __attribute__((address_space(1)))
#define LAS __attribute__((address_space(3)))
typedef unsigned short bf16;
typedef unsigned v4u __attribute__((ext_vector_type(4)));
typedef float f32x4 __attribute__((ext_vector_type(4)));
typedef short bf16x8 __attribute__((ext_vector_type(8)));
typedef GAS unsigned gu32;
typedef GAS unsigned long long gu64;
#define RLX_AGENT __ATOMIC_RELAXED, __HIP_MEMORY_SCOPE_AGENT
#define LDS_WAIT() asm volatile("s_waitcnt lgkmcnt(0)" ::: "memory")
#define VM_WAIT() asm volatile("s_waitcnt vmcnt(0)" ::: "memory")
__device__ __forceinline__ unsigned long long rt() { return __builtin_amdgcn_s_memrealtime(); }
__device__ __forceinline__ unsigned f2bf(float f) { unsigned u = __builtin_bit_cast(unsigned, f); return (u + 0x7fffu + ((u >> 16) & 1u)) >> 16; }
__device__ __forceinline__ unsigned pk2(float lo, float hi) { return f2bf(lo) | (f2bf(hi) << 16); }
#define XB_TMO      128
#define XB_XCNT(j)  (256  + 64 * (j))
#define XB_XSUB(j)  (1280 + 64 * (j))
#define XB_XGEN(j)  (2304 + 64 * (j))
#define XB_TOP      3328
#define XB_TOPGEN   3392
#define XCD_BAR_WORDS 3456
#define XB_SPIN_CAP (1u << 18)

__device__ __forceinline__ unsigned xb_ld(unsigned* p)              { return __hip_atomic_load(p, __ATOMIC_RELAXED, __HIP_MEMORY_SCOPE_AGENT); }
__device__ __forceinline__ unsigned xb_add(unsigned* p, unsigned v) { return __hip_atomic_fetch_add(p, v, __ATOMIC_RELAXED, __HIP_MEMORY_SCOPE_AGENT); }
__device__ __forceinline__ unsigned xb_xcc_id() { return (unsigned)__builtin_amdgcn_s_getreg((3 << 11) | 20) & 0xFu; }
#define XB_SPIN(cond, bar) do { unsigned _sp = 0; while (cond) { __builtin_amdgcn_s_sleep(1); \
    if ((++_sp & 255u) == 0u) { if (xb_ld(&(bar)[XB_TMO])) break; if (_sp > XB_SPIN_CAP) { atomicAdd(&(bar)[XB_TMO], 1u); break; } } } } while (0)

struct XcdBarrier {
    unsigned* bar; unsigned x;
    volatile LAS unsigned* st;
};

__device__ __forceinline__ XcdBarrier xcd_barrier_post(unsigned* bar, volatile LAS unsigned* st) {
    XcdBarrier b; b.bar = bar; b.x = xb_xcc_id(); b.st = st;
    if (threadIdx.x == 0) (void)xb_add(&bar[XB_XCNT(b.x)], 1u);
    return b;
}
__device__ __forceinline__ void xcd_barrier_complete(unsigned* bar, unsigned x, unsigned& nloc, unsigned& nx) {
    const unsigned G = gridDim.x * gridDim.y * gridDim.z;
    unsigned sum, cnt, mine, sp = 0u;
    for (;;) {
        sum = 0u; cnt = 0u; mine = 0u;
#pragma unroll
        for (unsigned j = 0; j < 16; ++j) { const unsigned c = xb_ld(&bar[XB_XCNT(j)]); sum += c; cnt += (c > 0u) ? 1u : 0u; mine = (j == x) ? c : mine; }
        if (sum == G) break;
        __builtin_amdgcn_s_sleep(1);
        if ((++sp & 255u) == 0u) { if (xb_ld(&bar[XB_TMO])) break; if (sp > XB_SPIN_CAP) { atomicAdd(&bar[XB_TMO], 1u); break; } }
    }
    nloc = mine > 0u ? mine : 1u; nx = cnt > 0u ? cnt : 1u;
}

__device__ __forceinline__ void xcd_barrier(const XcdBarrier& b, int tid) {
    asm volatile("s_waitcnt vmcnt(0)" ::: "memory");
    __syncthreads();
    if (tid == 0) {
        unsigned* bar = b.bar; asm volatile("" : "+s"(bar));
        __builtin_amdgcn_s_waitcnt(0);
        unsigned bx_ = b.x; asm volatile("" : "+s"(bx_));
        unsigned nloc = b.st[0], nx = b.st[1];
        if (nloc == 0u) { xcd_barrier_complete(bar, bx_, nloc, nx); b.st[0] = nloc; b.st[1] = nx; }
        const unsigned old = xb_add(&bar[XB_XSUB(bx_)], 1u);
        const unsigned gen = old / nloc;
        if (old + 1u == (gen + 1u) * nloc) {
            __builtin_amdgcn_fence(__ATOMIC_RELEASE, "agent");
            asm volatile("s_waitcnt vmcnt(0)" ::: "memory");
            const unsigned og = xb_add(&bar[XB_TOP], 1u);
            const unsigned tg = og / nx;
            if (og + 1u == (tg + 1u) * nx) xb_add(&bar[XB_TOPGEN], 1u);
            else XB_SPIN(xb_ld(&bar[XB_TOPGEN]) == tg, bar);
            __builtin_amdgcn_fence(__ATOMIC_ACQUIRE, "agent");
            xb_add(&bar[XB_XGEN(bx_)], 1u);
            asm volatile("s_waitcnt vmcnt(0)" ::: "memory");
        } else {
            XB_SPIN(xb_ld(&bar[XB_XGEN(bx_)]) == gen, bar);
            __builtin_amdgcn_fence(__ATOMIC_ACQUIRE, "agent");
            asm volatile("s_waitcnt vmcnt(0)" ::: "memory");
        }
    }
    __syncthreads();
}
constexpr int NWAVES = 8;
constexpr int DM = 1024, NBATCH = 4, SEQ = 4096, DEPTH = 4, DBATCH = 32, DSEQ = 4, PAST = 8192;
constexpr int MP = NBATCH * SEQ, MS = DBATCH * DSEQ;
constexpr int DIN = 3584, DFF = 2816, DUP = 2 * DFF, WCTX = 2048;
constexpr int C_QR = 0, C_KR = 512, C_VR = 1024, C_GR = 1536, C_QA = 2048, C_KA = 2560, C_VA = 3072;
constexpr float EPS = 1e-6f;
constexpr int NPOS = SEQ + DSEQ;

__host__ __device__ __forceinline__ int in_feature(int nrow) {
    const int pn = nrow >> 8, tc = nrow & 255, bj = tc >> 7, j = tc & 127;
    if (pn < 4) return (pn >> 1) * 512 + (2 * (pn & 1) + (j >> 6)) * 128 + (j & 63) + 64 * bj;
    if (pn >= 8 && pn < 12) return 2048 + ((pn - 8) >> 1) * 512 + (4 * (pn & 1) + (j >> 5)) * 64 + (j & 31) + 32 * bj;
    return nrow;
}

__host__ __device__ __forceinline__ int up_feature(int nrow) { const int pn = nrow >> 8, tc = nrow & 255; return tc < 128 ? 128 * pn + tc : 2816 + 128 * pn + (tc - 128); }

constexpr size_t MiB = 1u << 20;
constexpr size_t WS_CTL = 0, CTL_ZERO_BYTES = 1 * MiB;
constexpr size_t WS_T64 = 1 * MiB;
constexpr size_t WS_T32 = 4 * MiB;
constexpr size_t WS_SS1 = 356 * MiB, WS_SS2 = 358 * MiB;
constexpr size_t WS_WIN = 6 * MiB;
constexpr size_t WS_WOUT = 34 * MiB;
constexpr size_t WS_WUP = 42 * MiB;
constexpr size_t WS_WDN = 86 * MiB;
constexpr size_t WS_XRES = 108 * MiB;
constexpr size_t WS_HB = 172 * MiB;
constexpr size_t WS_ZB = 204 * MiB;
constexpr size_t WS_CATB = 316 * MiB;
constexpr size_t WS_UB = 348 * MiB;
constexpr size_t WS_AB = 524 * MiB;
constexpr size_t WS_OG = 612 * MiB;
constexpr size_t WS_LSE = 660 * MiB;
constexpr size_t WS_UPD = 662 * MiB;
constexpr size_t WS_ST = 694 * MiB;
constexpr size_t WS_SMP = 710 * MiB;
constexpr size_t WS_OPT_END = 718 * MiB;
constexpr size_t WS_NAIVE = 720 * MiB;
constexpr size_t SM_X = 0;
constexpr size_t SM_HB = 512 * 1024;
constexpr size_t SM_ZB = 768 * 1024;
constexpr size_t SM_CATB = 1792 * 1024;
constexpr size_t SM_U = 2048 * 1024;
constexpr size_t SM_AB = 5120 * 1024;
constexpr size_t SM_SS = 6144 * 1024;
constexpr int CW_TMO = 0, CW_CODE = 1, CW_BAR = 4096;

constexpr int RING_OFF = 0, RING_BYTES = 131072;
constexpr int LDSCTL_OFF = RING_BYTES, MISC_OFF = LDSCTL_OFF + 320;
constexpr int EXB_OFF = 132096;
constexpr int LDS_BYTES = 147456;
static_assert(MISC_OFF + 128 <= EXB_OFF && EXB_OFF + 8192 + 4096 <= LDS_BYTES, "LDS map");
struct Frame {
    LAS unsigned char* lds;
    volatile LAS unsigned* MISC;
    gu32* ctl;
    int tid, lane, wave;
    int vcu, G;
    unsigned char* ws;
};
struct Args { const float* in[16]; float* out; unsigned char* ws; int layer, pad; };

__device__ __forceinline__ float wave_sum(float v) {
#pragma unroll
    for (int o = 1; o < 64; o <<= 1) v += __shfl_xor(v, o);
    return v;
}
__device__ __forceinline__ float silu_f(float x) { return x / (1.f + __expf(-x)); }

struct P0Item { const float* src; bf16* dst; const float* ksc; int K, N; };
__device__ __forceinline__ void p0_item_load(const P0Item& I, f32x4 (&v)[8], int lane) {
#pragma unroll
    for (int i = 0; i < 8; ++i) v[i] = *(const GAS f32x4*)(I.src + (size_t)((lane >> 3) + 8 * i) * I.N + 4 * (lane & 7));
}
__device__ __forceinline__ void p0_item_store(const P0Item& I, const f32x4 (&v)[8], LAS float* scr, int lane) {
#pragma unroll
    for (int i = 0; i < 8; ++i) { const int kk = (lane >> 3) + 8 * i; const float sc = I.ksc ? I.ksc[kk] : 1.f; LAS float* d = scr + kk * 33 + 4 * (lane & 7);
        d[0] = v[i][0] * sc; d[1] = v[i][1] * sc; d[2] = v[i][2] * sc; d[3] = v[i][3] * sc; }
    LDS_WAIT(); asm volatile("" ::: "memory");
    const int c = lane & 7;
#pragma unroll
    for (int j = 0; j < 4; ++j) { const int n = (lane >> 3) + 8 * j; const LAS float* s = scr + (8 * c) * 33 + n;
        v4u o; o.x = pk2(s[0 * 33], s[1 * 33]); o.y = pk2(s[2 * 33], s[3 * 33]); o.z = pk2(s[4 * 33], s[5 * 33]); o.w = pk2(s[6 * 33], s[7 * 33]);
        *(GAS v4u*)(I.dst + (size_t)n * I.K + 8 * c) = o; }
    LDS_WAIT(); asm volatile("" ::: "memory");
}
constexpr int P0_I_IN = (DM / 64) * (DIN / 32), P0_I_OUT = (DM / 64) * (DM / 32), P0_I_UP = (DM / 64) * (DUP / 32), P0_I_DN = (DFF / 64) * (DM / 32), P0_I_L = P0_I_IN + P0_I_OUT + P0_I_UP + P0_I_DN;
__device__ __forceinline__ void p0_convert(Frame& F, const float* w_in, const float* w_out, const float* w_up, const float* w_dn, const float* n1w, const float* n2w, int it0, int it1, int gw, int NGW) {
    LAS float* scr = (LAS float*)(F.lds + RING_OFF + F.wave * 16384);
    constexpr int I_IN = P0_I_IN, I_OUT = P0_I_OUT, I_UP = P0_I_UP, I_L = P0_I_L;
    bf16* WIN = (bf16*)(F.ws + WS_WIN); bf16* WOUT = (bf16*)(F.ws + WS_WOUT); bf16* WUP = (bf16*)(F.ws + WS_WUP); bf16* WDN = (bf16*)(F.ws + WS_WDN);
    auto resolve = [&](int it) -> P0Item {
        const int l = it / I_L; int r = it % I_L; P0Item I;
        if (r < I_IN) { const int nblk = DIN / 32, kb = r / nblk, nb = r % nblk; I.K = DM; I.N = DIN; I.src = w_in + (size_t)l * DM * DIN + (size_t)(64 * kb) * DIN + in_feature(32 * nb); I.dst = WIN + (size_t)l * DIN * DM + (size_t)(32 * nb) * DM + 64 * kb; I.ksc = n1w + (size_t)l * DM + 64 * kb; return I; } r -= I_IN;
        if (r < I_OUT) { const int nblk = DM / 32, kb = r / nblk, nb = r % nblk; I.K = DM; I.N = DM; I.src = w_out + (size_t)l * DM * DM + (size_t)(64 * kb) * DM + 32 * nb; I.dst = WOUT + (size_t)l * DM * DM + (size_t)(32 * nb) * DM + 64 * kb; I.ksc = nullptr; return I; } r -= I_OUT;
        if (r < I_UP) { const int nblk = DUP / 32, kb = r / nblk, nb = r % nblk; I.K = DM; I.N = DUP; I.src = w_up + (size_t)l * DM * DUP + (size_t)(64 * kb) * DUP + up_feature(32 * nb); I.dst = WUP + (size_t)l * DUP * DM + (size_t)(32 * nb) * DM + 64 * kb; I.ksc = n2w + (size_t)l * DM + 64 * kb; return I; } r -= I_UP;
        { const int nblk = DM / 32, kb = r / nblk, nb = r % nblk; I.K = DFF; I.N = DM; I.src = w_dn + (size_t)l * DFF * DM + (size_t)(64 * kb) * DM + 32 * nb; I.dst = WDN + (size_t)l * DM * DFF + (size_t)(32 * nb) * DFF + 64 * kb; I.ksc = nullptr; return I; }
    };
    if (it0 + gw < it1) {
        P0Item cur = resolve(it0 + gw); f32x4 v[8]; p0_item_load(cur, v, F.lane);
#pragma unroll 1
        for (int it = it0 + gw; it < it1; it += NGW) {
            const bool more = it + NGW < it1; P0Item nxt = cur; f32x4 vn[8];
            if (more) { nxt = resolve(it + NGW); p0_item_load(nxt, vn, F.lane); }
            p0_item_store(cur, v, scr, F.lane);
            if (more) { cur = nxt;
#pragma unroll
                for (int i = 0; i < 8; ++i) v[i] = vn[i]; }
        }
    }
}
__device__ __forceinline__ void p0_prologue(Frame& F, const float* w_in, const float* w_out, const float* w_up, const float* w_dn, const float* n1w, const float* n2w, const float* xp) {
    const int gw = F.vcu * NWAVES + F.wave, NGW = F.G * NWAVES;
    p0_convert(F, w_in, w_out, w_up, w_dn, n1w, n2w, 0, DEPTH * P0_I_L, gw, NGW);
    { bf16* XB = (bf16*)(F.ws + WS_HB); float* SS1 = (float*)(F.ws + WS_SS1);
      for (int m = gw; m < MP; m += NGW) { const GAS f32x4* xr = (const GAS f32x4*)(xp + (size_t)m * DM) + F.lane; GAS unsigned long long* o8 = (GAS unsigned long long*)(XB + (size_t)m * DM) + F.lane; float s = 0.f;
#pragma unroll
          for (int j = 0; j < 4; ++j) { const f32x4 v = xr[64 * j]; s += (v.x * v.x + v.y * v.y) + (v.z * v.z + v.w * v.w); o8[64 * j] = (unsigned long long)pk2(v.x, v.y) | ((unsigned long long)pk2(v.z, v.w) << 32); }
          s = wave_sum(s); if (F.lane < 16) SS1[(size_t)m * 16 + F.lane] = (F.lane == 0) ? s : 0.f; } }
    float* T64 = (float*)(F.ws + WS_T64); float* T32 = (float*)(F.ws + WS_T32);
    const int gt = (F.vcu * NWAVES + F.wave) * 64 + F.lane, NT = F.G * NWAVES * 64;
    for (int i = gt; i < NPOS * 96; i += NT) {
        const int p = i / 96, k = i % 96; const float pos = (float)(p < SEQ ? p : PAST + (p - SEQ));
        float inv; float* dst;
        if (k < 64) { inv = powf(10000.f, -(float)k / 64.f); dst = T64 + ((size_t)p * 64 + k) * 2; }
        else { inv = powf(10000.f, -(float)(k - 64) / 32.f); dst = T32 + ((size_t)p * 32 + (k - 64)) * 2; }
        float sn, cs; sincosf(pos * inv, &sn, &cs); dst[0] = cs; dst[1] = sn;
    }
}
__device__ __forceinline__ void rms_row_to_bf16(const float* xrow, const float* w, bf16* orow, int lane) {
    const GAS f32x4* xr = (const GAS f32x4*)xrow + lane; const GAS f32x4* wr = (const GAS f32x4*)w + lane;
    f32x4 v[4]; float s = 0.f;
#pragma unroll
    for (int j = 0; j < 4; ++j) { v[j] = xr[64 * j]; s += (v[j].x * v[j].x + v[j].y * v[j].y) + (v[j].z * v[j].z + v[j].w * v[j].w); }
    const float rstd = 1.f / sqrtf(wave_sum(s) * (1.f / DM) + EPS);
    GAS unsigned long long* o8 = (GAS unsigned long long*)orow + lane;
#pragma unroll
    for (int j = 0; j < 4; ++j) { const f32x4 ww = wr[64 * j];
        o8[64 * j] = (unsigned long long)pk2(v[j].x * rstd * ww.x, v[j].y * rstd * ww.y) | ((unsigned long long)pk2(v[j].z * rstd * ww.z, v[j].w * rstd * ww.w) << 32); }
}
__device__ __forceinline__ void rms_row_to_f32(const float* xrow, const float* w, float* orow, int lane) {
    const GAS f32x4* xr = (const GAS f32x4*)xrow + lane; const GAS f32x4* wr = (const GAS f32x4*)w + lane;
    f32x4 v[4]; float s = 0.f;
#pragma unroll
    for (int j = 0; j < 4; ++j) { v[j] = xr[64 * j]; s += (v[j].x * v[j].x + v[j].y * v[j].y) + (v[j].z * v[j].z + v[j].w * v[j].w); }
    const float rstd = 1.f / sqrtf(wave_sum(s) * (1.f / DM) + EPS);
    GAS f32x4* o = (GAS f32x4*)orow + lane;
#pragma unroll
    for (int j = 0; j < 4; ++j) { const f32x4 ww = wr[64 * j]; o[64 * j] = (v[j] * rstd) * ww; }
}
__device__ __forceinline__ void norm_phase(Frame& F, const float* xp, const float* xs, const float* w) {
    const int gw = F.vcu * NWAVES + F.wave, NGW = F.G * NWAVES;
    bf16* HB = (bf16*)(F.ws + WS_HB); bf16* HS = (bf16*)(F.ws + WS_SMP + SM_HB);
    for (int m = gw; m < MP; m += NGW) rms_row_to_bf16(xp + (size_t)m * DM, w, HB + (size_t)m * DM, F.lane);
    for (int m = NGW - 1 - gw; m < MS; m += NGW) rms_row_to_bf16(xs + (size_t)m * DM, w, HS + (size_t)m * DM, F.lane);
}
__device__ __forceinline__ void rms_rowb_to_f32(const bf16* xrow, const float* w, float* orow, int lane) {
    const GAS unsigned long long* xr = (const GAS unsigned long long*)xrow + lane; const GAS f32x4* wr = (const GAS f32x4*)w + lane;
    f32x4 v[4]; float s = 0.f;
#pragma unroll
    for (int j = 0; j < 4; ++j) { const unsigned long long q = xr[64 * j]; v[j].x = __uint_as_float((unsigned)q << 16); v[j].y = __uint_as_float((unsigned)q & 0xffff0000u); v[j].z = __uint_as_float((unsigned)(q >> 32) << 16); v[j].w = __uint_as_float((unsigned)(q >> 32) & 0xffff0000u);
        s += (v[j].x * v[j].x + v[j].y * v[j].y) + (v[j].z * v[j].z + v[j].w * v[j].w); }
    const float rstd = 1.f / sqrtf(wave_sum(s) * (1.f / DM) + EPS);
    GAS f32x4* o = (GAS f32x4*)orow + lane;
#pragma unroll
    for (int j = 0; j < 4; ++j) { const f32x4 ww = wr[64 * j]; o[64 * j] = (v[j] * rstd) * ww; }
}
__device__ __forceinline__ void final_norm_phase(Frame& F, const bf16* xpb, const float* xs, const float* w, float* yp, float* ys) {
    const int gw = F.vcu * NWAVES + F.wave, NGW = F.G * NWAVES;
    for (int m = gw; m < MP; m += NGW) rms_rowb_to_f32(xpb + (size_t)m * DM, w, yp + (size_t)m * DM, F.lane);
    for (int m = NGW - 1 - gw; m < MS; m += NGW) rms_row_to_f32(xs + (size_t)m * DM, w, ys + (size_t)m * DM, F.lane);
}
__device__ __forceinline__ void conv_phase_prompt(Frame& F, const float* cw, const float* cb) {
    const bf16* UB = (const bf16*)(F.ws + WS_UB); bf16* AB = (bf16*)(F.ws + WS_AB);
    const int gt = (F.vcu * NWAVES + F.wave) * 64 + F.lane, NT = F.G * NWAVES * 64;
    constexpr int NCH = DFF / 8, NITEM = (MP / 16) * NCH;
    for (int it = gt; it < NITEM; it += NT) {
        const int rb = it / NCH, c8 = it % NCH, r0 = rb * 16, c0 = c8 * 8;
        float wg[3][8], wv[3][8], bg[8], bv[8];
#pragma unroll
        for (int j = 0; j < 3; ++j)
#pragma unroll
            for (int q = 0; q < 2; ++q) { const f32x4 a = *(const GAS f32x4*)(cw + (size_t)j * DUP + c0 + 4 * q), b = *(const GAS f32x4*)(cw + (size_t)j * DUP + DFF + c0 + 4 * q);
#pragma unroll
                for (int e = 0; e < 4; ++e) { wg[j][4 * q + e] = a[e]; wv[j][4 * q + e] = b[e]; } }
#pragma unroll
        for (int q = 0; q < 2; ++q) { const f32x4 a = *(const GAS f32x4*)(cb + c0 + 4 * q), b = *(const GAS f32x4*)(cb + DFF + c0 + 4 * q);
#pragma unroll
            for (int e = 0; e < 4; ++e) { bg[4 * q + e] = a[e]; bv[4 * q + e] = b[e]; } }
        float g2[8], g1[8], v2[8], v1[8];
        const bool has_prev = (r0 & 4095) != 0;
        {
            v4u a2 = {0u, 0u, 0u, 0u}, a1 = a2, b2 = a2, b1 = a2;
            if (has_prev) { a2 = *(const GAS v4u*)(UB + (size_t)(r0 - 2) * DUP + c0); a1 = *(const GAS v4u*)(UB + (size_t)(r0 - 1) * DUP + c0);
                            b2 = *(const GAS v4u*)(UB + (size_t)(r0 - 2) * DUP + DFF + c0); b1 = *(const GAS v4u*)(UB + (size_t)(r0 - 1) * DUP + DFF + c0); }
#pragma unroll
            for (int e = 0; e < 4; ++e) { g2[2 * e] = __uint_as_float(a2[e] << 16); g2[2 * e + 1] = __uint_as_float(a2[e] & 0xffff0000u); g1[2 * e] = __uint_as_float(a1[e] << 16); g1[2 * e + 1] = __uint_as_float(a1[e] & 0xffff0000u);
                                          v2[2 * e] = __uint_as_float(b2[e] << 16); v2[2 * e + 1] = __uint_as_float(b2[e] & 0xffff0000u); v1[2 * e] = __uint_as_float(b1[e] << 16); v1[2 * e + 1] = __uint_as_float(b1[e] & 0xffff0000u); }
        }
#pragma unroll 4
        for (int i = 0; i < 16; ++i) {
            const v4u a0 = *(const GAS v4u*)(UB + (size_t)(r0 + i) * DUP + c0), b0 = *(const GAS v4u*)(UB + (size_t)(r0 + i) * DUP + DFF + c0);
            float g0[8], v0[8], o[8];
#pragma unroll
            for (int e = 0; e < 4; ++e) { g0[2 * e] = __uint_as_float(a0[e] << 16); g0[2 * e + 1] = __uint_as_float(a0[e] & 0xffff0000u); v0[2 * e] = __uint_as_float(b0[e] << 16); v0[2 * e + 1] = __uint_as_float(b0[e] & 0xffff0000u); }
#pragma unroll
            for (int e = 0; e < 8; ++e) { const float gg = bg[e] + wg[0][e] * g2[e] + wg[1][e] * g1[e] + wg[2][e] * g0[e]; const float vv = bv[e] + wv[0][e] * v2[e] + wv[1][e] * v1[e] + wv[2][e] * v0[e];
                o[e] = silu_f(gg) * vv; g2[e] = g1[e]; g1[e] = g0[e]; v2[e] = v1[e]; v1[e] = v0[e]; }
            v4u w; w.x = pk2(o[0], o[1]); w.y = pk2(o[2], o[3]); w.z = pk2(o[4], o[5]); w.w = pk2(o[6], o[7]);
            *(GAS v4u*)(AB + (size_t)(r0 + i) * DFF + c0) = w;
        }
    }
}

__device__ __forceinline__ void conv_fixup_phase(Frame& F, const float* cw, const float* cb) {
    const float* UB = (const float*)(F.ws + WS_UB); bf16* AB = (bf16*)(F.ws + WS_AB);
    const int gt = (F.vcu * NWAVES + F.wave) * 64 + F.lane, NT = F.G * NWAVES * 64;
    for (int it = gt; it < 64 * 2 * DFF; it += NT) { const int c = it % DFF, tr = it / DFF, pm = tr >> 1, r = tr & 1;
        if ((pm & 15) == 0) continue;
        float o[2];
#pragma unroll
        for (int hh = 0; hh < 2; ++hh) { const int cc = c + hh * DFF;
            const float um2 = UB[((size_t)(pm - 1) * 4 + 2) * DUP + cc], um1 = UB[((size_t)(pm - 1) * 4 + 3) * DUP + cc], u0 = UB[((size_t)pm * 4 + 0) * DUP + cc], u1 = UB[((size_t)pm * 4 + 1) * DUP + cc];
            const float a = r ? um1 : um2, b = r ? u0 : um1, d = r ? u1 : u0;
            o[hh] = cb[cc] + cw[cc] * a + cw[DUP + cc] * b + cw[2 * DUP + cc] * d; }
        AB[(size_t)(pm * 256 + r) * DFF + c] = (bf16)f2bf(silu_f(o[0]) * o[1]); }
}

__device__ __forceinline__ void zero_rows_f32(Frame& F, float* p) { const int gt = (F.vcu * NWAVES + F.wave) * 64 + F.lane; if (gt < MP) p[gt] = 0.f; }
typedef float f32x16 __attribute__((ext_vector_type(16)));
typedef short s16x4 __attribute__((ext_vector_type(4)));
typedef float f32x2_t __attribute__((ext_vector_type(2))); typedef __bf16 bf16x2_t __attribute__((ext_vector_type(2)));
__device__ __forceinline__ unsigned cvtpk(float lo, float hi) { f32x2_t v = {lo, hi}; bf16x2_t b = __builtin_convertvector(v, bf16x2_t); return __builtin_bit_cast(unsigned, b); }
__device__ __forceinline__ int crow(int r, int hi) { return (r & 3) + 8 * (r >> 2) + 4 * hi; }
__device__ __forceinline__ s16x4 ds_tr(const LAS unsigned char* p) { return __builtin_bit_cast(s16x4, __builtin_amdgcn_ds_read_tr16_b64_v4i16((LAS s16x4*)p)); }
__device__ __forceinline__ bf16x8 mk8(s16x4 lo, s16x4 hi) { return (bf16x8){lo[0], lo[1], lo[2], lo[3], hi[0], hi[1], hi[2], hi[3]}; }
__device__ __forceinline__ bf16x8 pack_step(const f32x16& x, int s) {
    v4u p; p.x = cvtpk(x[8 * s], x[8 * s + 1]); p.y = cvtpk(x[8 * s + 2], x[8 * s + 3]); p.z = cvtpk(x[8 * s + 4], x[8 * s + 5]); p.w = cvtpk(x[8 * s + 6], x[8 * s + 7]);
    return __builtin_bit_cast(bf16x8, p);
}
#define MFMA32(a, b, c) __builtin_amdgcn_mfma_f32_32x32x16_bf16((a), (b), (c), 0, 0, 0)
__device__ __forceinline__ float log2_gamma(int h) { return log2f(1.f - exp2f(-5.f - (float)h)); }

constexpr int AT_V0 = 49152, AT_V1 = 49152 + 24576 + 128, AT_OSC = 100352;
static_assert(AT_V1 + 24576 <= AT_OSC && AT_OSC + 7 * 4352 <= RING_BYTES && EXB_OFF + 4352 <= LDS_BYTES, "attention LDS map");
struct AttnIds { int g, b, h, r, np; };
__device__ __forceinline__ AttnIds attn_ids(int uid) { AttnIds a; a.g = uid >> 9; const int rem = uid & 511, bh = rem >> 4, rn = rem & 15, npc = 16 >> (2 * a.g); a.b = bh >> 3; a.h = bh & 7; a.r = rn / npc; a.np = rn % npc; return a; }
__device__ __forceinline__ void attn_fetch(Frame& F, const AttnIds& a, v4u (&kreg)[6], v4u (&vreg)[6]) {
    const bf16* ZB = (const bf16*)(F.ws + WS_ZB); const int dsh = 2 * a.g; const size_t brow = (size_t)a.b * SEQ;
#pragma unroll
    for (int i = 0; i < 6; ++i) { const int c = F.tid + 512 * i, key = c >> 3, ch = c & 7; int uk = 256 * a.np - 128 + key; uk = uk < 0 ? 0 : uk;
        const bf16* src = ZB + (brow + a.r + ((size_t)uk << dsh)) * DIN + a.h * 64 + ch * 8;
        kreg[i] = *(const GAS v4u*)(src + C_KA); vreg[i] = *(const GAS v4u*)(src + C_VA); }
}
__device__ __forceinline__ void attn_stage(Frame& F, const v4u (&kreg)[6], const v4u (&vreg)[6]) {
#pragma unroll
    for (int i = 0; i < 6; ++i) { const int c = F.tid + 512 * i, key = c >> 3, ch = c & 7;
        *(LAS v4u*)(F.lds + key * 128 + ((ch ^ ((key >> 1) & 7)) << 4)) = kreg[i];
        *(LAS v4u*)(F.lds + ((ch >> 2) ? AT_V1 : AT_V0) + key * 64 + ((ch & 3) << 4)) = vreg[i]; }
}
__device__ __forceinline__ void attn_compute(Frame& F, const AttnIds& a, const bf16x8 (&qf)[4]) {
    const int g = a.g, b = a.b, h = a.h, r = a.r, np = a.np;
    const int dsh = 2 * g;
    bf16* OG = (bf16*)(F.ws + WS_OG) + (size_t)g * MP * 512; float* LSE = (float*)(F.ws + WS_LSE) + (size_t)g * MP * 8;
    const int lane = F.lane, w = F.wave, r32 = lane & 31, hi = lane >> 5;
    LAS unsigned char* Kl = F.lds;
    const size_t brow = (size_t)b * SEQ;
    const size_t qrow = brow + r + ((size_t)(256 * np + 32 * w + r32) << dsh);
    f32x16 p[5];
#pragma unroll
    for (int kb = 0; kb < 5; ++kb) {
        f32x16 a = {};
        const int key = 32 * w + 32 * kb + r32;
#pragma unroll
        for (int d0 = 0; d0 < 4; ++d0) { const bf16x8 kf = *(const LAS bf16x8*)(Kl + key * 128 + (((2 * d0 + hi) ^ ((key >> 1) & 7)) << 4)); a = MFMA32(kf, qf[d0], a); }
        p[kb] = a;
    }
    float mx = -INFINITY;
#pragma unroll
    for (int kb = 0; kb < 5; ++kb) { const bool blk_dead = (np == 0) && (kb < 4 - w);
#pragma unroll
        for (int rg = 0; rg < 16; ++rg) { const int c = crow(rg, hi); bool ok = !blk_dead; if (kb == 0) ok = ok && (c >= r32); if (kb == 4) ok = ok && (c <= r32);
            const float v = ok ? p[kb][rg] : -INFINITY; p[kb][rg] = v; mx = fmaxf(mx, v); } }
    mx = fmaxf(mx, __shfl_xor(mx, 32));
    float l = 0.f;
#pragma unroll
    for (int kb = 0; kb < 5; ++kb)
#pragma unroll
        for (int rg = 0; rg < 16; ++rg) { const float e = __builtin_amdgcn_exp2f(p[kb][rg] - mx); p[kb][rg] = e; l += e; }
    l += __shfl_xor(l, 32);
    f32x16 o[2]; o[0] = (f32x16){}; o[1] = (f32x16){};
    const int gidx = lane >> 4, ql = (lane & 15) >> 2, pl = lane & 3;
    const int voff = (4 * hi + ql) * 64 + (16 * (gidx & 1) + 4 * pl) * 2;
#pragma unroll
    for (int kb = 0; kb < 5; ++kb)
#pragma unroll
        for (int s = 0; s < 2; ++s) { const bf16x8 pf = pack_step(p[kb], s);
#pragma unroll
            for (int dh = 0; dh < 2; ++dh) { const LAS unsigned char* vb = F.lds + (dh ? AT_V1 : AT_V0) + (32 * w + 32 * kb + 16 * s) * 64 + voff;
                const bf16x8 vf = mk8(ds_tr(vb), ds_tr(vb + 8 * 64)); o[dh] = MFMA32(vf, pf, o[dh]); } }
    const float inv = 1.f / l;
    LAS unsigned char* osc = F.lds + (w < 7 ? AT_OSC + w * 4352 : EXB_OFF);
#pragma unroll
    for (int dh = 0; dh < 2; ++dh)
#pragma unroll
        for (int t = 0; t < 4; ++t) { const int d = 32 * dh + 8 * t + 4 * hi;
            const unsigned lo = cvtpk(o[dh][4 * t] * inv, o[dh][4 * t + 1] * inv), hi2 = cvtpk(o[dh][4 * t + 2] * inv, o[dh][4 * t + 3] * inv);
            *(LAS unsigned long long*)(osc + r32 * 136 + d * 2) = (unsigned long long)lo | ((unsigned long long)hi2 << 32); }
    if (hi == 0) LSE[qrow * 8 + h] = mx + log2f(l);
    asm volatile("s_waitcnt lgkmcnt(0)" ::: "memory");
#pragma unroll
    for (int j = 0; j < 4; ++j) { const int rr = (lane >> 3) + 8 * j, ch = lane & 7;
        const LAS unsigned long long* s8 = (const LAS unsigned long long*)(osc + rr * 136 + ch * 16);
        v4u val; { const unsigned long long x0 = s8[0], x1 = s8[1]; val.x = (unsigned)x0; val.y = (unsigned)(x0 >> 32); val.z = (unsigned)x1; val.w = (unsigned)(x1 >> 32); }
        const size_t qr = brow + r + ((size_t)(256 * np + 32 * w + rr) << dsh);
        *(GAS v4u*)(OG + qr * 512 + h * 64 + ch * 8) = val; }
}
__device__ __forceinline__ void attn_qfetch(Frame& F, const AttnIds& a, bf16x8 (&qf)[4]) {
    const bf16* ZB = (const bf16*)(F.ws + WS_ZB); const int r32 = F.lane & 31, hi = F.lane >> 5;
    const size_t qrow = (size_t)a.b * SEQ + a.r + ((size_t)(256 * a.np + 32 * F.wave + r32) << (2 * a.g));
#pragma unroll
    for (int d0 = 0; d0 < 4; ++d0) qf[d0] = *(const GAS bf16x8*)(ZB + qrow * DIN + C_QA + a.h * 64 + d0 * 16 + hi * 8);
}
__device__ __forceinline__ void attn_prompt_units(Frame& F) {
    const int per = (1536 + F.G - 1) / F.G, u0 = F.vcu * per, u1 = (u0 + per < 1536) ? u0 + per : 1536;
    if (u0 >= u1) return;
    v4u kreg[6], vreg[6]; bf16x8 qn[4];
    attn_fetch(F, attn_ids(u0), kreg, vreg); attn_qfetch(F, attn_ids(u0), qn);
#pragma unroll 1
    for (int uid = u0; uid < u1; ++uid) {
        const AttnIds a = attn_ids(uid);
        bf16x8 qf[4];
#pragma unroll
        for (int d0 = 0; d0 < 4; ++d0) qf[d0] = qn[d0];
        attn_stage(F, kreg, vreg);
        __syncthreads();
        if (uid + 1 < u1) { attn_fetch(F, attn_ids(uid + 1), kreg, vreg); attn_qfetch(F, attn_ids(uid + 1), qn); }
        attn_compute(F, a, qf);
        __syncthreads();
    }
}
__device__ __forceinline__ void combine_prompt(Frame& F) {
    const bf16* OG = (const bf16*)(F.ws + WS_OG); const float* LSE = (const float*)(F.ws + WS_LSE); bf16* CATB = (bf16*)(F.ws + WS_CATB);
    const int gt = (F.vcu * NWAVES + F.wave) * 64 + F.lane, NT = F.G * NWAVES * 64;
    for (int it0 = gt; it0 < MP * 64; it0 += 8 * NT) {
        float l0[8], l1[8], l2[8]; v4u a[8], b[8], c[8];
#pragma unroll
        for (int q = 0; q < 8; ++q) { const int it = it0 + q * NT; const int row = (it < MP * 64 ? it : gt) >> 6, hc = it & 63, h = hc >> 3;
            l0[q] = *(const GAS float*)(LSE + (size_t)row * 8 + h); l1[q] = *(const GAS float*)(LSE + ((size_t)MP + row) * 8 + h); l2[q] = *(const GAS float*)(LSE + ((size_t)2 * MP + row) * 8 + h);
            a[q] = *(const GAS v4u*)(OG + (size_t)row * 512 + hc * 8); b[q] = *(const GAS v4u*)(OG + ((size_t)MP + row) * 512 + hc * 8); c[q] = *(const GAS v4u*)(OG + ((size_t)2 * MP + row) * 512 + hc * 8); }
        __builtin_amdgcn_sched_barrier(0);
#pragma unroll
        for (int q = 0; q < 8; ++q) { const int it = it0 + q * NT; if (it >= MP * 64) break; const int row = it >> 6, hc = it & 63;
            const float m = fmaxf(l0[q], fmaxf(l1[q], l2[q])); float w0 = __builtin_amdgcn_exp2f(l0[q] - m), w1 = __builtin_amdgcn_exp2f(l1[q] - m), w2 = __builtin_amdgcn_exp2f(l2[q] - m); const float inv = 1.f / (w0 + w1 + w2); w0 *= inv; w1 *= inv; w2 *= inv;
            v4u o;
#pragma unroll
            for (int e = 0; e < 4; ++e) { const float x0 = w0 * __uint_as_float(a[q][e] << 16) + w1 * __uint_as_float(b[q][e] << 16) + w2 * __uint_as_float(c[q][e] << 16);
                const float x1 = w0 * __uint_as_float(a[q][e] & 0xffff0000u) + w1 * __uint_as_float(b[q][e] & 0xffff0000u) + w2 * __uint_as_float(c[q][e] & 0xffff0000u); o[e] = cvtpk(x0, x1); }
            *(GAS v4u*)(CATB + (size_t)row * DM + 512 + hc * 8) = o; }
    }
}
__device__ __forceinline__ void ret_upd_unit(Frame& F, int bh, int n) {
    const bf16* ZB = (const bf16*)(F.ws + WS_ZB); float* UPD = (float*)(F.ws + WS_UPD) + ((size_t)bh * 32 + n) * 16384;
    const int tid = F.tid, lane = F.lane, w = F.wave, r32 = lane & 31, hi = lane >> 5;
    const int b = bh >> 2, h = bh & 3; const size_t row0 = (size_t)b * SEQ + 128 * n; const float lg = log2_gamma(h);
    {
        v4u kreg[4], vreg[4];
#pragma unroll
        for (int i = 0; i < 4; ++i) { const int c = tid + 512 * i, tok = c >> 4, ch = c & 15; const bf16* src = ZB + (row0 + tok) * DIN + h * 128 + ch * 8;
            kreg[i] = *(const GAS v4u*)(src + C_KR); vreg[i] = *(const GAS v4u*)(src + C_VR); }
#pragma unroll
        for (int i = 0; i < 4; ++i) { const int c = tid + 512 * i, tok = c >> 4, ch = c & 15; const float dec = exp2f((float)(127 - tok) * lg);
            v4u kk;
#pragma unroll
            for (int e = 0; e < 4; ++e) kk[e] = cvtpk(__uint_as_float(kreg[i][e] << 16) * dec, __uint_as_float(kreg[i][e] & 0xffff0000u) * dec);
            const int dst = (ch >> 2) * 8192 + tok * 64 + ((ch & 3) << 4);
            *(LAS v4u*)(F.lds + dst) = kk; *(LAS v4u*)(F.lds + 32768 + dst) = vreg[i]; }
    }
    __syncthreads();
    const int eb = w >> 1, db0 = 2 * (w & 1);
    const int gidx = lane >> 4, ql = (lane & 15) >> 2, pl = lane & 3;
    const int toff = (4 * hi + ql) * 64 + (16 * (gidx & 1) + 4 * pl) * 2;
    f32x16 acc[2]; acc[0] = (f32x16){}; acc[1] = (f32x16){};
#pragma unroll
    for (int s = 0; s < 8; ++s) { const LAS unsigned char* vb = F.lds + 32768 + eb * 8192 + (16 * s) * 64 + toff; const bf16x8 vf = mk8(ds_tr(vb), ds_tr(vb + 8 * 64));
#pragma unroll
        for (int q = 0; q < 2; ++q) { const LAS unsigned char* kb = F.lds + (db0 + q) * 8192 + (16 * s) * 64 + toff; const bf16x8 kf = mk8(ds_tr(kb), ds_tr(kb + 8 * 64)); acc[q] = MFMA32(vf, kf, acc[q]); } }
#pragma unroll
    for (int q = 0; q < 2; ++q)
#pragma unroll
        for (int rg = 0; rg < 16; ++rg) UPD[(size_t)(32 * eb + crow(rg, hi)) * 128 + 32 * (db0 + q) + r32] = acc[q][rg];
    __syncthreads();
}
__device__ __forceinline__ void ret_scan(Frame& F, float* pret) {
    const float* UPD = (const float*)(F.ws + WS_UPD); bf16* ST = (bf16*)(F.ws + WS_ST);
    const int gt = (F.vcu * NWAVES + F.wave) * 64 + F.lane, NT = F.G * NWAVES * 64;
    for (int it = gt; it < 16 * 16384; it += NT) { const int bh = it >> 14, ed = it & 16383, e = ed >> 7, d = ed & 127;
        const float cd = exp2f(128.f * log2_gamma(bh & 3));
        float u[32];
#pragma unroll
        for (int n = 0; n < 32; ++n) u[n] = UPD[((size_t)bh * 32 + n) * 16384 + ed];
        float S = 0.f;
#pragma unroll
        for (int n = 0; n < 32; ++n) { ST[((size_t)bh * 32 + n) * 16384 + ed] = (bf16)f2bf(S); S = cd * S + u[n]; }
        pret[(size_t)bh * 16384 + d * 128 + e] = S; }
}
__device__ __forceinline__ void ret_out_pair(Frame& F, int upair, const float* gnw) {
    const bf16* ZB = (const bf16*)(F.ws + WS_ZB); bf16* CATB = (bf16*)(F.ws + WS_CATB);
    const int tid = F.tid, lane = F.lane, w = F.wave, r32 = lane & 31, hi = lane >> 5, qd = w >> 2, wq = w & 3, tq = tid & 255;
    const int unit = 2 * upair + qd, bh = unit >> 5, n = unit & 31, b = bh >> 2, h = bh & 3;
    const size_t row0 = (size_t)b * SEQ + 128 * n; const float lg = log2_gamma(h);
    const bf16* STu = (const bf16*)(F.ws + WS_ST) + ((size_t)bh * 32 + n) * 16384;
    LAS unsigned char* Vl = F.lds + qd * 32768;
    {
        v4u vreg[8];
#pragma unroll
        for (int i = 0; i < 8; ++i) { const int c = tq + 256 * i, tok = c >> 4, ch = c & 15; vreg[i] = *(const GAS v4u*)(ZB + (row0 + tok) * DIN + C_VR + h * 128 + ch * 8); }
#pragma unroll
        for (int i = 0; i < 8; ++i) { const int c = tq + 256 * i, tok = c >> 4, ch = c & 15; *(LAS v4u*)(Vl + (ch >> 2) * 8192 + tok * 64 + ((ch & 3) << 4)) = vreg[i]; }
    }
    const int iq = 32 * wq + r32; const size_t qrow = row0 + iq;
    bf16x8 qf[8];
#pragma unroll
    for (int ks = 0; ks < 8; ++ks) qf[ks] = *(const GAS bf16x8*)(ZB + qrow * DIN + C_QR + h * 128 + ks * 16 + hi * 8);
    __syncthreads();
    f32x16 acc[4];
#pragma unroll
    for (int eb = 0; eb < 4; ++eb) { f32x16 a = {};
        bf16x8 sf[8];
#pragma unroll
        for (int ks = 0; ks < 8; ++ks) sf[ks] = *(const GAS bf16x8*)(STu + (size_t)(32 * eb + r32) * 128 + ks * 16 + hi * 8);
        __builtin_amdgcn_sched_barrier(0);
#pragma unroll
        for (int ks = 0; ks < 8; ++ks) a = MFMA32(sf[ks], qf[ks], a);
        acc[eb] = a; __builtin_amdgcn_sched_barrier(0); }
    { const float cdec = exp2f((float)(iq + 1) * lg);
#pragma unroll
        for (int eb = 0; eb < 4; ++eb)
#pragma unroll
            for (int rg = 0; rg < 16; ++rg) acc[eb][rg] *= cdec; }
    const int gidx = lane >> 4, ql = (lane & 15) >> 2, pl = lane & 3;
    const int toff = (4 * hi + ql) * 64 + (16 * (gidx & 1) + 4 * pl) * 2;
#pragma unroll 1
    for (int kb = 0; kb <= wq; ++kb) {
        {
            f32x16 p = {};
            bf16x8 kfr[8];
#pragma unroll
            for (int ks = 0; ks < 8; ++ks) kfr[ks] = *(const GAS bf16x8*)(ZB + (row0 + 32 * kb + r32) * DIN + C_KR + h * 128 + ks * 16 + hi * 8);
            __builtin_amdgcn_sched_barrier(0);
#pragma unroll
            for (int ks = 0; ks < 8; ++ks) p = MFMA32(kfr[ks], qf[ks], p);
#pragma unroll
            for (int rg = 0; rg < 16; ++rg) { const int j = 32 * kb + crow(rg, hi); p[rg] = (j <= iq) ? p[rg] * __builtin_amdgcn_exp2f((float)(iq - j) * lg) : 0.f; }
#pragma unroll
            for (int s = 0; s < 2; ++s) { const bf16x8 pf = pack_step(p, s);
#pragma unroll
                for (int eb = 0; eb < 4; ++eb) { const LAS unsigned char* vb = Vl + eb * 8192 + (32 * kb + 16 * s) * 64 + toff; const bf16x8 vf = mk8(ds_tr(vb), ds_tr(vb + 8 * 64)); acc[eb] = MFMA32(vf, pf, acc[eb]); } }
        }
    }
    float s1 = 0.f;
#pragma unroll
    for (int eb = 0; eb < 4; ++eb)
#pragma unroll
        for (int rg = 0; rg < 16; ++rg) s1 += acc[eb][rg];
    s1 += __shfl_xor(s1, 32); const float mu = s1 * (1.f / 128.f);
    float s2 = 0.f;
#pragma unroll
    for (int eb = 0; eb < 4; ++eb)
#pragma unroll
        for (int rg = 0; rg < 16; ++rg) { const float dlt = acc[eb][rg] - mu; s2 += dlt * dlt; }
    s2 += __shfl_xor(s2, 32); const float rstd = 1.f / sqrtf(s2 * (1.f / 128.f) + EPS);
#pragma unroll
    for (int eb = 0; eb < 4; ++eb)
#pragma unroll
        for (int t = 0; t < 4; ++t) { const int e = 32 * eb + 8 * t + 4 * hi;
            const unsigned long long gg = *(const GAS unsigned long long*)(ZB + qrow * DIN + C_GR + h * 128 + e);
            const f32x4 gw = *(const GAS f32x4*)(gnw + h * 128 + e);
            float gv[4] = {__uint_as_float((unsigned)gg << 16), __uint_as_float((unsigned)gg & 0xffff0000u), __uint_as_float((unsigned)(gg >> 32) << 16), __uint_as_float((unsigned)(gg >> 32) & 0xffff0000u)};
            float y[4];
#pragma unroll
            for (int k = 0; k < 4; ++k) y[k] = silu_f(gv[k]) * ((acc[eb][4 * t + k] - mu) * rstd * gw[k]);
            *(GAS unsigned long long*)(CATB + qrow * DM + h * 128 + e) = (unsigned long long)cvtpk(y[0], y[1]) | ((unsigned long long)cvtpk(y[2], y[3]) << 32); }
    __syncthreads();
}
#define MFMA16(a, b, c) __builtin_amdgcn_mfma_f32_16x16x32_bf16((a), (b), (c), 0, 0, 0)
template <int KW, class Pre> __device__ __forceinline__ f32x4 smp_task_core(Frame& F, const bf16* A, const bf16* Bt, int K, int wrow, Pre&& pre) {
#if defined(DBG_NAIVE_CORE)
    { const int lane = F.lane, fr = lane & 15, fq = lane >> 4, row = 16 * F.wave + fr; f32x4 s;
      for (int i = 0; i < 4; ++i) { const int wr_i = __shfl(wrow, 4 * fq + i); float a = 0.f;
          for (int k = 0; k < K; ++k) a += __uint_as_float((unsigned)A[(size_t)row * K + k] << 16) * __uint_as_float((unsigned)Bt[(size_t)wr_i * K + k] << 16);
          s[i] = a; }
      __syncthreads(); return s; }
#endif
    const int lane = F.lane, w = F.wave, fr = lane & 15, fq = lane >> 4;
    const bf16* ap = A + (size_t)fr * K + w * KW + 8 * fq; const bf16* bp = Bt + (size_t)wrow * K + w * KW + 8 * fq;
    f32x4 acc[8];
#pragma unroll
    for (int mb = 0; mb < 8; ++mb) acc[mb] = (f32x4){0.f, 0.f, 0.f, 0.f};
    static_assert(KW % 32 == 0 && KW / 32 <= 4, "K slice");
    constexpr int NS = KW / 32;
    bf16x8 bf[NS], af[NS][8];
#pragma unroll
    for (int q = 0; q < NS; ++q) { bf[q] = *(const GAS bf16x8*)(bp + q * 32);
#pragma unroll
        for (int mb = 0; mb < 8; ++mb) af[q][mb] = *(const GAS bf16x8*)(ap + (size_t)(16 * mb) * K + q * 32); }
    __builtin_amdgcn_sched_barrier(0);
#pragma unroll
    for (int q = 0; q < NS; ++q)
#pragma unroll
        for (int mb = 0; mb < 8; ++mb) acc[mb] = MFMA16(bf[q], af[q][mb], acc[mb]);
    __builtin_amdgcn_sched_barrier(0);
    pre();
    __builtin_amdgcn_sched_barrier(0);
    LAS f32x4* red = (LAS f32x4*)F.lds;
#pragma unroll
    for (int mb = 0; mb < 8; ++mb) red[(w * 8 + mb) * 64 + lane] = acc[mb];
    __syncthreads();
    f32x4 s = red[(0 * 8 + w) * 64 + lane];
#pragma unroll
    for (int ww = 1; ww < 8; ++ww) s += red[(ww * 8 + w) * 64 + lane];
    return s;
}
struct SmpSS { f32x4 a, b, c, d; };
__device__ __forceinline__ SmpSS smp_rstd_issue(Frame& F) {
    const float* SSs = (const float*)(F.ws + WS_SMP + SM_SS); const int fr = F.lane & 15, fq = F.lane >> 4, row = 16 * F.wave + fr;
    const GAS f32x4* p = (const GAS f32x4*)(SSs + (size_t)row * 64 + 16 * fq); SmpSS r; r.a = p[0]; r.b = p[1]; r.c = p[2]; r.d = p[3]; return r;
}
__device__ __forceinline__ float smp_rstd_finish(const SmpSS& q) {
    const f32x4 a = q.a, b = q.b, c = q.c, d = q.d;
    float s = (((a[0] + a[1]) + (a[2] + a[3])) + ((b[0] + b[1]) + (b[2] + b[3]))) + (((c[0] + c[1]) + (c[2] + c[3])) + ((d[0] + d[1]) + (d[2] + d[3])));
    s += __shfl_xor(s, 16); s += __shfl_xor(s, 32); return 1.f / sqrtf(s * (1.f / DM) + EPS);
}
__device__ __forceinline__ float smp_rstd(Frame& F) { return smp_rstd_finish(smp_rstd_issue(F)); }

__device__ __forceinline__ void smp_load_a(Frame& F, const bf16* A, bf16x8 (&af)[4][8]) {
    const int fr = F.lane & 15, fq = F.lane >> 4; const bf16* ap = A + (size_t)fr * DM + F.wave * 128 + 8 * fq;
#pragma unroll
    for (int q = 0; q < 4; ++q)
#pragma unroll
        for (int mb = 0; mb < 8; ++mb) af[q][mb] = *(const GAS bf16x8*)(ap + (size_t)(16 * mb) * DM + q * 32);
}
__device__ __forceinline__ void smp_load_b(Frame& F, const bf16* Bt, int wrow, bf16x8 (&bf)[4]) {
    const int fq = F.lane >> 4; const bf16* bp = Bt + (size_t)wrow * DM + F.wave * 128 + 8 * fq;
#pragma unroll
    for (int q = 0; q < 4; ++q) bf[q] = *(const GAS bf16x8*)(bp + q * 32);
}
template <class Pre> __device__ __forceinline__ f32x4 smp_mma_reduce(Frame& F, const bf16x8 (&af)[4][8], const bf16x8 (&bf)[4], Pre&& pre) {
    const int lane = F.lane, w = F.wave;
    f32x4 acc[8];
#pragma unroll
    for (int mb = 0; mb < 8; ++mb) acc[mb] = (f32x4){0.f, 0.f, 0.f, 0.f};
#pragma unroll
    for (int q = 0; q < 4; ++q)
#pragma unroll
        for (int mb = 0; mb < 8; ++mb) acc[mb] = MFMA16(bf[q], af[q][mb], acc[mb]);
    __builtin_amdgcn_sched_barrier(0);
    pre();
    __builtin_amdgcn_sched_barrier(0);
    LAS f32x4* red = (LAS f32x4*)F.lds;
#pragma unroll
    for (int mb = 0; mb < 8; ++mb) red[(w * 8 + mb) * 64 + lane] = acc[mb];
    __syncthreads();
    f32x4 s = red[(0 * 8 + w) * 64 + lane];
#pragma unroll
    for (int ww = 1; ww < 8; ++ww) s += red[(ww * 8 + w) * 64 + lane];
    return s;
}

#if defined(DBG_RSTD_DIRECT)
#define smp_rstd smp_rstd_direct
__device__ __forceinline__ float smp_rstd_direct(Frame& F) {
    const float* XSf = (const float*)(F.ws + WS_SMP + SM_X); const int fr = F.lane & 15, fq = F.lane >> 4, row = 16 * F.wave + fr;
    const GAS f32x4* p = (const GAS f32x4*)(XSf + (size_t)row * DM + 256 * fq); float s = 0.f;
    for (int i = 0; i < 64; ++i) { const f32x4 a = p[i]; s += (a[0] * a[0] + a[1] * a[1]) + (a[2] * a[2] + a[3] * a[3]); }
    s += __shfl_xor(s, 16); s += __shfl_xor(s, 32); return 1.f / sqrtf(s * (1.f / DM) + EPS);
}
#endif
__device__ __forceinline__ int smp_pair_wrow(int task, int fr) { const int pn = task >> 4, j0 = (task & 15) * 8; return pn * 256 + (fr < 8 ? j0 + fr : 128 + j0 + (fr - 8)); }
__device__ __forceinline__ void sample_win_tasks(Frame& F, int task0, int tstep, const bf16* Wl, float* swk, float* swv) {
    if (task0 >= 224) return;
    const bf16* XSB = (const bf16*)(F.ws + WS_SMP + SM_HB); bf16* ZS = (bf16*)(F.ws + WS_SMP + SM_ZB);
    const float* T64 = (const float*)(F.ws + WS_T64); const float* T32 = (const float*)(F.ws + WS_T32);
    const int lane = F.lane, fr = lane & 15, fq = lane >> 4;
    bf16x8 af[4][8], bf[4];
    smp_load_a(F, XSB, af); smp_load_b(F, Wl, smp_pair_wrow(task0, fr), bf);
#pragma unroll 1
    for (int task = task0; task < 224; task += tstep) {
        const bool more = task + tstep < 224; bf16x8 bn[4];
        if (more) smp_load_b(F, Wl, smp_pair_wrow(task + tstep, fr), bn);
        const int pn = task >> 4, j0 = (task & 15) * 8;
        const int bj = fq >> 1, j = j0 + 4 * (fq & 1);
        const bool rot = (pn < 4) || (pn >= 8 && pn < 12);
        int feat; const float* T = T64; int tstride = 64, fidx = 0; float sc = 1.f;
        if (pn < 4) { feat = (pn >> 1) * 512 + (2 * (pn & 1) + (j >> 6)) * 128 + (j & 63) + 64 * bj; fidx = j & 63; sc = (pn >= 2) ? pg8::KR_SCALE : 1.f; }
        else if (pn >= 8 && pn < 12) { feat = 2048 + ((pn - 8) >> 1) * 512 + (4 * (pn & 1) + (j >> 5)) * 64 + (j & 31) + 32 * bj; fidx = j & 31; T = T32; tstride = 32; sc = (pn < 10) ? pg8::QA_SCALE : 1.f; }
        else feat = pn * 256 + 128 * bj + j;
        const int row = 16 * F.wave + fr;
        SmpSS ssq; f32x4 cs0, cs1;
        const float* tp = T + ((size_t)(SEQ + (row & 3)) * tstride + fidx) * 2;
        f32x4 v = smp_mma_reduce(F, af, bf, [&]() { ssq = smp_rstd_issue(F); cs0 = *(const GAS f32x4*)tp; cs1 = *(const GAS f32x4*)(tp + 4); });
        v *= smp_rstd_finish(ssq);
        f32x4 pr; pr[0] = __shfl_xor(v[0], 32); pr[1] = __shfl_xor(v[1], 32); pr[2] = __shfl_xor(v[2], 32); pr[3] = __shfl_xor(v[3], 32);
        if (rot) {
            const float c[4] = {cs0[0], cs0[2], cs1[0], cs1[2]}, s[4] = {cs0[1], cs0[3], cs1[1], cs1[3]};
#pragma unroll
            for (int i = 0; i < 4; ++i) v[i] = (bj == 0 ? (v[i] * c[i] - pr[i] * s[i]) : (v[i] * c[i] + pr[i] * s[i])) * sc; }
        *(GAS unsigned long long*)(ZS + (size_t)row * DIN + feat) = (unsigned long long)cvtpk(v[0], v[1]) | ((unsigned long long)cvtpk(v[2], v[3]) << 32);
        if (pn == 10 || pn == 11) *(GAS f32x4*)(swk + (size_t)row * 512 + (feat - C_KA)) = v;
        if (pn >= 12) *(GAS f32x4*)(swv + (size_t)row * 512 + (feat - C_VA)) = v;
        __syncthreads();
        if (more) {
#pragma unroll
            for (int q = 0; q < 4; ++q) bf[q] = bn[q]; }
    }
}
template <int KW> __device__ __forceinline__ void sample_resid_task(Frame& F, const bf16* A, const bf16* Bt, int K, int task) {
    float* XS = (float*)(F.ws + WS_SMP + SM_X); bf16* XSB = (bf16*)(F.ws + WS_SMP + SM_HB); float* SSs = (float*)(F.ws + WS_SMP + SM_SS);
    const int lane = F.lane, w = F.wave, fr = lane & 15, fq = lane >> 4, cg = task >> 2, rq = task & 3;
    constexpr int NS = KW / 32;
    const bf16* ap = A + (size_t)(32 * rq + fr) * K + w * KW + 8 * fq; const bf16* bp = Bt + (size_t)(16 * cg + fr) * K + w * KW + 8 * fq;
    bf16x8 bf[NS], a0[NS], a1[NS];
#pragma unroll
    for (int s = 0; s < NS; ++s) { bf[s] = *(const GAS bf16x8*)(bp + s * 32); a0[s] = *(const GAS bf16x8*)(ap + s * 32); a1[s] = *(const GAS bf16x8*)(ap + (size_t)16 * K + s * 32); }
    __builtin_amdgcn_sched_barrier(0);
    f32x4 acc0 = {0.f, 0.f, 0.f, 0.f}, acc1 = acc0;
#pragma unroll
    for (int s = 0; s < NS; ++s) { acc0 = MFMA16(bf[s], a0[s], acc0); acc1 = MFMA16(bf[s], a1[s], acc1); }
    LAS f32x4* red = (LAS f32x4*)F.lds;
    red[(w * 2 + 0) * 64 + lane] = acc0; red[(w * 2 + 1) * 64 + lane] = acc1;
    __syncthreads();
    if (w < 2) {
        f32x4 d = red[(0 * 2 + w) * 64 + lane];
#pragma unroll
        for (int ww = 1; ww < 8; ++ww) d += red[(ww * 2 + w) * 64 + lane];
        const int row = 32 * rq + 16 * w + fr;
        float* xp = XS + (size_t)row * DM + 16 * cg + 4 * fq;
        const f32x4 x = *(const GAS f32x4*)xp + d;
        *(GAS f32x4*)xp = x;
        *(GAS unsigned long long*)(XSB + (size_t)row * DM + 16 * cg + 4 * fq) = (unsigned long long)cvtpk(x[0], x[1]) | ((unsigned long long)cvtpk(x[2], x[3]) << 32);
        float s = (x[0] * x[0] + x[1] * x[1]) + (x[2] * x[2] + x[3] * x[3]); s += __shfl_xor(s, 16); s += __shfl_xor(s, 32);
        if (fq == 0) SSs[(size_t)row * 64 + cg] = s;
    }
    __syncthreads();
}

#if defined(DBG_NAIVE_RESID)
__device__ __forceinline__ void sample_resid_naive(Frame& F, const bf16* A, const bf16* Bt, int K) {
    float* XSf = (float*)(F.ws + WS_SMP + SM_X); bf16* XSB = (bf16*)(F.ws + WS_SMP + SM_HB);
    const int gt = (F.vcu * NWAVES + F.wave) * 64 + F.lane, NT = F.G * NWAVES * 64;
    for (int it = gt; it < MS * DM; it += NT) { const int row = it / DM, col = it % DM; float s = 0.f;
        for (int k = 0; k < K; ++k) s += __uint_as_float((unsigned)A[(size_t)row * K + k] << 16) * __uint_as_float((unsigned)Bt[(size_t)col * K + k] << 16);
        const float x = XSf[it] + s; XSf[it] = x; XSB[it] = (bf16)f2bf(x); }
}
#endif
__device__ __forceinline__ void sample_up_tasks(Frame& F, int task0, int tstep, const bf16* Wl, const float* sconv_in, const float* cw, const float* cb, float* sconv_out) {
    if (task0 >= 352) return;
    const bf16* XSB = (const bf16*)(F.ws + WS_SMP + SM_HB); bf16* AS = (bf16*)(F.ws + WS_SMP + SM_AB);
    const int lane = F.lane, fr = lane & 15, fq = lane >> 4;
    bf16x8 af[4][8], bf[4];
    smp_load_a(F, XSB, af); smp_load_b(F, Wl, smp_pair_wrow(task0, fr), bf);
#pragma unroll 1
    for (int task = task0; task < 352; task += tstep) {
        const bool more = task + tstep < 352; bf16x8 bn[4];
        if (more) smp_load_b(F, Wl, smp_pair_wrow(task + tstep, fr), bn);
        const int pn = task >> 4, j0 = (task & 15) * 8;
        const int row = 16 * F.wave + fr, b = row >> 2, t = row & 3;
        const int feat = (fq >> 1) * DFF + 128 * pn + j0 + 4 * (fq & 1);
        SmpSS ssq; f32x4 c0, c1, w0, w1, w2, bb;
        const f32x4 u_raw = smp_mma_reduce(F, af, bf, [&]() { ssq = smp_rstd_issue(F);
            c0 = *(const GAS f32x4*)(sconv_in + ((size_t)b * 2 + 0) * DUP + feat); c1 = *(const GAS f32x4*)(sconv_in + ((size_t)b * 2 + 1) * DUP + feat);
            w0 = *(const GAS f32x4*)(cw + feat); w1 = *(const GAS f32x4*)(cw + DUP + feat); w2 = *(const GAS f32x4*)(cw + 2 * DUP + feat); bb = *(const GAS f32x4*)(cb + feat); });
        const f32x4 u = u_raw * smp_rstd_finish(ssq);
        f32x4 r;
#pragma unroll
        for (int i = 0; i < 4; ++i) { const float s1 = __shfl_up(u[i], 1, 16), s2 = __shfl_up(u[i], 2, 16);
            const float p1 = (t >= 1) ? s1 : c1[i], p2 = (t >= 2) ? s2 : (t == 1 ? c1[i] : c0[i]);
            r[i] = bb[i] + w0[i] * p2 + w1[i] * p1 + w2[i] * u[i]; }
        f32x4 pr; pr[0] = __shfl_xor(r[0], 32); pr[1] = __shfl_xor(r[1], 32); pr[2] = __shfl_xor(r[2], 32); pr[3] = __shfl_xor(r[3], 32);
        if (fq < 2) { const int c = 128 * pn + j0 + 4 * fq;
            *(GAS unsigned long long*)(AS + (size_t)row * DFF + c) = (unsigned long long)cvtpk(silu_f(r[0]) * pr[0], silu_f(r[1]) * pr[1]) | ((unsigned long long)cvtpk(silu_f(r[2]) * pr[2], silu_f(r[3]) * pr[3]) << 32); }
        if (t >= 2) *(GAS f32x4*)(sconv_out + ((size_t)b * 2 + (t - 2)) * DUP + feat) = u;
        __syncthreads();
        if (more) {
#pragma unroll
            for (int q = 0; q < 4; ++q) bf[q] = bn[q]; }
    }
}

__device__ __forceinline__ void sample_attn_unit(Frame& F, int b, int h, const float* ck, const float* cv) {
    const bf16* ZS = (const bf16*)(F.ws + WS_SMP + SM_ZB); bf16* CATS = (bf16*)(F.ws + WS_SMP + SM_CATB);
    LAS float* sc = (LAS float*)F.lds; LAS float* part = sc + 4 * 388; LAS float* ml = part + 8 * 64;
    const int lane = F.lane, w = F.wave, t = w & 3, hf = w >> 2, sub = lane >> 4, l16 = lane & 15;
    float q[4];
    { const unsigned long long qq = *(const GAS unsigned long long*)(ZS + (size_t)(b * 4 + t) * DIN + C_QA + h * 64 + 4 * l16);
      q[0] = __uint_as_float((unsigned)qq << 16); q[1] = __uint_as_float((unsigned)qq & 0xffff0000u); q[2] = __uint_as_float((unsigned)(qq >> 32) << 16); q[3] = __uint_as_float((unsigned)(qq >> 32) & 0xffff0000u); }
    const float* ckb = ck + ((size_t)b * WCTX * 8 + h) * 64 + 4 * l16; const float* cvb = cv + ((size_t)b * WCTX * 8 + h) * 64 + 4 * l16;
#pragma unroll 1
    for (int c0 = 0; c0 < 50; c0 += 25) {
        f32x4 kvv[25];
#pragma unroll
        for (int u = 0; u < 25; ++u) { const int k = 4 * (hf + 2 * (c0 + u)) + sub; const int kk = k < 387 ? k : 386;
            const int g = kk / 129, j = kk - 129 * g; const int idx = WCTX + t - (j << (2 * g)); const int ic = idx >= WCTX ? WCTX - 1 : idx;
            kvv[u] = *(const GAS f32x4*)(ckb + (size_t)ic * 512); }
        __builtin_amdgcn_sched_barrier(0);
#pragma unroll
        for (int u = 0; u < 25; ++u) { const int k = 4 * (hf + 2 * (c0 + u)) + sub; const bool valid = k < 387; const int kk = valid ? k : 386;
            const int g = kk / 129, j = kk - 129 * g; const int idx = WCTX + t - (j << (2 * g)); const bool isnew = idx >= WCTX;
            const f32x4 kv = kvv[u];
            float s = q[0] * kv[0] + q[1] * kv[1] + q[2] * kv[2] + q[3] * kv[3];
            s += __shfl_xor(s, 1); s += __shfl_xor(s, 2); s += __shfl_xor(s, 4); s += __shfl_xor(s, 8);
            if (l16 == 0 && valid && !isnew) sc[t * 388 + k] = s; }
        __builtin_amdgcn_sched_barrier(0);
    }
#define SMP_NEWPAIR(pi, kvar, rvar) const bool pv_ = (pi) < t + 3; const int kvar = (pi) <= t ? (pi) : ((pi) == t + 1 ? 129 : 258); const int rvar = (pi) <= t ? t - (pi) : t;
    if (hf == 0) {
#pragma unroll
        for (int i = 0; i < 2; ++i) { SMP_NEWPAIR(4 * i + sub, kn, rn)
            const unsigned long long x = *(const GAS unsigned long long*)(ZS + (size_t)(b * 4 + rn) * DIN + C_KA + h * 64 + 4 * l16);
            float s = q[0] * __uint_as_float((unsigned)x << 16) + q[1] * __uint_as_float((unsigned)x & 0xffff0000u) + q[2] * __uint_as_float((unsigned)(x >> 32) << 16) + q[3] * __uint_as_float((unsigned)(x >> 32) & 0xffff0000u);
            s += __shfl_xor(s, 1); s += __shfl_xor(s, 2); s += __shfl_xor(s, 4); s += __shfl_xor(s, 8);
            if (l16 == 0 && pv_) sc[t * 388 + kn] = s; }
    }
    __syncthreads();
    if (w < 4) {
        float m = -INFINITY;
        for (int k = lane; k < 387; k += 64) m = fmaxf(m, sc[t * 388 + k]);
#pragma unroll
        for (int o = 1; o < 64; o <<= 1) m = fmaxf(m, __shfl_xor(m, o));
        float l = 0.f;
        for (int k = lane; k < 387; k += 64) { const float e = exp2f(sc[t * 388 + k] - m); sc[t * 388 + k] = e; l += e; }
        l = wave_sum(l);
        if (lane == 0) { ml[t] = l; sc[t * 388 + 387] = 0.f; }
    }
    __syncthreads();
    float a4[4] = {0.f, 0.f, 0.f, 0.f};
#pragma unroll 1
    for (int c0 = 0; c0 < 50; c0 += 25) {
        f32x4 vvv[25];
#pragma unroll
        for (int u = 0; u < 25; ++u) { const int k = 4 * (hf + 2 * (c0 + u)) + sub; const int kk = k < 387 ? k : 386;
            const int g = kk / 129, j = kk - 129 * g; const int idx = WCTX + t - (j << (2 * g)); const int ic = idx >= WCTX ? WCTX - 1 : idx;
            vvv[u] = *(const GAS f32x4*)(cvb + (size_t)ic * 512); }
        __builtin_amdgcn_sched_barrier(0);
#pragma unroll
        for (int u = 0; u < 25; ++u) { const int k = 4 * (hf + 2 * (c0 + u)) + sub; const bool valid = k < 387; const int kk = valid ? k : 386;
            const int g = kk / 129, j = kk - 129 * g; const int idx = WCTX + t - (j << (2 * g)); const bool isnew = idx >= WCTX;
            const f32x4 vv = vvv[u];
            const float p = (valid && !isnew) ? sc[t * 388 + kk] : 0.f;
#pragma unroll
            for (int i = 0; i < 4; ++i) a4[i] += p * vv[i]; }
        __builtin_amdgcn_sched_barrier(0);
    }
    if (hf == 0) {
#pragma unroll
        for (int i = 0; i < 2; ++i) { SMP_NEWPAIR(4 * i + sub, kn, rn)
            const unsigned long long x = *(const GAS unsigned long long*)(ZS + (size_t)(b * 4 + rn) * DIN + C_VA + h * 64 + 4 * l16);
            const float p = pv_ ? sc[t * 388 + kn] : 0.f;
            a4[0] += p * __uint_as_float((unsigned)x << 16); a4[1] += p * __uint_as_float((unsigned)x & 0xffff0000u); a4[2] += p * __uint_as_float((unsigned)(x >> 32) << 16); a4[3] += p * __uint_as_float((unsigned)(x >> 32) & 0xffff0000u); }
    }
#undef SMP_NEWPAIR
#pragma unroll
    for (int i = 0; i < 4; ++i) { a4[i] += __shfl_xor(a4[i], 16); a4[i] += __shfl_xor(a4[i], 32); }
    if (lane < 16) { part[w * 64 + 4 * l16 + 0] = a4[0]; part[w * 64 + 4 * l16 + 1] = a4[1]; part[w * 64 + 4 * l16 + 2] = a4[2]; part[w * 64 + 4 * l16 + 3] = a4[3]; }
    __syncthreads();
    if (w < 4) { const float o = (part[w * 64 + lane] + part[(w + 4) * 64 + lane]) / ml[w];
        CATS[(size_t)(b * 4 + w) * DM + 512 + h * 64 + lane] = (bf16)f2bf(o); }
    __syncthreads();
}
__device__ __forceinline__ void sample_ret_unit(Frame& F, int b, int h, const float* s0, float* s1, const float* gnw) {
    const bf16* ZS = (const bf16*)(F.ws + WS_SMP + SM_ZB); bf16* CATS = (bf16*)(F.ws + WS_SMP + SM_CATB);
    LAS float* qs = (LAS float*)F.lds; LAS float* ks = qs + 512; LAS float* vs = ks + 512; LAS float* part = vs + 512; LAS float* ob = part + 512;
    const int tid = F.tid, lane = F.lane, w = F.wave, e = tid & 127, dq = tid >> 7;
    { const int tt = tid >> 7, dd = tid & 127; const bf16* zr = ZS + (size_t)(b * 4 + tt) * DIN + h * 128 + dd;
      qs[tid] = __uint_as_float((unsigned)zr[C_QR] << 16); ks[tid] = __uint_as_float((unsigned)zr[C_KR] << 16); vs[tid] = __uint_as_float((unsigned)zr[C_VR] << 16); }
    const size_t sbase = ((size_t)b * 4 + h) * 16384;
    float S[32];
#pragma unroll
    for (int d = 0; d < 32; ++d) S[d] = s0[sbase + (size_t)(32 * dq + d) * 128 + e];
    const float gam = 1.f - exp2f(-5.f - (float)h);
    __syncthreads();
#pragma unroll 1
    for (int t = 0; t < 4; ++t) {
        const float v = vs[t * 128 + e]; float po = 0.f;
#pragma unroll
        for (int d = 0; d < 32; ++d) { S[d] = gam * S[d] + ks[t * 128 + 32 * dq + d] * v; po += qs[t * 128 + 32 * dq + d] * S[d]; }
        part[dq * 128 + e] = po;
        __syncthreads();
        if (dq == 0) ob[t * 128 + e] = (part[e] + part[128 + e]) + (part[256 + e] + part[384 + e]);
        __syncthreads();
    }
#pragma unroll
    for (int d = 0; d < 32; ++d) s1[sbase + (size_t)(32 * dq + d) * 128 + e] = S[d];
    if (w < 4) { const int t = w; const float a = ob[t * 128 + lane], c = ob[t * 128 + 64 + lane];
        const float mu = wave_sum(a + c) * (1.f / 128.f); const float var = wave_sum((a - mu) * (a - mu) + (c - mu) * (c - mu)) * (1.f / 128.f); const float rstd = 1.f / sqrtf(var + EPS);
        const bf16* zr = ZS + (size_t)(b * 4 + t) * DIN + C_GR + h * 128;
        const float g0 = __uint_as_float((unsigned)zr[lane] << 16), g1 = __uint_as_float((unsigned)zr[64 + lane] << 16);
        CATS[(size_t)(b * 4 + t) * DM + h * 128 + lane] = (bf16)f2bf(silu_f(g0) * ((a - mu) * rstd * gnw[h * 128 + lane]));
        CATS[(size_t)(b * 4 + t) * DM + h * 128 + 64 + lane] = (bf16)f2bf(silu_f(g1) * ((c - mu) * rstd * gnw[h * 128 + 64 + lane])); }
    __syncthreads();
}
#if defined(__HIP_DEVICE_COMPILE__)
#define MK_ASSUME_GLOBAL(p) do { __builtin_assume(!__builtin_amdgcn_is_shared((const void*)(p))); __builtin_assume(!__builtin_amdgcn_is_private((const void*)(p))); } while (0)
#else
#define MK_ASSUME_GLOBAL(p) do { } while (0)
#endif
#define MK_REFRESH() do { int t_; asm volatile("v_mbcnt_lo_u32_b32 %0, -1, 0\n\tv_mbcnt_hi_u32_b32 %0, -1, %0" : "=v"(t_)); t_ += wave_s * 64;     F.tid = t_; F.lane = t_ & 63; F.wave = __builtin_amdgcn_readfirstlane(t_ >> 6); \
    GAS unsigned char* w_ = (GAS unsigned char*)args.ws; asm volatile("" : "+s"(w_)); F.ws = (unsigned char*)w_;     F.ctl = (gu32*)(w_ + WS_CTL); { GAS float* o_ = (GAS float*)args.out; asm volatile("" : "+s"(o_)); outp = (float*)o_; } \
    bx = blockIdx.x; asm volatile("" : "+s"(bx)); F.G = gridDim.x; F.vcu = (F.G % 8 == 0) ? (bx % 8) * (F.G / 8) + bx / 8 : bx; } while (0)
#define MK_FRAME_SETUP() \
    extern __shared__ __attribute__((aligned(16))) unsigned char lds[]; \
    Frame F; F.lds = (LAS unsigned char*)lds; F.MISC = (volatile LAS unsigned*)(F.lds + MISC_OFF); \
    F.tid = threadIdx.x; F.lane = F.tid & 63; F.wave = __builtin_amdgcn_readfirstlane(F.tid >> 6); \
    F.G = gridDim.x; { const int bx = blockIdx.x; F.vcu = (F.G % 8 == 0) ? (bx % 8) * (F.G / 8) + bx / 8 : bx; } \
    F.ws = args.ws; F.ctl = (gu32*)(args.ws + WS_CTL);

enum { I_XP = 0, I_XS = 1, I_CK = 2, I_CV = 3, I_SRET = 4, I_SCONV = 5, I_N1W = 6, I_WIN = 7, I_GNW = 8, I_WOUT = 9, I_N2W = 10, I_WUP = 11, I_CW = 12, I_CB = 13, I_WDN = 14, I_FNW = 15 };
constexpr size_t O_YP = 0, O_YS = O_YP + (size_t)MP * DM, O_PWK = O_YS + (size_t)MS * DM, O_PWV = O_PWK + (size_t)DEPTH * NBATCH * 2048 * 512,
                 O_PRET = O_PWV + (size_t)DEPTH * NBATCH * 2048 * 512, O_PCONV = O_PRET + (size_t)DEPTH * NBATCH * 4 * 16384, O_SWK = O_PCONV + (size_t)DEPTH * NBATCH * 2 * DUP,
                 O_SWV = O_SWK + (size_t)DEPTH * MS * 512, O_SRET = O_SWV + (size_t)DEPTH * MS * 512, O_SCONV = O_SRET + (size_t)DEPTH * DBATCH * 4 * 16384, O_END = O_SCONV + (size_t)DEPTH * DBATCH * 2 * DUP;


__global__ void __launch_bounds__(NWAVES * 64, 2) mk_fwd(Args args) {
    MK_FRAME_SETUP();
#define INP(i) ((const float*)(const GAS float*)args.in[i])
    float* outp = args.out; int bx = blockIdx.x; const int wave_s = __builtin_amdgcn_readfirstlane((int)threadIdx.x >> 6);
    for (int u = F.tid; u < (LDS_BYTES - LDSCTL_OFF) / 4; u += NWAVES * 64) ((LAS unsigned*)(F.lds + LDSCTL_OFF))[u] = 0u;
    __syncthreads();
    XcdBarrier bar = xcd_barrier_post((unsigned*)(F.ctl + CW_BAR), F.MISC + 8);
#define XRES ((float*)(F.ws + WS_XRES))
#define XS ((float*)(F.ws + WS_SMP + SM_X))
    p0_prologue(F, INP(I_WIN), INP(I_WOUT), INP(I_WUP), INP(I_WDN), INP(I_N1W), INP(I_N2W), INP(I_XP));
    { const int gw = F.vcu * NWAVES + F.wave, NGW = F.G * NWAVES;
      for (int r = NGW - 1 - gw; r < MS; r += NGW) { const GAS f32x4* xr = (const GAS f32x4*)(INP(I_XS) + (size_t)r * DM) + F.lane; GAS f32x4* xo = (GAS f32x4*)(XS + (size_t)r * DM) + F.lane;
          GAS unsigned long long* o8 = (GAS unsigned long long*)((bf16*)(F.ws + WS_SMP + SM_HB) + (size_t)r * DM) + F.lane; float s = 0.f;
#pragma unroll
          for (int j = 0; j < 4; ++j) { const f32x4 v = xr[64 * j]; xo[64 * j] = v; s += (v.x * v.x + v.y * v.y) + (v.z * v.z + v.w * v.w); o8[64 * j] = (unsigned long long)pk2(v.x, v.y) | ((unsigned long long)pk2(v.z, v.w) << 32); }
          s = wave_sum(s); ((float*)(F.ws + WS_SMP + SM_SS))[(size_t)r * 64 + F.lane] = (F.lane == 0) ? s : 0.f; } }
    MK_REFRESH(); xcd_barrier(bar, F.tid); MK_REFRESH();
    for (int l = 0; l < DEPTH; ++l) {
        {
            pg8::Gemm g{(const pg8::bf16_t*)(F.ws + WS_HB), (const pg8::bf16_t*)(F.ws + WS_WIN) + (size_t)l * DIN * DM, MP, DIN, DM}; pg8::StaticOrder S; S.init(MP, DIN, F.G, bx); S.wperm = true;
            pg8::EpiIn E{(pg8::bf16_t*)(F.ws + WS_ZB), (const float*)(F.ws + WS_T64), (const float*)(F.ws + WS_T32), outp + O_PWK + (size_t)l * NBATCH * 2048 * 512, outp + O_PWV + (size_t)l * NBATCH * 2048 * 512, (const float*)(F.ws + WS_SS1)};
            if (bx >= F.G / 2) sample_win_tasks(F, bx - F.G / 2, F.G - F.G / 2, (const bf16*)(F.ws + WS_WIN) + (size_t)l * DIN * DM, outp + O_SWK + (size_t)l * MS * 512, outp + O_SWV + (size_t)l * MS * 512);
            pg8::gemm_phase<pg8::EpiIn, pg8::StaticOrder, true, true>(F.lds + RING_OFF, g, S, E, F.tid);
        }
        MK_REFRESH(); xcd_barrier(bar, F.tid); MK_REFRESH();
        {
#define MK_SAMPLE_UNITS() do { \
                for (int u = F.G - 1 - F.vcu; u < 256; u += F.G) sample_attn_unit(F, u >> 3, u & 7, INP(I_CK) + (size_t)l * DBATCH * WCTX * 512, INP(I_CV) + (size_t)l * DBATCH * WCTX * 512); \
                for (int u = (F.G == 256) ? ((F.vcu & 1) ? (F.vcu >> 1) : 128) : F.vcu; u < 128; u += F.G) sample_ret_unit(F, u >> 2, u & 3, INP(I_SRET) + (size_t)l * DBATCH * 4 * 16384, outp + O_SRET + (size_t)l * DBATCH * 4 * 16384, INP(I_GNW) + (size_t)l * 512); } while (0)
            if (F.vcu & 1) MK_SAMPLE_UNITS();
            attn_prompt_units(F);
            for (int u = F.vcu; u < 512; u += F.G) ret_upd_unit(F, u >> 5, u & 31);
            if (!(F.vcu & 1)) MK_SAMPLE_UNITS();
#undef MK_SAMPLE_UNITS
        }
        MK_REFRESH(); xcd_barrier(bar, F.tid); MK_REFRESH();
        ret_scan(F, outp + O_PRET + (size_t)l * NBATCH * 4 * 16384);
#if defined(DBG_NAIVE_RESID)
        sample_resid_naive(F, (const bf16*)(F.ws + WS_SMP + SM_CATB), (const bf16*)(F.ws + WS_WOUT) + (size_t)l * DM * DM, DM);
#else
        for (int task = bx; task < 256; task += F.G) sample_resid_task<128>(F, (const bf16*)(F.ws + WS_SMP + SM_CATB), (const bf16*)(F.ws + WS_WOUT) + (size_t)l * DM * DM, DM, task);
#endif
        MK_REFRESH(); xcd_barrier(bar, F.tid); MK_REFRESH();
        { for (int u = F.vcu; u < 256; u += F.G) ret_out_pair(F, u, INP(I_GNW) + (size_t)l * 512); combine_prompt(F); }
        MK_REFRESH(); xcd_barrier(bar, F.tid); MK_REFRESH();
        {
            pg8::Gemm g{(const pg8::bf16_t*)(F.ws + WS_CATB), (const pg8::bf16_t*)(F.ws + WS_WOUT) + (size_t)l * DM * DM, MP, DM, DM}; pg8::StaticOrder S; S.init(MP, DM, F.G, bx);
            pg8::EpiResidNorm E{(pg8::bf16_t*)(F.ws + WS_HB), (float*)(F.ws + WS_SS2)};
            pg8::gemm_phase<pg8::EpiResidNorm, pg8::StaticOrder, true, true>(F.lds + RING_OFF, g, S, E, F.tid);
        }
        MK_REFRESH(); xcd_barrier(bar, F.tid); MK_REFRESH();
        {
            pg8::Gemm g{(const pg8::bf16_t*)(F.ws + WS_HB), (const pg8::bf16_t*)(F.ws + WS_WUP) + (size_t)l * DUP * DM, MP, DUP, DM}; pg8::StaticOrder S; S.init(MP, DUP, F.G, bx);
            pg8::EpiUpConv E{(pg8::bf16_t*)(F.ws + WS_AB), (float*)(F.ws + WS_UB), outp + O_PCONV + (size_t)l * NBATCH * 2 * DUP, INP(I_CW) + (size_t)l * 3 * DUP, INP(I_CB) + (size_t)l * DUP, (PG8_LAS float*)(F.lds + EXB_OFF), (const float*)(F.ws + WS_SS2)};
            if (bx >= F.G / 2) sample_up_tasks(F, bx - F.G / 2, F.G - F.G / 2, (const bf16*)(F.ws + WS_WUP) + (size_t)l * DUP * DM, INP(I_SCONV) + (size_t)l * DBATCH * 2 * DUP, INP(I_CW) + (size_t)l * 3 * DUP, INP(I_CB) + (size_t)l * DUP, outp + O_SCONV + (size_t)l * DBATCH * 2 * DUP);
            pg8::gemm_phase<pg8::EpiUpConv, pg8::StaticOrder, true, true>(F.lds + RING_OFF, g, S, E, F.tid);
        }
        MK_REFRESH(); xcd_barrier(bar, F.tid); MK_REFRESH();
        {
            conv_fixup_phase(F, INP(I_CW) + (size_t)l * 3 * DUP, INP(I_CB) + (size_t)l * DUP);
#if defined(DBG_NAIVE_RESID)
            sample_resid_naive(F, (const bf16*)(F.ws + WS_SMP + SM_AB), (const bf16*)(F.ws + WS_WDN) + (size_t)l * DM * DFF, DFF);
#else
            for (int task = bx; task < 256; task += F.G) sample_resid_task<352>(F, (const bf16*)(F.ws + WS_SMP + SM_AB), (const bf16*)(F.ws + WS_WDN) + (size_t)l * DM * DFF, DFF, task);
#endif
        }
        MK_REFRESH(); xcd_barrier(bar, F.tid); MK_REFRESH();
        {
            pg8::Gemm g{(const pg8::bf16_t*)(F.ws + WS_AB), (const pg8::bf16_t*)(F.ws + WS_WDN) + (size_t)l * DM * DFF, MP, DM, DFF}; pg8::StaticOrder S; S.init(MP, DM, F.G, bx);
            pg8::EpiResidNorm E{(pg8::bf16_t*)(F.ws + WS_HB), (float*)(F.ws + WS_SS1)};
            pg8::gemm_phase<pg8::EpiResidNorm, pg8::StaticOrder, true, true>(F.lds + RING_OFF, g, S, E, F.tid);
        }
        MK_REFRESH(); xcd_barrier(bar, F.tid); MK_REFRESH();
    }
    final_norm_phase(F, (const bf16*)(F.ws + WS_HB), XS, INP(I_FNW), outp + O_YP, outp + O_YS);
}

extern "C" void kernel_launch(void* const* d_in, const int* in_sizes, int n_in, void* d_out, int out_size, void* d_ws, size_t ws_size, hipStream_t stream) {
    static int grid = 0;
    if (grid == 0) {
        if (n_in != 16 || (size_t)out_size != O_END || ws_size < WS_OPT_END) { fprintf(stderr, "kernel_launch: unexpected sizes (n_in %d out %d ws %zu)\n", n_in, out_size, ws_size); grid = -1; return; }
        int dev = 0, cus = 0, per_cu = 0;
        if (hipGetDevice(&dev) != hipSuccess || hipDeviceGetAttribute(&cus, hipDeviceAttributeMultiprocessorCount, dev) != hipSuccess) { grid = -1; return; }
        if (hipFuncSetAttribute((const void*)mk_fwd, hipFuncAttributeMaxDynamicSharedMemorySize, LDS_BYTES) != hipSuccess) { fprintf(stderr, "kernel_launch: hipFuncSetAttribute failed\n"); grid = -1; return; }
        if (hipOccupancyMaxActiveBlocksPerMultiprocessor(&per_cu, (const void*)mk_fwd, NWAVES * 64, LDS_BYTES) != hipSuccess || per_cu < 1) { fprintf(stderr, "kernel_launch: occupancy query says %d blocks per CU\n", per_cu); }
        (void)hipGetLastError();
        grid = cus;
    }
    if (grid < 0) return;
    if (hipMemsetAsync((char*)d_ws + WS_CTL, 0, CTL_ZERO_BYTES, stream) != hipSuccess) return;
    Args a{}; for (int i = 0; i < 16; ++i) a.in[i] = (const float*)d_in[i];
    a.out = (float*)d_out; a.ws = (unsigned char*)d_ws; a.layer = 0; a.pad = 0;
    hipLaunchKernelGGL(mk_fwd, dim3(grid), dim3(NWAVES * 64), LDS_BYTES, stream, a);
}
```
